# Optimizing an MI355X kernel written in HIP

```python
import math
import jax
import jax.numpy as jnp
from jax import lax
import numpy as np

D_MODEL = 1024
BATCH = 8
SEQ = 8192
DEPTH = 4

HEAD_DIM = 64
MIX_WIDTH = D_MODEL
A_HEADS = 4
DIFF_QK_DIM = HEAD_DIM // 2
DIFF_V_DIM = HEAD_DIM
B_HEADS = 6
C_HEADS = 6
DILATED_PATTERNS = ((128, 1), (512, 4), (2048, 16))
Q_BLOCK = 128
ROPE_THETA = 10000.0
D_FF = 2816
CONV_WIDTH = 3
NORM_EPS = 1e-6
SUBLN_EPS = 1e-5
FORGET_BIAS_INIT = 4.0

A_Q = A_HEADS * 2 * DIFF_QK_DIM
A_K = A_HEADS * 2 * DIFF_QK_DIM
A_V = A_HEADS * DIFF_V_DIM
B_W = B_HEADS * HEAD_DIM
C_W = C_HEADS * HEAD_DIM
IN_COLS = A_Q + A_K + A_V + 3 * B_W + 3 * C_W + C_HEADS

kernel_name = 'hybrid_diff_dilated_fox_block'


def rmsnorm(x, g, eps=NORM_EPS):
    xf = x.astype(jnp.float32)
    y = xf * lax.rsqrt(jnp.mean(xf * xf, axis=-1, keepdims=True) + eps)
    return (y * g.astype(jnp.float32)).astype(x.dtype)


def rope_tables(seq, dim):
    inv = 1.0 / (ROPE_THETA ** (jnp.arange(0, dim, 2, dtype=jnp.float32) / dim))
    ang = jnp.arange(seq, dtype=jnp.float32)[:, None] * inv[None, :]
    return jnp.cos(ang), jnp.sin(ang)


def apply_rope(x, cos, sin):
    half = x.shape[-1] // 2
    xf = x.astype(jnp.float32)
    x1, x2 = xf[..., :half], xf[..., half:]
    out = jnp.concatenate([x1 * cos - x2 * sin, x2 * cos + x1 * sin], axis=-1)
    return out.astype(x.dtype)


def diff_attention(q, k, v, lam):
    bn, h, _, t, dk = q.shape
    nb = t // Q_BLOCK
    qb = q.reshape(bn, h, 2, nb, Q_BLOCK, dk).transpose(3, 0, 1, 2, 4, 5)
    kpos = jnp.arange(t)
    scale = dk ** -0.5
    vf = v.astype(jnp.float32)

    def block(args):
        qblk, bi = args
        s = jnp.einsum('bhmqd,bhmkd->bhmqk', qblk, k).astype(jnp.float32) * scale
        qpos = bi * Q_BLOCK + jnp.arange(Q_BLOCK)
        s = jnp.where(kpos[None, :] <= qpos[:, None], s, -jnp.inf)
        p = jax.nn.softmax(s, axis=-1)
        a = p[:, :, 0] - lam * p[:, :, 1]
        return jnp.einsum('bhqk,bhkd->bhqd', a, vf)

    o = lax.map(block, (qb, jnp.arange(nb)))
    return o.transpose(1, 2, 0, 3, 4).reshape(bn, h, t, -1)


def forgetting_attention(q, k, v, cum_logf):
    bn, h, t, hd = q.shape
    nb = t // Q_BLOCK
    qb = q.reshape(bn, h, nb, Q_BLOCK, hd).transpose(2, 0, 1, 3, 4)
    fb = cum_logf.reshape(bn, h, nb, Q_BLOCK).transpose(2, 0, 1, 3)
    kpos = jnp.arange(t)
    scale = hd ** -0.5
    vf = v.astype(jnp.float32)

    def block(args):
        qblk, fq, bi = args
        s = jnp.einsum('bhqd,bhkd->bhqk', qblk, k).astype(jnp.float32) * scale
        s = s + fq[..., :, None] - cum_logf[..., None, :]
        qpos = bi * Q_BLOCK + jnp.arange(Q_BLOCK)
        s = jnp.where(kpos[None, :] <= qpos[:, None], s, -jnp.inf)
        p = jax.nn.softmax(s, axis=-1)
        return jnp.einsum('bhqk,bhkd->bhqd', p, vf)

    o = lax.map(block, (qb, fb, jnp.arange(nb)))
    return o.transpose(1, 2, 0, 3, 4).reshape(bn, h, t, hd)


def banded_window_attention(q, k, v, w):
    bn, g, l, hd = q.shape
    nb = l // w
    qb = q.reshape(bn, g, nb, w, hd)

    def with_prev(a):
        a = a.reshape(bn, g, nb, w, hd)
        prev = jnp.pad(a, ((0, 0), (0, 0), (1, 0), (0, 0), (0, 0)))[:, :, :-1]
        return jnp.concatenate([prev, a], axis=3)

    kk, vv = with_prev(k), with_prev(v)
    s = jnp.einsum('bgnqd,bgnkd->bgnqk', qb, kk).astype(jnp.float32) * (hd ** -0.5)
    dist = jnp.arange(w)[:, None] + w - jnp.arange(2 * w)[None, :]
    kidx = jnp.arange(nb)[:, None] * w + jnp.arange(2 * w)[None, :] - w
    mask = ((dist >= 0) & (dist <= w))[None, :, :] & (kidx >= 0)[:, None, :]
    s = jnp.where(mask, s, -jnp.inf)
    m = jnp.max(s, axis=-1, keepdims=True)
    p = jnp.exp(s - m)
    den = jnp.sum(p, axis=-1, keepdims=True)
    o = jnp.einsum('bgnqk,bgnkd->bgnqd', p, vv.astype(jnp.float32)) / den
    lse = (m + jnp.log(den))[..., 0]
    return o.reshape(bn, g, l, hd), lse.reshape(bn, g, l)


def dilated_mixture_attention(q, k, v):
    bn, h, t, hd = q.shape
    outs, lses = [], []
    for window, d in DILATED_PATTERNS:
        l = t // d
        w = window // d
        lp = -(-l // w) * w

        def fold(a):
            a = a.reshape(bn, h, l, d, hd).transpose(0, 1, 3, 2, 4).reshape(bn, h * d, l, hd)
            return jnp.pad(a, ((0, 0), (0, 0), (0, lp - l), (0, 0)))

        o, lse = banded_window_attention(fold(q), fold(k), fold(v), w)
        o = o[:, :, :l].reshape(bn, h, d, l, hd).transpose(0, 1, 3, 2, 4).reshape(bn, h, t, hd)
        lse = lse[:, :, :l].reshape(bn, h, d, l).transpose(0, 1, 3, 2).reshape(bn, h, t)
        outs.append(o)
        lses.append(lse)
    wts = jax.nn.softmax(jnp.stack(lses, axis=0), axis=0)
    return jnp.sum(wts[..., None] * jnp.stack(outs, axis=0), axis=0)


def causal_depthwise_conv(g, w, b):
    t = g.shape[1]
    gp = jnp.pad(g, ((0, 0), (CONV_WIDTH - 1, 0), (0, 0)))
    y = b
    for i in range(CONV_WIDTH):
        y = y + gp[:, i:i + t] * w[i]
    return y


def mixer_layer(h, w_in, w_out, lam_params, subln_g, forget_bias, lam_init, cos_a, sin_a, cos_b, sin_b):
    bn, t, _ = h.shape
    proj = h @ w_in
    cuts = np.cumsum([A_Q, A_K, A_V, B_W, B_W, B_W, C_W, C_W, C_W])
    qa, ka, va, qb, kb, vb, qc, kc, vc, fz = jnp.split(proj, cuts, axis=-1)

    qa = apply_rope(qa.reshape(bn, t, A_HEADS, 2, DIFF_QK_DIM).transpose(0, 2, 3, 1, 4), cos_a, sin_a)
    ka = apply_rope(ka.reshape(bn, t, A_HEADS, 2, DIFF_QK_DIM).transpose(0, 2, 3, 1, 4), cos_a, sin_a)
    va = va.reshape(bn, t, A_HEADS, DIFF_V_DIM).transpose(0, 2, 1, 3)
    lp = lam_params.astype(jnp.float32)
    lam = jnp.exp(jnp.sum(lp[0] * lp[1])) - jnp.exp(jnp.sum(lp[2] * lp[3])) + lam_init
    oa = diff_attention(qa, ka, va, lam)
    oa = oa * lax.rsqrt(jnp.mean(oa * oa, axis=-1, keepdims=True) + SUBLN_EPS)
    oa = oa * subln_g.astype(jnp.float32) * (1.0 - lam_init)

    def heads(a, n):
        return a.reshape(bn, t, n, HEAD_DIM).transpose(0, 2, 1, 3)
    qb = apply_rope(heads(qb, B_HEADS), cos_b, sin_b)
    kb = apply_rope(heads(kb, B_HEADS), cos_b, sin_b)
    ob = dilated_mixture_attention(qb, kb, heads(vb, B_HEADS))

    logf = jax.nn.log_sigmoid((fz + forget_bias).astype(jnp.float32))
    cum_logf = lax.cumsum(logf, axis=1).transpose(0, 2, 1)
    oc = forgetting_attention(heads(qc, C_HEADS), heads(kc, C_HEADS), heads(vc, C_HEADS), cum_logf)

    def merge(o):
        return o.transpose(0, 2, 1, 3).reshape(bn, t, -1)
    o = jnp.concatenate([merge(oa), merge(ob), merge(oc)], axis=-1).astype(h.dtype)
    return o @ w_out


def setup_inputs(seed: int = 0) -> dict:
    key = jax.random.key(seed)
    ks = jax.random.split(key, 18)
    f32 = jnp.float32
    n = jax.random.normal
    return {
        'x': n(ks[0], (BATCH, SEQ, D_MODEL), f32),
        'c': n(ks[1], (BATCH, D_MODEL), f32),
        'w_mod': n(ks[2], (DEPTH, D_MODEL, 6 * D_MODEL), f32) * (0.5 * D_MODEL ** -0.5),
        'b_mod': n(ks[3], (DEPTH, 6 * D_MODEL), f32) * 0.02,
        'g_attn': 1.0 + 0.02 * n(ks[4], (DEPTH, D_MODEL), f32),
        'w_in': n(ks[5], (DEPTH, D_MODEL, IN_COLS), f32) * D_MODEL ** -0.5,
        'diff_lambda': n(ks[6], (DEPTH, 4, DIFF_QK_DIM), f32) * 0.1,
        'subln_g': 1.0 + 0.02 * n(ks[7], (DEPTH, DIFF_V_DIM), f32),
        'forget_bias': FORGET_BIAS_INIT + 0.5 * n(ks[8], (DEPTH, C_HEADS), f32),
        'w_out': n(ks[9], (DEPTH, MIX_WIDTH, D_MODEL), f32) * MIX_WIDTH ** -0.5,
        'g_mlp': 1.0 + 0.02 * n(ks[10], (DEPTH, D_MODEL), f32),
        'w_up': n(ks[11], (DEPTH, D_MODEL, 2 * D_FF), f32) * D_MODEL ** -0.5,
        'conv_w': n(ks[12], (DEPTH, CONV_WIDTH, D_FF), f32) * CONV_WIDTH ** -0.5,
        'conv_b': n(ks[13], (DEPTH, D_FF), f32) * 0.02,
        'w_down': n(ks[14], (DEPTH, D_FF, D_MODEL), f32) * D_FF ** -0.5,
        'g_final': 1.0 + 0.02 * n(ks[15], (D_MODEL,), f32),
    }


def reference(x, c, w_mod, b_mod, g_attn, w_in, diff_lambda, subln_g, forget_bias, w_out,
              g_mlp, w_up, conv_w, conv_b, w_down, g_final):
    t = x.shape[1]
    cos_a, sin_a = rope_tables(t, DIFF_QK_DIM)
    cos_b, sin_b = rope_tables(t, HEAD_DIM)
    sc = jax.nn.silu(c)
    for layer in range(DEPTH):
        lam_init = 0.8 - 0.6 * math.exp(-0.3 * layer)
        mod = sc @ w_mod[layer] + b_mod[layer]
        shift1, scale1, gate1, shift2, scale2, gate2 = [m[:, None, :] for m in jnp.split(mod, 6, axis=-1)]

        h = rmsnorm(x, g_attn[layer]) * (1.0 + scale1) + shift1
        o = mixer_layer(h, w_in[layer], w_out[layer], diff_lambda[layer], subln_g[layer],
                        forget_bias[layer], lam_init, cos_a, sin_a, cos_b, sin_b)
        x = x + gate1 * o

        h = rmsnorm(x, g_mlp[layer]) * (1.0 + scale2) + shift2
        up = h @ w_up[layer]
        u, g = up[..., :D_FF], up[..., D_FF:]
        g = causal_depthwise_conv(g, conv_w[layer], conv_b[layer])
        x = x + gate2 * ((jax.nn.silu(g) * u) @ w_down[layer])
    return rmsnorm(x, g_final)
```

```cpp
#include <hip/hip_runtime.h>
#include <hip/hip_cooperative_groups.h>
#include <cstdio>
#include <cstdint>
namespace cg = cooperative_groups;
namespace pg8 {
#define PG8_LAS __attribute__((address_space(3)))
typedef unsigned short bf16_t;
typedef short bf16x8 __attribute__((ext_vector_type(8)));
typedef float f32x4 __attribute__((ext_vector_type(4)));
typedef unsigned u32x4 __attribute__((ext_vector_type(4)));
constexpr int BM = 256, BK = 64, HALF = 128, HTB = HALF * BK * 2  , STAGE_BYTES = 8 * HTB, NXCD = 8, WGM = 8;

__host__ __device__ __forceinline__ int lds_byte(int r, int c) { const int st = (r >> 4) * 2 + (c >> 5), rr = r & 15, cc = c & 31, ob = rr * 64 + cc * 2; return st * 1024 + (ob ^ (((ob >> 9) & 1) << 5)); }
__host__ __device__ __forceinline__ void stage_rc(int b, int& R, int& C) { const int st = b / 1024, sb = b % 1024, swz = sb ^ (((sb >> 9) & 1) << 5); R = (st >> 1) * 16 + swz / 64; C = (st & 1) * 32 + (swz % 64) / 2; }
__host__ __device__ __forceinline__ int perm32(int rho) { const int n = rho >> 4, i = rho & 15; return 8 * (i >> 2) + 4 * n + (i & 3); }

struct Unit { int pm, pn; };
struct Gemm { const bf16_t* A; const bf16_t* Bt; int M, N, K; };

struct StaticOrder {
    int nM, nN, nwg, G, c;
    __host__ __device__ void init(int M, int N, int G_, int c_) { nM = M / BM; nN = N / BM; nwg = nM * nN; G = G_; c = c_; }
    __host__ __device__ bool next(int i, Unit& u) const {
        const long L = (long)i * G + c; if (L >= nwg) return false;
        int wgid = (int)L; { const int q = nwg / NXCD, r = nwg % NXCD, xcd = wgid % NXCD, off = wgid / NXCD; wgid = (xcd < r ? xcd * (q + 1) : r * (q + 1) + (xcd - r) * q) + off; }
        const int nig = WGM * nN, gid = wgid / nig, fm = gid * WGM, gsz = (nM - fm) < WGM ? (nM - fm) : WGM;
        u.pm = fm + ((wgid % nig) % gsz); u.pn = (wgid % nig) / gsz; return true;
    }
    __device__ __forceinline__ void a_ready(const Unit&) const {}
    __device__ __forceinline__ void done(const Unit&) const {}
};

__device__ __forceinline__ unsigned cvt_pk_bf16(float lo, float hi) { unsigned r; asm volatile("v_cvt_pk_bf16_f32 %0, %1, %2" : "=v"(r) : "v"(lo), "v"(hi)); return r; }
template <class Epi, class Sched, bool ALIGN_EPI = false, bool SP2 = false>
__device__ __forceinline__ void gemm_phase(PG8_LAS unsigned char* lds, const Gemm g, const Sched& S, const Epi& E) {
    int tid_l = threadIdx.x; asm volatile("" : "+v"(tid_l));
    const int tid = tid_l, wid = __builtin_amdgcn_readfirstlane(tid >> 6), lane = tid & 63, wr = wid >> 2, wc = wid & 3, fr = lane & 15, fq = lane >> 4;
    const int K = g.K, nt = K / BK;
    unsigned voffA[2], voffB[2];
#pragma unroll
    for (int i = 0; i < 2; ++i) { int R, C; stage_rc(tid * 16 + i * 8192, R, C); const int Rb = Epi::PERM ? ((R & ~31) + perm32(R & 31)) : R;
        voffA[i] = (unsigned)(R * K + C) * 2u; voffB[i] = (unsigned)(Rb * K + C) * 2u; }
    const size_t kstep = (size_t)(BK * 2);
    const size_t hstep = (size_t)HALF * K * 2;
    const size_t tstep = 2 * hstep;
    const unsigned ldsw = (unsigned)wid * 1024u;
    const int aoff = lds_byte(wr * 64 + fr, fq * 8), boff = lds_byte(wc * 32 + fr, fq * 8);
#define PG8_SA(b, h) (((b) * 2 + (h)) * HTB)
#define PG8_SB(b, h) ((4 + (b) * 2 + (h)) * HTB)
#define PG8_STAGE(bufoff, gbase, voff) do { _Pragma("unroll") for (int _i = 0; _i < 2; ++_i) \
        __builtin_amdgcn_global_load_lds((const unsigned*)((const char*)(gbase) + (voff)[_i]), (PG8_LAS unsigned*)(lds + (bufoff) + ldsw + _i * 8192), 16, 0, 0); } while (0)
#define PG8_LDA(dst, b, h) do { _Pragma("unroll") for (int m = 0; m < 4; ++m) _Pragma("unroll") for (int k = 0; k < 2; ++k) dst[m][k] = *(const PG8_LAS bf16x8*)(lds + PG8_SA(b, h) + aoff + m * 2048 + k * 1024); } while (0)
#define PG8_LDB(dst, b, h) do { _Pragma("unroll") for (int n = 0; n < 2; ++n) _Pragma("unroll") for (int k = 0; k < 2; ++k) dst[n][k] = *(const PG8_LAS bf16x8*)(lds + PG8_SB(b, h) + boff + n * 2048 + k * 1024); } while (0)
#define PG8_MMA(ai, bj, At, Bt) do { __builtin_amdgcn_s_setprio(1); _Pragma("unroll") for (int m = 0; m < 4; ++m) _Pragma("unroll") for (int n = 0; n < 2; ++n) _Pragma("unroll") for (int k = 0; k < 2; ++k) \
        acc[ai][bj][m][n] = __builtin_amdgcn_mfma_f32_16x16x32_bf16(Bt[n][k], At[m][k], acc[ai][bj][m][n], 0, 0, 0); __builtin_amdgcn_s_setprio(0); } while (0)
#define PG8_WAIT_V(n) asm volatile("s_waitcnt vmcnt(" #n ")" ::: "memory")
#define PG8_WAIT_L(n) asm volatile("s_waitcnt lgkmcnt(" #n ")" ::: "memory")
#define PG8_BAR __builtin_amdgcn_s_barrier()
#define PG8_SCHED __builtin_amdgcn_sched_barrier(0)
    Unit cur, nxt; int ui = 0;
    if (!S.next(0, cur)) return;
    f32x4 acc[2][2][4][2];
#pragma unroll
    for (int a = 0; a < 2; ++a)
#pragma unroll
        for (int b = 0; b < 2; ++b)
#pragma unroll
            for (int m = 0; m < 4; ++m)
#pragma unroll
                for (int n = 0; n < 2; ++n) acc[a][b][m][n] = (f32x4){0.f, 0.f, 0.f, 0.f};
    bf16x8 At[4][2], B0[2][2], B1[2][2];
    const char* cA = (const char*)g.A + (size_t)cur.pm * tstep; const char* cB = (const char*)g.Bt + (size_t)cur.pn * tstep;
    S.a_ready(cur);
    if constexpr (SP2) {
        PG8_STAGE(PG8_SB(0, 0), cB, voffB); PG8_STAGE(PG8_SB(0, 1), cB + hstep, voffB); PG8_STAGE(PG8_SA(0, 0), cA, voffA); PG8_STAGE(PG8_SA(0, 1), cA + hstep, voffA);
        if (wr == 1) PG8_BAR;
        PG8_WAIT_V(2); PG8_BAR;
        PG8_STAGE(PG8_SB(1, 0), cB + kstep, voffB); PG8_STAGE(PG8_SA(1, 0), cA + kstep, voffA); PG8_STAGE(PG8_SB(1, 1), cB + hstep + kstep, voffB);
        PG8_WAIT_V(6); PG8_BAR;
    } else {
        PG8_STAGE(PG8_SB(0, 0), cB, voffB); PG8_STAGE(PG8_SA(0, 0), cA, voffA); PG8_STAGE(PG8_SB(0, 1), cB + hstep, voffB); PG8_STAGE(PG8_SA(0, 1), cA + hstep, voffA);
        if (wr == 1) PG8_BAR;
        PG8_WAIT_V(4); PG8_BAR;
        PG8_STAGE(PG8_SB(1, 0), cB + kstep, voffB); PG8_STAGE(PG8_SA(1, 0), cA + kstep, voffA); PG8_STAGE(PG8_SB(1, 1), cB + hstep + kstep, voffB);
        PG8_WAIT_V(6); PG8_BAR;
    }
    for (;;) {
        const bool has_next = S.next(ui + 1, nxt);
        const char* nA = has_next ? (const char*)g.A + (size_t)nxt.pm * tstep : cA; const char* nB = has_next ? (const char*)g.Bt + (size_t)nxt.pn * tstep : cB;
        for (int t = 0; t < nt; t += 2) {
            const bool last = (t == nt - 2);
            const char* a1 = cA + (size_t)(t + 1) * kstep;
            const char* a2 = last ? nA : cA + (size_t)(t + 2) * kstep; const char* b2 = last ? nB : cB + (size_t)(t + 2) * kstep;
            const char* a3 = a2 + kstep; const char* b3 = b2 + kstep;
            if (last && has_next) S.a_ready(nxt);
            if constexpr (SP2) {
            PG8_LDB(B0, 0, 0); PG8_LDB(B1, 0, 1); PG8_SCHED; PG8_LDA(At, 0, 0); PG8_STAGE(PG8_SA(1, 1), a1 + hstep, voffA);
            PG8_WAIT_V(8); PG8_WAIT_L(0); PG8_BAR; PG8_MMA(0, 0, At, B0); PG8_MMA(0, 1, At, B1); PG8_BAR; PG8_SCHED;
            PG8_LDA(At, 0, 1); PG8_STAGE(PG8_SB(0, 0), b2, voffB); PG8_STAGE(PG8_SB(0, 1), b2 + hstep, voffB); PG8_STAGE(PG8_SA(0, 0), a2, voffA);
            PG8_WAIT_V(8); PG8_WAIT_L(0); PG8_BAR; PG8_MMA(1, 0, At, B0); PG8_MMA(1, 1, At, B1); PG8_BAR; PG8_SCHED;
            PG8_LDB(B0, 1, 0); PG8_LDB(B1, 1, 1); PG8_SCHED; PG8_LDA(At, 1, 0); PG8_STAGE(PG8_SA(0, 1), a2 + hstep, voffA);
            PG8_WAIT_V(8); PG8_WAIT_L(0); PG8_BAR; PG8_MMA(0, 0, At, B0); PG8_MMA(0, 1, At, B1); PG8_BAR; PG8_SCHED;
            PG8_LDA(At, 1, 1); PG8_STAGE(PG8_SB(1, 0), b3, voffB); PG8_STAGE(PG8_SB(1, 1), b3 + hstep, voffB); PG8_STAGE(PG8_SA(1, 0), a3, voffA);
            PG8_WAIT_V(8); PG8_WAIT_L(0); PG8_BAR; PG8_MMA(1, 0, At, B0); PG8_MMA(1, 1, At, B1); PG8_BAR; PG8_SCHED;
            } else {
            PG8_LDB(B0, 0, 0); PG8_SCHED; PG8_LDA(At, 0, 0); PG8_STAGE(PG8_SA(1, 1), a1 + hstep, voffA);
            PG8_WAIT_L(8); PG8_BAR; PG8_WAIT_L(0); PG8_MMA(0, 0, At, B0); PG8_BAR; PG8_SCHED;
            PG8_LDB(B1, 0, 1); PG8_STAGE(PG8_SB(0, 0), b2, voffB);
            PG8_BAR; PG8_WAIT_L(0); PG8_MMA(0, 1, At, B1); PG8_BAR;
            PG8_LDA(At, 0, 1); PG8_STAGE(PG8_SA(0, 0), a2, voffA);
            PG8_BAR; PG8_WAIT_L(0); PG8_MMA(1, 0, At, B0); PG8_BAR; PG8_SCHED;
            PG8_STAGE(PG8_SB(0, 1), b2 + hstep, voffB);
            PG8_WAIT_V(6); PG8_BAR; PG8_MMA(1, 1, At, B1); PG8_BAR;
            PG8_LDB(B0, 1, 0); PG8_SCHED; PG8_LDA(At, 1, 0); PG8_STAGE(PG8_SA(0, 1), a2 + hstep, voffA);
            PG8_WAIT_L(8); PG8_BAR; PG8_WAIT_L(0); PG8_MMA(0, 0, At, B0); PG8_BAR; PG8_SCHED;
            PG8_LDB(B1, 1, 1); PG8_STAGE(PG8_SB(1, 0), b3, voffB);
            PG8_BAR; PG8_WAIT_L(0); PG8_MMA(0, 1, At, B1); PG8_BAR;
            PG8_LDA(At, 1, 1); PG8_STAGE(PG8_SA(1, 0), a3, voffA);
            PG8_BAR; PG8_WAIT_L(0); PG8_MMA(1, 0, At, B0); PG8_BAR; PG8_SCHED;
            PG8_STAGE(PG8_SB(1, 1), b3 + hstep, voffB);
            PG8_WAIT_V(6); PG8_BAR; PG8_MMA(1, 1, At, B1); PG8_BAR;
            }
        }
        if constexpr (ALIGN_EPI) { if (wr == 0) PG8_BAR; }
        if constexpr (!Epi::AFTER_DRAIN) { E(acc, cur, wr, wc, fr, fq); S.done(cur); }
        if (!has_next) break;
#pragma unroll
        for (int a = 0; a < 2; ++a)
#pragma unroll
            for (int b = 0; b < 2; ++b)
#pragma unroll
                for (int m = 0; m < 4; ++m)
#pragma unroll
                    for (int n = 0; n < 2; ++n) acc[a][b][m][n] = (f32x4){0.f, 0.f, 0.f, 0.f};
        cur = nxt; cA = nA; cB = nB; ++ui;
        if constexpr (ALIGN_EPI) { if (wr == 1) PG8_BAR; }
    }
    PG8_WAIT_V(0);
    if constexpr (!ALIGN_EPI) { if (wr == 0) PG8_BAR; }
    PG8_BAR;
    if constexpr (Epi::AFTER_DRAIN) { E.fused(acc, cur, wr, wc, fr, fq, lds, wid, lane); S.done(cur); }
#undef PG8_SA
#undef PG8_SB
#undef PG8_STAGE
#undef PG8_LDA
#undef PG8_LDB
#undef PG8_MMA
#undef PG8_WAIT_V
#undef PG8_WAIT_L
#undef PG8_BAR
#undef PG8_SCHED
}
}

using pg8::bf16_t; using pg8::f32x4; using pg8::u32x4; using pg8::bf16x8;
typedef float f32x16 __attribute__((ext_vector_type(16)));
typedef short v4i16_t __attribute__((ext_vector_type(4)));
#define LAS __attribute__((address_space(3)))

constexpr int NB = 8, T = 8192, DM = 1024, DEPTH = 4, MROWS = NB * T;
constexpr int INC = 3078, NIN = 3072, DFF = 2816, NUP = 5632, NSLOT = 48, NMOD = 6 * DM;
constexpr float LOG2E = 1.4426950408889634f;
constexpr float QSC_A = 0.17677669529663687f * LOG2E;
constexpr float QSC_B = 0.125f * LOG2E;

constexpr size_t MiB = 1u << 20;
constexpr size_t WS_CTL = 0, CTL_BYTES = 1 * MiB;
constexpr size_t WS_WT = 2 * MiB;
constexpr size_t WL_IN = 0, WL_OUT = (size_t)NIN * DM, WL_UP = WL_OUT + (size_t)DM * DM, WL_DN = WL_UP + (size_t)NUP * DM, WL_ELEMS = WL_DN + (size_t)DM * DFF;
constexpr size_t WS_MOD = 102 * MiB;
constexpr size_t WS_ROPEA = 103 * MiB;
constexpr size_t WS_ROPEB = 104 * MiB;
constexpr size_t WS_WFZ = 106 * MiB;
constexpr size_t WS_LOGF = 107 * MiB;
constexpr size_t WS_LSEB = 109 * MiB;
constexpr size_t WS_H = 116 * MiB;
constexpr size_t WS_QKV = 244 * MiB;
constexpr size_t WS_ACT = WS_QKV;
constexpr size_t WS_O = 628 * MiB;
constexpr size_t WS_OBP = 756 * MiB;
constexpr size_t WS_FIX = WS_OBP;
constexpr size_t FIX_ELEMS = (size_t)1024 * 2 * DFF;
constexpr size_t WS_END = 900 * MiB;
static_assert(WS_WT + WL_ELEMS * 2 * DEPTH <= WS_MOD, "weights fit");
static_assert(3 * FIX_ELEMS * 4 <= 144 * MiB, "fix fits");

constexpr int LDS_BYTES = 147456;
constexpr int MISC_OFF = 131072;
constexpr int AT_K = 0, AT_V = 8192, AT_BIAS = 16384, AT_BUF = 16640, AT_WS = 2 * AT_BUF;

struct Args { const float* in[16]; float* out; unsigned char* ws; };

__device__ __forceinline__ unsigned f2bf(float f) { unsigned u = __builtin_bit_cast(unsigned, f); return (u + 0x7fffu + ((u >> 16) & 1u)) >> 16; }
__device__ __forceinline__ unsigned pk2(float lo, float hi) { return f2bf(lo) | (f2bf(hi) << 16); }
__device__ __forceinline__ float bf2f(unsigned short h) { return __builtin_bit_cast(float, (unsigned)h << 16); }
__device__ __forceinline__ float wave_sum(float v) {
#pragma unroll
    for (int o = 1; o < 64; o <<= 1) v += __shfl_xor(v, o);
    return v;
}
#define LDS_FENCE() asm volatile("s_waitcnt lgkmcnt(0)" ::: "memory")

namespace pg8 {
struct EpiIn {
    static constexpr bool PERM = true, AFTER_DRAIN = false;
    bf16_t* QKV; const float* ropeA; const float* ropeB;
    __device__ __forceinline__ void operator()(const f32x4 (&acc)[2][2][4][2], const Unit& u, int wr, int wc, int fr, int fq) const {
#pragma unroll
        for (int bj = 0; bj < 2; ++bj) {
            const int slot = 4 * u.pn + 2 * bj + (wc >> 1);
            const int c0 = 32 * (wc & 1) + 8 * fq;
            int kind = 0; float sc = 1.f;
            if (slot < 8) { kind = 1; if (slot < 4) sc = QSC_A; }
            else if (slot >= 12 && slot < 24) { kind = 2; if (slot < 18) sc = QSC_B; }
            else if (slot >= 30 && slot < 36) sc = QSC_B;
#pragma unroll
            for (int ai = 0; ai < 2; ++ai)
#pragma unroll
                for (int m = 0; m < 4; ++m) {
                    const int row = u.pm * BM + ai * HALF + wr * 64 + m * 16 + fr, b = row >> 13, t = row & (T - 1);
                    f32x4 v0 = acc[ai][bj][m][0], v1 = acc[ai][bj][m][1];
                    if (kind) {
                        const float* tb = (kind == 1) ? ropeA + ((size_t)t * 16 + 4 * fq) * 2 : ropeB + ((size_t)t * 32 + 16 * (wc & 1) + 4 * fq) * 2;
                        const f32x4 c01 = *(const f32x4*)tb, c23 = *(const f32x4*)(tb + 4);
                        f32x4 w0, w1;
                        w0[0] = v0[0] * c01[0] - v0[1] * c01[1]; w0[1] = v0[1] * c01[0] + v0[0] * c01[1];
                        w0[2] = v0[2] * c01[2] - v0[3] * c01[3]; w0[3] = v0[3] * c01[2] + v0[2] * c01[3];
                        w1[0] = v1[0] * c23[0] - v1[1] * c23[1]; w1[1] = v1[1] * c23[0] + v1[0] * c23[1];
                        w1[2] = v1[2] * c23[2] - v1[3] * c23[3]; w1[3] = v1[3] * c23[2] + v1[2] * c23[3];
                        v0 = w0; v1 = w1;
                    }
                    v0 = v0 * sc; v1 = v1 * sc;
                    u32x4 w; w.x = cvt_pk_bf16(v0[0], v0[1]); w.y = cvt_pk_bf16(v0[2], v0[3]); w.z = cvt_pk_bf16(v1[0], v1[1]); w.w = cvt_pk_bf16(v1[2], v1[3]);
                    const size_t sb = (size_t)(b * NSLOT + slot) * T * 64;
                    const size_t off = (kind == 1) ? sb + (size_t)(wc & 1) * T * 32 + (size_t)t * 32 + 8 * fq : sb + (size_t)t * 64 + c0;
                    *(u32x4*)(QKV + off) = w;
                }
        }
    }
};
struct EpiRes {
    static constexpr bool PERM = false, AFTER_DRAIN = false;
    const float* base; float* out; const float* gate;
    __device__ __forceinline__ void operator()(const f32x4 (&acc)[2][2][4][2], const Unit& u, int wr, int wc, int fr, int fq) const {
        const int b = (u.pm * BM) >> 13;
#pragma unroll
        for (int bj = 0; bj < 2; ++bj)
#pragma unroll
            for (int n = 0; n < 2; ++n) {
                const int col = u.pn * BM + bj * HALF + wc * 32 + n * 16 + 4 * fq;
                const f32x4 g4 = *(const f32x4*)(gate + (size_t)b * NMOD + col);
#pragma unroll
                for (int ai = 0; ai < 2; ++ai)
#pragma unroll
                    for (int m = 0; m < 4; ++m) {
                        const size_t off = (size_t)(u.pm * BM + ai * HALF + wr * 64 + m * 16 + fr) * DM + col;
                        const f32x4 x4 = *(const f32x4*)(base + off);
                        *(f32x4*)(out + off) = x4 + g4 * acc[ai][bj][m][n];
                    }
            }
    }
};
struct EpiUp {
    static constexpr bool PERM = true, AFTER_DRAIN = false;
    bf16_t* ACT; float* FIXU; float* FIXG; float* FIXT; const float* cw; const float* cb;
    __device__ __forceinline__ void operator()(const f32x4 (&acc)[2][2][4][2], const Unit& u, int wr, int wc, int fr, int fq) const {
        const int f0 = u.pn * HALF + wc * 32 + 8 * fq;
        float w0[8], w1[8], w2[8], bb[8];
#pragma unroll
        for (int h = 0; h < 2; ++h) {
            const f32x4 a0 = *(const f32x4*)(cw + f0 + 4 * h), a1 = *(const f32x4*)(cw + DFF + f0 + 4 * h), a2 = *(const f32x4*)(cw + 2 * DFF + f0 + 4 * h), a3 = *(const f32x4*)(cb + f0 + 4 * h);
#pragma unroll
            for (int i = 0; i < 4; ++i) { w0[4 * h + i] = a0[i]; w1[4 * h + i] = a1[i]; w2[4 * h + i] = a2[i]; bb[4 * h + i] = a3[i]; }
        }
        const int lane = fq * 16 + fr;
        const int src1 = (lane & 48) | ((fr - 1) & 15), src2 = (lane & 48) | ((fr - 2) & 15);
#pragma unroll
        for (int ai = 0; ai < 2; ++ai) {
            float p1[8], p2[8];
#pragma unroll
            for (int e = 0; e < 8; ++e) { p1[e] = 0.f; p2[e] = 0.f; }
#pragma unroll
            for (int m = 0; m < 4; ++m) {
                const int row = u.pm * BM + ai * HALF + wr * 64 + m * 16 + fr;
                float g[8], uu[8], r1[8], r2[8], av[8];
#pragma unroll
                for (int e = 0; e < 8; ++e) { g[e] = acc[ai][1][m][e >> 2][e & 3]; uu[e] = acc[ai][0][m][e >> 2][e & 3]; }
#pragma unroll
                for (int e = 0; e < 8; ++e) { r1[e] = __shfl(g[e], src1); r2[e] = __shfl(g[e], src2); }
#pragma unroll
                for (int e = 0; e < 8; ++e) {
                    const float gm1 = (fr >= 1) ? r1[e] : p1[e], gm2 = (fr >= 2) ? r2[e] : p2[e];
                    const float y = bb[e] + w0[e] * gm2 + w1[e] * gm1 + w2[e] * g[e];
                    av[e] = y * __builtin_amdgcn_rcpf(1.f + __expf(-y)) * uu[e];
                }
                const bool fixrow = (m == 0) && (fr < 2);
                const int grp = row >> 6;
                if (!fixrow) {
                    u32x4 w; w.x = cvt_pk_bf16(av[0], av[1]); w.y = cvt_pk_bf16(av[2], av[3]); w.z = cvt_pk_bf16(av[4], av[5]); w.w = cvt_pk_bf16(av[6], av[7]);
                    *(u32x4*)(ACT + (size_t)row * DFF + f0) = w;
                } else {
                    const size_t o = ((size_t)grp * 2 + fr) * DFF + f0;
                    *(f32x4*)(FIXU + o) = (f32x4){uu[0], uu[1], uu[2], uu[3]}; *(f32x4*)(FIXU + o + 4) = (f32x4){uu[4], uu[5], uu[6], uu[7]};
                    *(f32x4*)(FIXG + o) = (f32x4){g[0], g[1], g[2], g[3]};     *(f32x4*)(FIXG + o + 4) = (f32x4){g[4], g[5], g[6], g[7]};
                }
                if (m == 3 && fr >= 14) {
                    const size_t o = ((size_t)grp * 2 + (fr - 14)) * DFF + f0;
                    *(f32x4*)(FIXT + o) = (f32x4){g[0], g[1], g[2], g[3]};     *(f32x4*)(FIXT + o + 4) = (f32x4){g[4], g[5], g[6], g[7]};
                }
#pragma unroll
                for (int e = 0; e < 8; ++e) { p1[e] = r1[e]; p2[e] = r2[e]; }
            }
        }
    }
};
}

template <int MAPK> __device__ __forceinline__ int colmap(int n) {
    if (MAPK == 1) {
        const int slot = n >> 6, c = n & 63;
        if (slot < 8) { const int m = c >> 5, cc = c & 31; return slot * 64 + m * 32 + ((cc & 1) ? (cc >> 1) + 16 : (cc >> 1)); }
        if (slot >= 12 && slot < 24) return slot * 64 + ((c & 1) ? (c >> 1) + 32 : (c >> 1));
        return n;
    }
    if (MAPK == 2) { const int pn = n >> 8, r = n & 255; return (r < 128) ? 128 * pn + r : DFF + 128 * pn + (r - 128); }
    return n;
}
template <int MAPK> __device__ __forceinline__ void transpose_item(const float* W, int K, int N, int ldw, bf16_t* WT, float* scr, int item, int lane) {
    const int nblk = N / 32, kb = item / nblk, nb = item % nblk, k0 = 64 * kb, n0 = 32 * nb;
    const int sc = colmap<MAPK>(n0 + (lane & 31));
#pragma unroll 8
    for (int i = 0; i < 32; ++i) { const int kk = 2 * i + (lane >> 5); scr[kk * 33 + (lane & 31)] = W[(size_t)(k0 + kk) * ldw + sc]; }
    LDS_FENCE();
    const int c = lane & 7;
#pragma unroll
    for (int j = 0; j < 4; ++j) { const int n = (lane >> 3) + 8 * j; const float* s = scr + (8 * c) * 33 + n;
        u32x4 o; o.x = pk2(s[0 * 33], s[1 * 33]); o.y = pk2(s[2 * 33], s[3 * 33]); o.z = pk2(s[4 * 33], s[5 * 33]); o.w = pk2(s[6 * 33], s[7 * 33]);
        *(u32x4*)(WT + (size_t)(n0 + n) * K + k0 + 8 * c) = o; }
    LDS_FENCE();
}

__device__ __forceinline__ void prologue(const Args& a, unsigned char* lds, int tid, int G) {
    unsigned char* ws = a.ws;
    const int lane = tid & 63, wave = tid >> 6;
    const float* c_in = a.in[1]; const float* w_mod = a.in[2]; const float* b_mod = a.in[3];
    {
        float* sc = (float*)lds;
        float* red = (float*)(lds + 32768);
        for (int i = tid; i < NB * DM; i += 512) { const float v = c_in[i]; sc[i] = v / (1.f + __expf(-v)); }
        __syncthreads();
        float* MOD = (float*)(ws + WS_MOD);
        for (int item = blockIdx.x; item < DEPTH * (NMOD / 64); item += G) {
            const int l = item / (NMOD / 64), jb = item % (NMOD / 64), kg = tid >> 6, col = tid & 63;
            const float* wp = w_mod + ((size_t)l * DM + kg * 128) * NMOD + jb * 64 + col;
            float acc[8];
#pragma unroll
            for (int b = 0; b < 8; ++b) acc[b] = 0.f;
#pragma unroll 8
            for (int k = 0; k < 128; ++k) { const float w = wp[(size_t)k * NMOD];
#pragma unroll
                for (int b = 0; b < 8; ++b) acc[b] += sc[b * DM + kg * 128 + k] * w; }
#pragma unroll
            for (int b = 0; b < 8; ++b) red[(kg * 8 + b) * 64 + col] = acc[b];
            __syncthreads();
            { const int b = tid >> 6; float s = b_mod[(size_t)l * NMOD + jb * 64 + col];
#pragma unroll
              for (int g = 0; g < 8; ++g) s += red[(g * 8 + b) * 64 + col];
              MOD[((size_t)l * NB + b) * NMOD + jb * 64 + col] = s; }
            __syncthreads();
        }
    }
    __syncthreads();
    {
        const int gt = blockIdx.x * 512 + tid, NT_ = G * 512;
        float* RA = (float*)(ws + WS_ROPEA); float* RB = (float*)(ws + WS_ROPEB);
        for (int i = gt; i < T * 48; i += NT_) {
            const int t = i / 48, j = i % 48; const bool isA = j < 16; const int fi = isA ? j : j - 16; const float dim = isA ? 32.f : 64.f;
            const float e = (float)(2 * fi) / dim;
            const float pw = (float)exp2((double)e * 13.287712379549449);
            const float inv = 1.0f / pw;
            const float ang = (float)t * inv;
            const double x = (double)ang, k = rint(x * 0.15915494309189535);
            double r = fma(-k, 6.283185307179586, x); r = fma(-k, 2.4492935982947064e-16, r);
            const float rf = (float)r;
            const float cs = cosf(rf), sn = sinf(rf);
            float* dst = isA ? RA + ((size_t)t * 16 + fi) * 2 : RB + ((size_t)t * 32 + fi) * 2;
            dst[0] = cs; dst[1] = sn;
        }
        float* WFZ = (float*)(ws + WS_WFZ); const float* w_in = a.in[5];
        for (int i = gt; i < DEPTH * 6 * DM; i += NT_) { const int l = i / (6 * DM), r = i % (6 * DM), j = r / DM, k = r % DM; WFZ[i] = w_in[((size_t)l * DM + k) * INC + NIN + j]; }
    }
    {
        float* scr = (float*)(lds + wave * 16384);
        const int gw = blockIdx.x * 8 + wave, NGW = G * 8;
        constexpr int I_IN = (DM / 64) * (NIN / 32), I_OUT = (DM / 64) * (DM / 32), I_UP = (DM / 64) * (NUP / 32), I_DN = (DFF / 64) * (DM / 32), I_L = I_IN + I_OUT + I_UP + I_DN;
        for (int it = gw; it < DEPTH * I_L; it += NGW) {
            const int l = it / I_L; int r = it % I_L;
            bf16_t* WT = (bf16_t*)(ws + WS_WT) + (size_t)l * WL_ELEMS;
            if (r < I_IN) { transpose_item<1>(a.in[5] + (size_t)l * DM * INC, DM, NIN, INC, WT + WL_IN, scr, r, lane); continue; } r -= I_IN;
            if (r < I_OUT) { transpose_item<0>(a.in[9] + (size_t)l * DM * DM, DM, DM, DM, WT + WL_OUT, scr, r, lane); continue; } r -= I_OUT;
            if (r < I_UP) { transpose_item<2>(a.in[11] + (size_t)l * DM * NUP, DM, NUP, NUP, WT + WL_UP, scr, r, lane); continue; } r -= I_UP;
            transpose_item<0>(a.in[14] + (size_t)l * DFF * DM, DFF, DM, DM, WT + WL_DN, scr, r, lane);
        }
    }
}

template <bool FZ> __device__ __forceinline__ void norm_phase(const float* x, bf16_t* H, const float* gw_, const float* modl, int shift_off, int scale_off,
                                                              const float* wfz, const float* fbias, float* LOGF, int tid, int G) {
    const int lane = tid & 63, wave = tid >> 6, gw = blockIdx.x * 8 + wave, NGW = G * 8;
    const int rpw = (MROWS + NGW - 1) / NGW;
    int r0 = gw * rpw, r1 = r0 + rpw; if (r1 > MROWS) r1 = MROWS;
    f32x4 A[4], B[4]; f32x4 wz[FZ ? 6 : 1][4]; float fb[6];
    if (FZ) {
#pragma unroll
        for (int j = 0; j < 6; ++j) { fb[j] = fbias[j];
#pragma unroll
            for (int q = 0; q < 4; ++q) wz[j][q] = *(const f32x4*)(wfz + j * DM + 4 * lane + 256 * q); }
    }
    int curb = -1;
    for (int r = r0; r < r1; ++r) {
        const int b = r >> 13;
        if (b != curb) { curb = b;
#pragma unroll
            for (int q = 0; q < 4; ++q) { const int c = 4 * lane + 256 * q; const f32x4 g4 = *(const f32x4*)(gw_ + c), s4 = *(const f32x4*)(modl + (size_t)b * NMOD + scale_off + c);
                A[q] = g4 * (s4 + 1.0f); B[q] = *(const f32x4*)(modl + (size_t)b * NMOD + shift_off + c); } }
        const f32x4* xr = (const f32x4*)(x + (size_t)r * DM) + lane;
        f32x4 v[4]; float s = 0.f;
#pragma unroll
        for (int q = 0; q < 4; ++q) { v[q] = xr[64 * q]; s += (v[q][0] * v[q][0] + v[q][1] * v[q][1]) + (v[q][2] * v[q][2] + v[q][3] * v[q][3]); }
        const float rs = 1.0f / sqrtf(wave_sum(s) * (1.f / DM) + 1e-6f);
#pragma unroll
        for (int q = 0; q < 4; ++q) v[q] = v[q] * rs * A[q] + B[q];
        unsigned long long* o8 = (unsigned long long*)(H + (size_t)r * DM) + lane;
#pragma unroll
        for (int q = 0; q < 4; ++q) o8[64 * q] = (unsigned long long)pk2(v[q][0], v[q][1]) | ((unsigned long long)pk2(v[q][2], v[q][3]) << 32);
        if (FZ) {
            float z = 0.f;
#pragma unroll
            for (int j = 0; j < 6; ++j) { float d = 0.f;
#pragma unroll
                for (int q = 0; q < 4; ++q) d += (v[q][0] * wz[j][q][0] + v[q][1] * wz[j][q][1]) + (v[q][2] * wz[j][q][2] + v[q][3] * wz[j][q][3]);
                d = wave_sum(d) + fb[j]; if (lane == j) z = d; }
            if (lane < 6) { const float lf = fminf(z, 0.f) - log1pf(__expf(-fabsf(z))); LOGF[((size_t)b * 6 + lane) * T + (r & (T - 1))] = lf; }
        }
    }
}
__device__ __forceinline__ void final_norm(float* x, const float* g, int tid, int G) {
    const int lane = tid & 63, wave = tid >> 6, gw = blockIdx.x * 8 + wave, NGW = G * 8;
    f32x4 A[4];
#pragma unroll
    for (int q = 0; q < 4; ++q) A[q] = *(const f32x4*)(g + 4 * lane + 256 * q);
    for (int r = gw; r < MROWS; r += NGW) {
        f32x4* xr = (f32x4*)(x + (size_t)r * DM) + lane;
        f32x4 v[4]; float s = 0.f;
#pragma unroll
        for (int q = 0; q < 4; ++q) { v[q] = xr[64 * q]; s += (v[q][0] * v[q][0] + v[q][1] * v[q][1]) + (v[q][2] * v[q][2] + v[q][3] * v[q][3]); }
        const float rs = 1.0f / sqrtf(wave_sum(s) * (1.f / DM) + 1e-6f);
#pragma unroll
        for (int q = 0; q < 4; ++q) xr[64 * q] = v[q] * rs * A[q];
    }
}
__device__ __forceinline__ void scan_phase(float* LOGF, unsigned char* lds, int tid, int G) {
    float* wt = (float*)lds;
    for (int seq = blockIdx.x; seq < NB * 6; seq += G) {
        f32x4* p = (f32x4*)(LOGF + (size_t)seq * T) + tid * 4;
        f32x4 v[4]; float run = 0.f;
#pragma unroll
        for (int q = 0; q < 4; ++q) { v[q] = p[q];
#pragma unroll
            for (int i = 0; i < 4; ++i) { run += v[q][i]; v[q][i] = run; } }
        float inc = run;
        const int lane = tid & 63, wave = tid >> 6;
#pragma unroll
        for (int o = 1; o < 64; o <<= 1) { const float n = __shfl_up(inc, o); if (lane >= o) inc += n; }
        if (lane == 63) wt[wave] = inc;
        __syncthreads();
        float off = inc - run;
        for (int w = 0; w < wave; ++w) off += wt[w];
#pragma unroll
        for (int q = 0; q < 4; ++q) p[q] = (v[q] + off) * LOG2E;
        __syncthreads();
    }
}

__device__ __forceinline__ int crow(int r, int hi) { return (r & 3) + 8 * (r >> 2) + 4 * hi; }
__device__ __forceinline__ unsigned cvtpk(float lo, float hi) { unsigned r; asm volatile("v_cvt_pk_bf16_f32 %0, %1, %2" : "=v"(r) : "v"(lo), "v"(hi)); return r; }

template <int DK, int MODE>
__device__ __forceinline__ void attn_core(unsigned char* lds, int tid, const bf16_t* Qg, long qrs, const bf16_t* Kg, long krs, const bf16_t* Vg, long vrs,
                                          const float* Fg, float fref, int q0, int kt_lo, int kt_hi, int korg,
                                          float& mref_out, float& l_out, f32x16& o0, f32x16& o1) {
    constexpr int ROWB = DK * 2, ND = DK / 16;
    const int lane = tid & 63, wid = __builtin_amdgcn_readfirstlane(tid >> 6), r32 = lane & 31, hi = lane >> 5;
    const int qw = q0 + 32 * wid, qi = qw + r32;
    bf16x8 qr[ND];
#pragma unroll
    for (int d0 = 0; d0 < ND; ++d0) qr[d0] = *(const bf16x8*)(Qg + (long)qi * qrs + d0 * 16 + hi * 8);
    f32x16 o[2];
#pragma unroll
    for (int r = 0; r < 16; ++r) { o[0][r] = 0.f; o[1][r] = 0.f; }
    float mref = 0.f, l = 0.f;
    float* wsf = (float*)(lds + AT_WS + wid * 256);
    const int krow = (DK == 64) ? (tid >> 3) : ((tid & 255) >> 2), kch = (DK == 64) ? (tid & 7) : (tid & 3);
    const int kswz = (DK == 64) ? (krow & 7) : ((krow >> 1) & 3);
    const bool kact = (DK == 64) || (tid < 256);
    const int vrow = tid >> 3, vch = tid & 7, vswz = (vrow & 2) << 1;
    const int koff = AT_K + krow * ROWB + ((kch ^ kswz) << 4), voff = AT_V + vrow * 128 + ((vch ^ vswz) << 4);
    u32x4 kreg = (u32x4){0u, 0u, 0u, 0u}, vreg = (u32x4){0u, 0u, 0u, 0u}; float breg = 0.f;
#define AT_LOAD(kt) do { const int key0_ = 64 * (kt) + korg; if (kact) kreg = *(const u32x4*)(Kg + (long)(key0_ + krow) * krs + kch * 8); \
        vreg = *(const u32x4*)(Vg + (long)(key0_ + vrow) * vrs + vch * 8); if (MODE == 1 && tid < 64) breg = fref - Fg[key0_ + tid]; } while (0)
#define AT_STORE(buf) do { unsigned char* B_ = lds + (buf) * AT_BUF; if (kact) *(u32x4*)(B_ + koff) = kreg; *(u32x4*)(B_ + voff) = vreg; \
        if (MODE == 1 && tid < 64) *(float*)(B_ + AT_BIAS + tid * 4) = breg; } while (0)
    const int kfs = (DK == 64) ? (r32 & 7) : ((r32 >> 1) & 3);
    const int q4 = (lane & 15) >> 2, p4 = lane & 3, dh = (lane >> 4) & 1;
    const int vs = (q4 & 2) >> 1;
    const int vbase = AT_V + (4 * hi + q4) * 128 + (p4 & 1) * 8;
    const int vc = 2 * dh + (p4 >> 1);

    AT_LOAD(kt_lo); AT_STORE(0);
    __syncthreads();
    for (int kt = kt_lo; kt < kt_hi; ++kt) {
        const int cur = (kt - kt_lo) & 1;
        const bool more = (kt + 1 < kt_hi);
        if (more) AT_LOAD(kt + 1);
        const int key0 = 64 * kt + korg;
        const bool active = (MODE == 2) ? !(key0 > qw + 31 || key0 + 63 < qw - 128) : !(key0 > qw + 31);
        if (active) {
            const unsigned char* B = lds + cur * AT_BUF;
            f32x16 p0, p1;
#pragma unroll
            for (int r = 0; r < 16; ++r) { p0[r] = -mref; p1[r] = -mref; }
#pragma unroll
            for (int d0 = 0; d0 < ND; ++d0) {
                const int ch = ((2 * d0 + hi) ^ kfs) << 4;
                const bf16x8 kf0 = *(const bf16x8*)(B + AT_K + r32 * ROWB + ch), kf1 = *(const bf16x8*)(B + AT_K + (32 + r32) * ROWB + ch);
                p0 = __builtin_amdgcn_mfma_f32_32x32x16_bf16(kf0, qr[d0], p0, 0, 0, 0);
                p1 = __builtin_amdgcn_mfma_f32_32x32x16_bf16(kf1, qr[d0], p1, 0, 0, 0);
            }
            if (MODE == 1) {
#pragma unroll
                for (int g = 0; g < 4; ++g) { const f32x4 b0 = *(const f32x4*)(B + AT_BIAS + (8 * g + 4 * hi) * 4), b1 = *(const f32x4*)(B + AT_BIAS + (32 + 8 * g + 4 * hi) * 4);
#pragma unroll
                    for (int i = 0; i < 4; ++i) { p0[4 * g + i] += b0[i]; p1[4 * g + i] += b1[i]; } }
            }
            if (MODE == 2) {
#pragma unroll
                for (int r = 0; r < 16; ++r) { const int dlt = qi - (key0 + crow(r, hi)); if (dlt < 0 || dlt > 128) p0[r] = -INFINITY; if (dlt - 32 < 0 || dlt - 32 > 128) p1[r] = -INFINITY; }
            } else if (key0 + 63 > qw) {
#pragma unroll
                for (int r = 0; r < 16; ++r) { const int kk = key0 + crow(r, hi); if (kk > qi) p0[r] = -INFINITY; if (kk + 32 > qi) p1[r] = -INFINITY; }
            }
            float rm = fmaxf(p0[0], p1[0]);
#pragma unroll
            for (int r = 1; r < 16; ++r) rm = fmaxf(rm, fmaxf(p0[r], p1[r]));
            rm = fmaxf(rm, __shfl_xor(rm, 32));
            if (__any(rm > 8.f)) {
                const float dl = fmaxf(rm, 0.f); mref += dl;
#pragma unroll
                for (int r = 0; r < 16; ++r) { p0[r] -= dl; p1[r] -= dl; }
                const float f = __builtin_amdgcn_exp2f(-dl); l *= f;
                if (hi == 0) wsf[r32] = f;
                LDS_FENCE();
#pragma unroll
                for (int g = 0; g < 4; ++g) { const f32x4 fv = *(const f32x4*)(wsf + 8 * g + 4 * hi);
#pragma unroll
                    for (int i = 0; i < 4; ++i) { o[0][4 * g + i] *= fv[i]; o[1][4 * g + i] *= fv[i]; } }
                LDS_FENCE();
            }
            float s = 0.f;
#pragma unroll
            for (int r = 0; r < 16; ++r) { p0[r] = __builtin_amdgcn_exp2f(p0[r]); p1[r] = __builtin_amdgcn_exp2f(p1[r]); s += p0[r] + p1[r]; }
            l += s;
#pragma unroll
            for (int j = 0; j < 4; ++j) {
                u32x4 pw;
                if (j < 2) { const int bs = 8 * (j & 1); pw = (u32x4){cvtpk(p0[bs], p0[bs + 1]), cvtpk(p0[bs + 2], p0[bs + 3]), cvtpk(p0[bs + 4], p0[bs + 5]), cvtpk(p0[bs + 6], p0[bs + 7])}; }
                else { const int bs = 8 * (j & 1); pw = (u32x4){cvtpk(p1[bs], p1[bs + 1]), cvtpk(p1[bs + 2], p1[bs + 3]), cvtpk(p1[bs + 4], p1[bs + 5]), cvtpk(p1[bs + 6], p1[bs + 7])}; }
                const bf16x8 pa = __builtin_bit_cast(bf16x8, pw);
#pragma unroll
                for (int d0 = 0; d0 < 2; ++d0) {
                    const int ad = vbase + j * 2048 + ((((d0 ^ vs) << 2) | vc) << 4);
                    const v4i16_t lo = __builtin_amdgcn_ds_read_tr16_b64_v4i16((LAS v4i16_t*)(B + ad));
                    const v4i16_t hh = __builtin_amdgcn_ds_read_tr16_b64_v4i16((LAS v4i16_t*)(B + ad + 1024));
                    const bf16x8 vf = (bf16x8){lo[0], lo[1], lo[2], lo[3], hh[0], hh[1], hh[2], hh[3]};
                    o[d0] = __builtin_amdgcn_mfma_f32_32x32x16_bf16(pa, vf, o[d0], 0, 0, 0);
                }
            }
        }
        if (more) AT_STORE(cur ^ 1);
        __syncthreads();
    }
#undef AT_LOAD
#undef AT_STORE
    l += __shfl_xor(l, 32);
    mref_out = mref; l_out = l; o0 = o[0]; o1 = o[1];
}

__device__ __forceinline__ void row_bcast(float* wsf, float val, int r32, int hi, float (&out)[16]) {
    LDS_FENCE();
    if (hi == 0) wsf[r32] = val;
    LDS_FENCE();
#pragma unroll
    for (int g = 0; g < 4; ++g) { const f32x4 fv = *(const f32x4*)(wsf + 8 * g + 4 * hi);
#pragma unroll
        for (int i = 0; i < 4; ++i) out[4 * g + i] = fv[i]; }
    LDS_FENCE();
}

constexpr int N_AC = 32 * 80, N_BU = 3 * NB * 6 * 32, N_UNITS = N_AC + N_BU;

__device__ __forceinline__ void attn_phase(const Args& a, unsigned char* lds, int tid, int layer, unsigned* counter) {
    unsigned char* ws = a.ws;
    const bf16_t* QKV = (const bf16_t*)(ws + WS_QKV);
    bf16_t* O = (bf16_t*)(ws + WS_O);
    bf16_t* OBP = (bf16_t*)(ws + WS_OBP);
    float* LSEB = (float*)(ws + WS_LSEB);
    const float* F2 = (const float*)(ws + WS_LOGF);
    const int lane = tid & 63, wid = __builtin_amdgcn_readfirstlane(tid >> 6), r32 = lane & 31, hi = lane >> 5;
    float* wsf = (float*)(lds + AT_WS + wid * 256);
    volatile int* uq = (volatile int*)(lds + MISC_OFF);
    const float lam_init = 0.8f - 0.6f * __expf(-0.3f * (float)layer);
    float lam;
    { const float* lp = a.in[6] + (size_t)layer * 128; float s1 = 0.f, s2 = 0.f; if (lane < 32) { s1 = lp[lane] * lp[32 + lane]; s2 = lp[64 + lane] * lp[96 + lane]; }
      s1 = wave_sum(s1); s2 = wave_sum(s2); lam = expf(s1) - expf(s2) + lam_init; }
    for (;;) {
        __syncthreads();
        if (tid == 0) uq[0] = (int)atomicAdd(counter, 1u);
        __syncthreads();
        const int u = uq[0];
        if (u >= N_UNITS) break;
        float mref, l; f32x16 o0, o1; float rl[16];
        if (u < N_AC) {
            const int qb = 31 - u / 80, j = u % 80, q0 = qb * 256;
            if (j < 48) {
                const int b = j / 6, h = j % 6;
                const bf16_t* Qg = QKV + (size_t)(b * NSLOT + 30 + h) * T * 64; const bf16_t* Kg = QKV + (size_t)(b * NSLOT + 36 + h) * T * 64; const bf16_t* Vg = QKV + (size_t)(b * NSLOT + 42 + h) * T * 64;
                const float* Fg = F2 + (size_t)(b * 6 + h) * T;
                attn_core<64, 1>(lds, tid, Qg, 64, Kg, 64, Vg, 64, Fg, Fg[q0], q0, 0, 4 * qb + 4, 0, mref, l, o0, o1);
                row_bcast(wsf, 1.0f / l, r32, hi, rl);
                bf16_t* Ob = O + (size_t)(b * T + q0 + 32 * wid) * DM + 640 + h * 64 + r32;
#pragma unroll
                for (int r = 0; r < 16; ++r) { bf16_t* op = Ob + (size_t)crow(r, hi) * DM; op[0] = (bf16_t)f2bf(o0[r] * rl[r]); op[32] = (bf16_t)f2bf(o1[r] * rl[r]); }
            } else {
                const int jj = j - 48, b = jj / 4, h = jj % 4;
                const bf16_t* Qg = QKV + (size_t)(b * NSLOT + h) * T * 64; const bf16_t* Kg = QKV + (size_t)(b * NSLOT + 4 + h) * T * 64; const bf16_t* Vg = QKV + (size_t)(b * NSLOT + 8 + h) * T * 64;
                attn_core<32, 0>(lds, tid, Qg, 32, Kg, 32, Vg, 64, nullptr, 0.f, q0, 0, 4 * qb + 4, 0, mref, l, o0, o1);
                row_bcast(wsf, 1.0f / l, r32, hi, rl);
                f32x16 n0, n1;
#pragma unroll
                for (int r = 0; r < 16; ++r) { n0[r] = o0[r] * rl[r]; n1[r] = o1[r] * rl[r]; }
                attn_core<32, 0>(lds, tid, Qg + (size_t)T * 32, 32, Kg + (size_t)T * 32, 32, Vg, 64, nullptr, 0.f, q0, 0, 4 * qb + 4, 0, mref, l, o0, o1);
                row_bcast(wsf, 1.0f / l, r32, hi, rl);
                const float* sg = a.in[7] + (size_t)layer * 64;
                const float g0 = sg[r32] * (1.0f - lam_init), g1 = sg[32 + r32] * (1.0f - lam_init);
                bf16_t* Ob = O + (size_t)(b * T + q0 + 32 * wid) * DM + h * 64 + r32;
#pragma unroll
                for (int r = 0; r < 16; ++r) {
                    const float v0 = n0[r] - lam * (o0[r] * rl[r]), v1 = n1[r] - lam * (o1[r] * rl[r]);
                    float ss = v0 * v0 + v1 * v1;
                    ss += __shfl_xor(ss, 1); ss += __shfl_xor(ss, 2); ss += __shfl_xor(ss, 4); ss += __shfl_xor(ss, 8); ss += __shfl_xor(ss, 16);
                    const float rs = 1.0f / sqrtf(ss * (1.f / 64.f) + 1e-5f);
                    bf16_t* op = Ob + (size_t)crow(r, hi) * DM; op[0] = (bf16_t)f2bf(v0 * rs * g0); op[32] = (bf16_t)f2bf(v1 * rs * g1);
                }
            }
        } else {
            const int v = u - N_AC, k = v & 31, bhp = v >> 5, h = bhp % 6, b = (bhp / 6) % NB, p = bhp / (6 * NB);
            const int d = (p == 0) ? 1 : (p == 1) ? 4 : 16, bpc = 32 / d, cls = k / bpc, nb = k % bpc, q0 = nb * 256;
            const bf16_t* Qg = QKV + ((size_t)(b * NSLOT + 12 + h) * T + cls) * 64; const bf16_t* Kg = QKV + ((size_t)(b * NSLOT + 18 + h) * T + cls) * 64; const bf16_t* Vg = QKV + ((size_t)(b * NSLOT + 24 + h) * T + cls) * 64;
            const long rs_ = (long)d * 64;
            attn_core<64, 2>(lds, tid, Qg, rs_, Kg, rs_, Vg, rs_, nullptr, 0.f, q0, (nb == 0) ? 2 : 0, 6, q0 - 128, mref, l, o0, o1);
            row_bcast(wsf, 1.0f / l, r32, hi, rl);
            const size_t pb = ((size_t)(p * NB + b) * 6 + h) * T;
            if (hi == 0) LSEB[pb + cls + d * (q0 + 32 * wid + r32)] = mref + __log2f(l);
#pragma unroll
            for (int r = 0; r < 16; ++r) { bf16_t* op = OBP + (pb + cls + (size_t)d * (q0 + 32 * wid + crow(r, hi))) * 64 + r32; op[0] = (bf16_t)f2bf(o0[r] * rl[r]); op[32] = (bf16_t)f2bf(o1[r] * rl[r]); }
        }
    }
}

__device__ __forceinline__ void combine_phase(unsigned char* ws, int tid, int G) {
    const bf16_t* OBP = (const bf16_t*)(ws + WS_OBP); const float* LSEB = (const float*)(ws + WS_LSEB); bf16_t* O = (bf16_t*)(ws + WS_O);
    const size_t NI = (size_t)MROWS * 48, PS = (size_t)NB * 6 * T;
    for (size_t i = (size_t)blockIdx.x * 512 + tid; i < NI; i += (size_t)G * 512) {
        const int row = (int)(i / 48), rem = (int)(i % 48), h = rem >> 3, ch = rem & 7, b = row >> 13, t = row & (T - 1);
        const size_t e = ((size_t)b * 6 + h) * T + t;
        const float l0 = LSEB[e], l1 = LSEB[PS + e], l2 = LSEB[2 * PS + e];
        const float mx = fmaxf(l0, fmaxf(l1, l2));
        float w0 = __builtin_amdgcn_exp2f(l0 - mx), w1 = __builtin_amdgcn_exp2f(l1 - mx), w2 = __builtin_amdgcn_exp2f(l2 - mx);
        const float inv = 1.0f / (w0 + w1 + w2); w0 *= inv; w1 *= inv; w2 *= inv;
        const u32x4 a0 = *(const u32x4*)(OBP + e * 64 + ch * 8), a1 = *(const u32x4*)(OBP + (PS + e) * 64 + ch * 8), a2 = *(const u32x4*)(OBP + (2 * PS + e) * 64 + ch * 8);
        u32x4 o;
#pragma unroll
        for (int q = 0; q < 4; ++q) {
            const float x0 = w0 * bf2f((unsigned short)(a0[q] & 0xffffu)) + w1 * bf2f((unsigned short)(a1[q] & 0xffffu)) + w2 * bf2f((unsigned short)(a2[q] & 0xffffu));
            const float x1 = w0 * bf2f((unsigned short)(a0[q] >> 16)) + w1 * bf2f((unsigned short)(a1[q] >> 16)) + w2 * bf2f((unsigned short)(a2[q] >> 16));
            o[q] = pk2(x0, x1);
        }
        *(u32x4*)(O + (size_t)row * DM + 256 + h * 64 + ch * 8) = o;
    }
}
__device__ __forceinline__ void fix_phase(unsigned char* ws, const float* cw, const float* cb, int tid, int G) {
    const float* FIXU = (const float*)(ws + WS_FIX); const float* FIXG = FIXU + FIX_ELEMS; const float* FIXT = FIXG + FIX_ELEMS; bf16_t* ACT = (bf16_t*)(ws + WS_ACT);
    constexpr int F4 = DFF / 4; const int NI = 1024 * 2 * F4;
    for (int i = blockIdx.x * 512 + tid; i < NI; i += G * 512) {
        const int grp = i / (2 * F4), rem = i % (2 * F4), rr = rem / F4, f = (rem % F4) * 4;
        const int row = grp * 64 + rr, t = row & (T - 1);
        const f32x4 g0 = *(const f32x4*)(FIXG + ((size_t)grp * 2 + rr) * DFF + f), uu = *(const f32x4*)(FIXU + ((size_t)grp * 2 + rr) * DFF + f);
        f32x4 gm1 = (f32x4){0.f, 0.f, 0.f, 0.f}, gm2 = gm1;
        if (rr == 0) { if (t >= 1) gm1 = *(const f32x4*)(FIXT + ((size_t)(grp - 1) * 2 + 1) * DFF + f); if (t >= 2) gm2 = *(const f32x4*)(FIXT + ((size_t)(grp - 1) * 2 + 0) * DFF + f); }
        else { gm1 = *(const f32x4*)(FIXG + ((size_t)grp * 2 + 0) * DFF + f); if (t >= 2) gm2 = *(const f32x4*)(FIXT + ((size_t)(grp - 1) * 2 + 1) * DFF + f); }
        const f32x4 w0 = *(const f32x4*)(cw + f), w1 = *(const f32x4*)(cw + DFF + f), w2 = *(const f32x4*)(cw + 2 * DFF + f), bb = *(const f32x4*)(cb + f);
        float av[4];
#pragma unroll
        for (int q = 0; q < 4; ++q) { const float y = bb[q] + w0[q] * gm2[q] + w1[q] * gm1[q] + w2[q] * g0[q]; av[q] = y * __builtin_amdgcn_rcpf(1.f + __expf(-y)) * uu[q]; }
        *(unsigned long long*)(ACT + (size_t)row * DFF + f) = (unsigned long long)pk2(av[0], av[1]) | ((unsigned long long)pk2(av[2], av[3]) << 32);
    }
}

__global__ void __launch_bounds__(512, 2) fwd_mega(Args a) {
    extern __shared__ __attribute__((aligned(16))) unsigned char lds[];
    cg::grid_group grid = cg::this_grid();
    const int tid0 = threadIdx.x, G = gridDim.x;
#define LAUNDER_TID() int tid = tid0; asm volatile("" : "+v"(tid))
    unsigned char* ws = a.ws;
    PG8_LAS unsigned char* ldsl = (PG8_LAS unsigned char*)lds;
    bf16_t* H = (bf16_t*)(ws + WS_H);
    float* MOD = (float*)(ws + WS_MOD);
    unsigned* ctl = (unsigned*)(ws + WS_CTL);

#ifndef SK_PRO
    { LAUNDER_TID(); prologue(a, lds, tid, G); }
#endif
    grid.sync();
#pragma unroll 1
    for (int layer = 0; layer < DEPTH; ++layer) {
        const float* xin = (layer == 0) ? a.in[0] : a.out;
        const float* modl = MOD + (size_t)layer * NB * NMOD;
        const bf16_t* WT = (const bf16_t*)(ws + WS_WT) + (size_t)layer * WL_ELEMS;
#ifndef SK_N1
        { LAUNDER_TID(); norm_phase<true>(xin, H, a.in[4] + (size_t)layer * DM, modl, 0, DM, (const float*)(ws + WS_WFZ) + (size_t)layer * 6 * DM, a.in[8] + (size_t)layer * 6, (float*)(ws + WS_LOGF), tid, G); }
#endif
        grid.sync();
#ifndef SK_SCAN
        { LAUNDER_TID(); scan_phase((float*)(ws + WS_LOGF), lds, tid, G); }
#endif
        __syncthreads();
#ifndef SK_GIN
        { pg8::Gemm g{H, WT + WL_IN, MROWS, NIN, DM}; pg8::StaticOrder S; S.init(MROWS, NIN, G, (int)blockIdx.x);
          pg8::EpiIn E{(bf16_t*)(ws + WS_QKV), (const float*)(ws + WS_ROPEA), (const float*)(ws + WS_ROPEB)};
          pg8::gemm_phase<pg8::EpiIn, pg8::StaticOrder, true, true>(ldsl, g, S, E); }
#endif
        grid.sync();
#ifndef SK_ATT
        { LAUNDER_TID(); attn_phase(a, lds, tid, layer, ctl + 64 * (1 + layer)); }
#endif
        grid.sync();
#ifndef SK_CMB
        { LAUNDER_TID(); combine_phase(ws, tid, G); }
#endif
        grid.sync();
#ifndef SK_GOUT
        { pg8::Gemm g{(const bf16_t*)(ws + WS_O), WT + WL_OUT, MROWS, DM, DM}; pg8::StaticOrder S; S.init(MROWS, DM, G, (int)blockIdx.x);
          pg8::EpiRes E{xin, a.out, modl + 2 * DM};
          pg8::gemm_phase<pg8::EpiRes, pg8::StaticOrder, true, true>(ldsl, g, S, E); }
#endif
        grid.sync();
#ifndef SK_N2
        { LAUNDER_TID(); norm_phase<false>(a.out, H, a.in[10] + (size_t)layer * DM, modl, 3 * DM, 4 * DM, nullptr, nullptr, nullptr, tid, G); }
#endif
        grid.sync();
#ifndef SK_GUP
        { pg8::Gemm g{H, WT + WL_UP, MROWS, NUP, DM}; pg8::StaticOrder S; S.init(MROWS, NUP, G, (int)blockIdx.x);
          float* FX = (float*)(ws + WS_FIX);
          pg8::EpiUp E{(bf16_t*)(ws + WS_ACT), FX, FX + FIX_ELEMS, FX + 2 * FIX_ELEMS, a.in[12] + (size_t)layer * 3 * DFF, a.in[13] + (size_t)layer * DFF};
          pg8::gemm_phase<pg8::EpiUp, pg8::StaticOrder, true, true>(ldsl, g, S, E); }
#endif
        grid.sync();
#ifndef SK_FIX
        { LAUNDER_TID(); fix_phase(ws, a.in[12] + (size_t)layer * 3 * DFF, a.in[13] + (size_t)layer * DFF, tid, G); }
#endif
        grid.sync();
#ifndef SK_GDN
        { pg8::Gemm g{(const bf16_t*)(ws + WS_ACT), WT + WL_DN, MROWS, DM, DFF}; pg8::StaticOrder S; S.init(MROWS, DM, G, (int)blockIdx.x);
          pg8::EpiRes E{a.out, a.out, modl + 5 * DM};
          pg8::gemm_phase<pg8::EpiRes, pg8::StaticOrder, true, true>(ldsl, g, S, E); }
#endif
        grid.sync();
    }
    { LAUNDER_TID(); final_norm(a.out, a.in[15], tid, G); }
}

extern "C" void kernel_launch(void* const* d_in, const int* in_sizes, int n_in, void* d_out, int out_size, void* d_ws, size_t ws_size, hipStream_t stream) {
    static int grid = 0;
    if (grid == 0) {
        if (n_in != 16 || ws_size < WS_END) { fprintf(stderr, "kernel_launch: unexpected inputs (n_in %d, ws %zu)\n", n_in, ws_size); grid = -1; return; }
        int dev = 0, cus = 0, per_cu = 0;
        hipGetDevice(&dev);
        hipDeviceGetAttribute(&cus, hipDeviceAttributeMultiprocessorCount, dev);
        hipFuncSetAttribute((const void*)fwd_mega, hipFuncAttributeMaxDynamicSharedMemorySize, LDS_BYTES);
        hipOccupancyMaxActiveBlocksPerMultiprocessor(&per_cu, (const void*)fwd_mega, 512, LDS_BYTES);
        if (per_cu < 1) per_cu = 1;
        (void)hipGetLastError();
        grid = cus * per_cu;
    }
    if (grid < 0) return;
    hipMemsetAsync((char*)d_ws + WS_CTL, 0, CTL_BYTES, stream);
    Args a{};
    for (int i = 0; i < 16; ++i) a.in[i] = (const float*)d_in[i];
    a.out = (float*)d_out; a.ws = (unsigned char*)d_ws;
    void* args[] = {&a};
    hipError_t e = hipLaunchCooperativeKernel((const void*)fwd_mega, dim3(grid), dim3(512), args, LDS_BYTES, stream);
    if (e != hipSuccess) fprintf(stderr, "cooperative launch failed: %s (grid %d)\n", hipGetErrorString(e), grid);
}
```

```cpp
#include <hip/hip_runtime.h>
#include <hip/hip_cooperative_groups.h>
#include <cstdio>
#include <cstdint>
namespace cg = cooperative_groups;
namespace pg8 {
#define PG8_LAS __attribute__((address_space(3)))
typedef unsigned short bf16_t;
typedef short bf16x8 __attribute__((ext_vector_type(8)));
typedef float f32x4 __attribute__((ext_vector_type(4)));
typedef unsigned u32x4 __attribute__((ext_vector_type(4)));
constexpr int BM = 256, BK = 64, HALF = 128, HTB = HALF * BK * 2  , STAGE_BYTES = 8 * HTB, NXCD = 8, WGM = 8;

__host__ __device__ __forceinline__ int lds_byte(int r, int c) { const int st = (r >> 4) * 2 + (c >> 5), rr = r & 15, cc = c & 31, ob = rr * 64 + cc * 2; return st * 1024 + (ob ^ (((ob >> 9) & 1) << 5)); }
__host__ __device__ __forceinline__ void stage_rc(int b, int& R, int& C) { const int st = b / 1024, sb = b % 1024, swz = sb ^ (((sb >> 9) & 1) << 5); R = (st >> 1) * 16 + swz / 64; C = (st & 1) * 32 + (swz % 64) / 2; }
__host__ __device__ __forceinline__ int perm32(int rho) { const int n = rho >> 4, i = rho & 15; return 8 * (i >> 2) + 4 * n + (i & 3); }

struct Unit { int pm, pn; };
struct Gemm { const bf16_t* A; const bf16_t* Bt; int M, N, K; };

struct StaticOrder {
    int nM, nN, nwg, G, c;
    __host__ __device__ void init(int M, int N, int G_, int c_) { nM = M / BM; nN = N / BM; nwg = nM * nN; G = G_; c = c_; }
    __host__ __device__ bool next(int i, Unit& u) const {
        const long L = (long)i * G + c; if (L >= nwg) return false;
        int wgid = (int)L; { const int q = nwg / NXCD, r = nwg % NXCD, xcd = wgid % NXCD, off = wgid / NXCD; wgid = (xcd < r ? xcd * (q + 1) : r * (q + 1) + (xcd - r) * q) + off; }
        const int nig = WGM * nN, gid = wgid / nig, fm = gid * WGM, gsz = (nM - fm) < WGM ? (nM - fm) : WGM;
        u.pm = fm + ((wgid % nig) % gsz); u.pn = (wgid % nig) / gsz; return true;
    }
    __device__ __forceinline__ void a_ready(const Unit&) const {}
    __device__ __forceinline__ void done(const Unit&) const {}
};

__device__ __forceinline__ unsigned cvt_pk_bf16(float lo, float hi) { unsigned r; asm volatile("v_cvt_pk_bf16_f32 %0, %1, %2" : "=v"(r) : "v"(lo), "v"(hi)); return r; }
template <class Epi, class Sched, bool ALIGN_EPI = false, bool SP2 = false>
__device__ __forceinline__ void gemm_phase(PG8_LAS unsigned char* lds, const Gemm g, const Sched& S, const Epi& E) {
    int tid_l = threadIdx.x; asm volatile("" : "+v"(tid_l));
    const int tid = tid_l, wid = __builtin_amdgcn_readfirstlane(tid >> 6), lane = tid & 63, wr = wid >> 2, wc = wid & 3, fr = lane & 15, fq = lane >> 4;
    const int K = g.K, nt = K / BK;
    unsigned voffA[2], voffB[2];
#pragma unroll
    for (int i = 0; i < 2; ++i) { int R, C; stage_rc(tid * 16 + i * 8192, R, C); const int Rb = Epi::PERM ? ((R & ~31) + perm32(R & 31)) : R;
        voffA[i] = (unsigned)(R * K + C) * 2u; voffB[i] = (unsigned)(Rb * K + C) * 2u; }
    const size_t kstep = (size_t)(BK * 2);
    const size_t hstep = (size_t)HALF * K * 2;
    const size_t tstep = 2 * hstep;
    const unsigned ldsw = (unsigned)wid * 1024u;
    const int aoff = lds_byte(wr * 64 + fr, fq * 8), boff = lds_byte(wc * 32 + fr, fq * 8);
#define PG8_SA(b, h) (((b) * 2 + (h)) * HTB)
#define PG8_SB(b, h) ((4 + (b) * 2 + (h)) * HTB)
#define PG8_STAGE(bufoff, gbase, voff) do { _Pragma("unroll") for (int _i = 0; _i < 2; ++_i) \
        __builtin_amdgcn_global_load_lds((const unsigned*)((const char*)(gbase) + (voff)[_i]), (PG8_LAS unsigned*)(lds + (bufoff) + ldsw + _i * 8192), 16, 0, 0); } while (0)
#define PG8_LDA(dst, b, h) do { _Pragma("unroll") for (int m = 0; m < 4; ++m) _Pragma("unroll") for (int k = 0; k < 2; ++k) dst[m][k] = *(const PG8_LAS bf16x8*)(lds + PG8_SA(b, h) + aoff + m * 2048 + k * 1024); } while (0)
#define PG8_LDB(dst, b, h) do { _Pragma("unroll") for (int n = 0; n < 2; ++n) _Pragma("unroll") for (int k = 0; k < 2; ++k) dst[n][k] = *(const PG8_LAS bf16x8*)(lds + PG8_SB(b, h) + boff + n * 2048 + k * 1024); } while (0)
#define PG8_MMA(ai, bj, At, Bt) do { __builtin_amdgcn_s_setprio(1); _Pragma("unroll") for (int m = 0; m < 4; ++m) _Pragma("unroll") for (int n = 0; n < 2; ++n) _Pragma("unroll") for (int k = 0; k < 2; ++k) \
        acc[ai][bj][m][n] = __builtin_amdgcn_mfma_f32_16x16x32_bf16(Bt[n][k], At[m][k], acc[ai][bj][m][n], 0, 0, 0); __builtin_amdgcn_s_setprio(0); } while (0)
#define PG8_WAIT_V(n) asm volatile("s_waitcnt vmcnt(" #n ")" ::: "memory")
#define PG8_WAIT_L(n) asm volatile("s_waitcnt lgkmcnt(" #n ")" ::: "memory")
#define PG8_BAR __builtin_amdgcn_s_barrier()
#define PG8_SCHED __builtin_amdgcn_sched_barrier(0)
    Unit cur, nxt; int ui = 0;
    if (!S.next(0, cur)) return;
    f32x4 acc[2][2][4][2];
#pragma unroll
    for (int a = 0; a < 2; ++a)
#pragma unroll
        for (int b = 0; b < 2; ++b)
#pragma unroll
            for (int m = 0; m < 4; ++m)
#pragma unroll
                for (int n = 0; n < 2; ++n) acc[a][b][m][n] = (f32x4){0.f, 0.f, 0.f, 0.f};
    bf16x8 At[4][2], B0[2][2], B1[2][2];
    const char* cA = (const char*)g.A + (size_t)cur.pm * tstep; const char* cB = (const char*)g.Bt + (size_t)cur.pn * tstep;
    S.a_ready(cur);
    if constexpr (SP2) {
        PG8_STAGE(PG8_SB(0, 0), cB, voffB); PG8_STAGE(PG8_SB(0, 1), cB + hstep, voffB); PG8_STAGE(PG8_SA(0, 0), cA, voffA); PG8_STAGE(PG8_SA(0, 1), cA + hstep, voffA);
        if (wr == 1) PG8_BAR;
        PG8_WAIT_V(2); PG8_BAR;
        PG8_STAGE(PG8_SB(1, 0), cB + kstep, voffB); PG8_STAGE(PG8_SA(1, 0), cA + kstep, voffA); PG8_STAGE(PG8_SB(1, 1), cB + hstep + kstep, voffB);
        PG8_WAIT_V(6); PG8_BAR;
    } else {
        PG8_STAGE(PG8_SB(0, 0), cB, voffB); PG8_STAGE(PG8_SA(0, 0), cA, voffA); PG8_STAGE(PG8_SB(0, 1), cB + hstep, voffB); PG8_STAGE(PG8_SA(0, 1), cA + hstep, voffA);
        if (wr == 1) PG8_BAR;
        PG8_WAIT_V(4); PG8_BAR;
        PG8_STAGE(PG8_SB(1, 0), cB + kstep, voffB); PG8_STAGE(PG8_SA(1, 0), cA + kstep, voffA); PG8_STAGE(PG8_SB(1, 1), cB + hstep + kstep, voffB);
        PG8_WAIT_V(6); PG8_BAR;
    }
    for (;;) {
        const bool has_next = S.next(ui + 1, nxt);
        const char* nA = has_next ? (const char*)g.A + (size_t)nxt.pm * tstep : cA; const char* nB = has_next ? (const char*)g.Bt + (size_t)nxt.pn * tstep : cB;
        for (int t = 0; t < nt; t += 2) {
            const bool last = (t == nt - 2);
            const char* a1 = cA + (size_t)(t + 1) * kstep;
            const char* a2 = last ? nA : cA + (size_t)(t + 2) * kstep; const char* b2 = last ? nB : cB + (size_t)(t + 2) * kstep;
            const char* a3 = a2 + kstep; const char* b3 = b2 + kstep;
            if (last && has_next) S.a_ready(nxt);
            if constexpr (SP2) {
            PG8_LDB(B0, 0, 0); PG8_LDB(B1, 0, 1); PG8_SCHED; PG8_LDA(At, 0, 0); PG8_STAGE(PG8_SA(1, 1), a1 + hstep, voffA);
            PG8_WAIT_V(8); PG8_WAIT_L(0); PG8_BAR; PG8_MMA(0, 0, At, B0); PG8_MMA(0, 1, At, B1); PG8_BAR; PG8_SCHED;
            PG8_LDA(At, 0, 1); PG8_STAGE(PG8_SB(0, 0), b2, voffB); PG8_STAGE(PG8_SB(0, 1), b2 + hstep, voffB); PG8_STAGE(PG8_SA(0, 0), a2, voffA);
            PG8_WAIT_V(8); PG8_WAIT_L(0); PG8_BAR; PG8_MMA(1, 0, At, B0); PG8_MMA(1, 1, At, B1); PG8_BAR; PG8_SCHED;
            PG8_LDB(B0, 1, 0); PG8_LDB(B1, 1, 1); PG8_SCHED; PG8_LDA(At, 1, 0); PG8_STAGE(PG8_SA(0, 1), a2 + hstep, voffA);
            PG8_WAIT_V(8); PG8_WAIT_L(0); PG8_BAR; PG8_MMA(0, 0, At, B0); PG8_MMA(0, 1, At, B1); PG8_BAR; PG8_SCHED;
            PG8_LDA(At, 1, 1); PG8_STAGE(PG8_SB(1, 0), b3, voffB); PG8_STAGE(PG8_SB(1, 1), b3 + hstep, voffB); PG8_STAGE(PG8_SA(1, 0), a3, voffA);
            PG8_WAIT_V(8); PG8_WAIT_L(0); PG8_BAR; PG8_MMA(1, 0, At, B0); PG8_MMA(1, 1, At, B1); PG8_BAR; PG8_SCHED;
            } else {
            PG8_LDB(B0, 0, 0); PG8_SCHED; PG8_LDA(At, 0, 0); PG8_STAGE(PG8_SA(1, 1), a1 + hstep, voffA);
            PG8_WAIT_L(8); PG8_BAR; PG8_WAIT_L(0); PG8_MMA(0, 0, At, B0); PG8_BAR; PG8_SCHED;
            PG8_LDB(B1, 0, 1); PG8_STAGE(PG8_SB(0, 0), b2, voffB);
            PG8_BAR; PG8_WAIT_L(0); PG8_MMA(0, 1, At, B1); PG8_BAR;
            PG8_LDA(At, 0, 1); PG8_STAGE(PG8_SA(0, 0), a2, voffA);
            PG8_BAR; PG8_WAIT_L(0); PG8_MMA(1, 0, At, B0); PG8_BAR; PG8_SCHED;
            PG8_STAGE(PG8_SB(0, 1), b2 + hstep, voffB);
            PG8_WAIT_V(6); PG8_BAR; PG8_MMA(1, 1, At, B1); PG8_BAR;
            PG8_LDB(B0, 1, 0); PG8_SCHED; PG8_LDA(At, 1, 0); PG8_STAGE(PG8_SA(0, 1), a2 + hstep, voffA);
            PG8_WAIT_L(8); PG8_BAR; PG8_WAIT_L(0); PG8_MMA(0, 0, At, B0); PG8_BAR; PG8_SCHED;
            PG8_LDB(B1, 1, 1); PG8_STAGE(PG8_SB(1, 0), b3, voffB);
            PG8_BAR; PG8_WAIT_L(0); PG8_MMA(0, 1, At, B1); PG8_BAR;
            PG8_LDA(At, 1, 1); PG8_STAGE(PG8_SA(1, 0), a3, voffA);
            PG8_BAR; PG8_WAIT_L(0); PG8_MMA(1, 0, At, B0); PG8_BAR; PG8_SCHED;
            PG8_STAGE(PG8_SB(1, 1), b3 + hstep, voffB);
            PG8_WAIT_V(6); PG8_BAR; PG8_MMA(1, 1, At, B1); PG8_BAR;
            }
        }
        if constexpr (ALIGN_EPI) { if (wr == 0) PG8_BAR; }
        if constexpr (!Epi::AFTER_DRAIN) { E(acc, cur, wr, wc, fr, fq); S.done(cur); }
        if (!has_next) break;
#pragma unroll
        for (int a = 0; a < 2; ++a)
#pragma unroll
            for (int b = 0; b < 2; ++b)
#pragma unroll
                for (int m = 0; m < 4; ++m)
#pragma unroll
                    for (int n = 0; n < 2; ++n) acc[a][b][m][n] = (f32x4){0.f, 0.f, 0.f, 0.f};
        cur = nxt; cA = nA; cB = nB; ++ui;
        if constexpr (ALIGN_EPI) { if (wr == 1) PG8_BAR; }
    }
    PG8_WAIT_V(0);
    if constexpr (!ALIGN_EPI) { if (wr == 0) PG8_BAR; }
    PG8_BAR;
    if constexpr (Epi::AFTER_DRAIN) { E.fused(acc, cur, wr, wc, fr, fq, lds, wid, lane); S.done(cur); }
#undef PG8_SA
#undef PG8_SB
#undef PG8_STAGE
#undef PG8_LDA
#undef PG8_LDB
#undef PG8_MMA
#undef PG8_WAIT_V
#undef PG8_WAIT_L
#undef PG8_BAR
#undef PG8_SCHED
}
}

using pg8::bf16_t; using pg8::f32x4; using pg8::u32x4; using pg8::bf16x8;
typedef float f32x16 __attribute__((ext_vector_type(16)));
typedef short v4i16_t __attribute__((ext_vector_type(4)));
#define LAS __attribute__((address_space(3)))

constexpr int NB = 8, T = 8192, DM = 1024, DEPTH = 4, MROWS = NB * T;
constexpr int INC = 3078, NIN = 3072, DFF = 2816, NUP = 5632, NSLOT = 48, NMOD = 6 * DM;
constexpr float LOG2E = 1.4426950408889634f;
constexpr float QSC_A = 0.17677669529663687f * LOG2E;
constexpr float QSC_B = 0.125f * LOG2E;

constexpr size_t MiB = 1u << 20;
constexpr size_t WS_CTL = 0, CTL_BYTES = 1 * MiB;
constexpr size_t WS_WT = 2 * MiB;
constexpr size_t WL_IN = 0, WL_OUT = (size_t)NIN * DM, WL_UP = WL_OUT + (size_t)DM * DM, WL_DN = WL_UP + (size_t)NUP * DM, WL_ELEMS = WL_DN + (size_t)DM * DFF;
constexpr size_t WS_MOD = 102 * MiB;
constexpr size_t WS_ROPEA = 103 * MiB;
constexpr size_t WS_ROPEB = 104 * MiB;
constexpr size_t WS_WFZ = 106 * MiB;
constexpr size_t WS_LOGF = 107 * MiB;
constexpr size_t WS_LSEB = 109 * MiB;
constexpr size_t WS_XB = 116 * MiB;
constexpr size_t WS_H = 628 * MiB;
constexpr size_t WS_QKV = 244 * MiB;
constexpr size_t WS_ACT = WS_QKV;
constexpr size_t WS_O = 628 * MiB;
constexpr size_t WS_OBP = 756 * MiB;
constexpr size_t WS_FIX = WS_OBP;
constexpr size_t FIX_ELEMS = (size_t)1024 * 2 * DFF;
constexpr size_t WS_SSQ = 114 * MiB;
constexpr size_t WS_XA = 822 * MiB;
constexpr size_t WS_CUP = 950 * MiB;
constexpr size_t WS_END = 952 * MiB;
static_assert(WS_WT + WL_ELEMS * 2 * DEPTH <= WS_MOD, "weights fit");
static_assert(WS_FIX + 3 * FIX_ELEMS * 4 <= WS_XA && WS_XA + (size_t)65536 * 1024 * 2 <= WS_CUP, "fix / xa fit");

constexpr int LDS_BYTES = 147456;
constexpr int MISC_OFF = 131072;
constexpr int AT_K = 0, AT_V = 8192, AT_BIAS = 16384, AT_BUF = 17408, AT_WS = 2 * AT_BUF, AT_Q = AT_WS + 2048, AT_STASH = AT_Q + 32768;

struct Args { const float* in[16]; float* out; unsigned char* ws; };

__device__ __forceinline__ unsigned f2bf(float f) { unsigned u = __builtin_bit_cast(unsigned, f); return (u + 0x7fffu + ((u >> 16) & 1u)) >> 16; }
__device__ __forceinline__ unsigned pk2(float lo, float hi) { return f2bf(lo) | (f2bf(hi) << 16); }
__device__ __forceinline__ float bf2f(unsigned short h) { return __builtin_bit_cast(float, (unsigned)h << 16); }
typedef _Float16 h16x2 __attribute__((ext_vector_type(2))); typedef float f32x2v __attribute__((ext_vector_type(2)));
__device__ __forceinline__ unsigned f2h2(float lo, float hi) { const f32x2v v = {lo, hi}; const h16x2 h = __builtin_convertvector(v, h16x2); return __builtin_bit_cast(unsigned, h); }
__device__ __forceinline__ f32x2v h2f2(unsigned w) { const h16x2 h = __builtin_bit_cast(h16x2, w); return __builtin_convertvector(h, f32x2v); }
__device__ __forceinline__ float wave_sum(float v) {
#pragma unroll
    for (int o = 1; o < 64; o <<= 1) v += __shfl_xor(v, o);
    return v;
}
#define LDS_FENCE() asm volatile("s_waitcnt lgkmcnt(0)" ::: "memory")

namespace pg8 {
struct EpiIn {
    static constexpr bool PERM = true, AFTER_DRAIN = false;
    bf16_t* QKV; const float* ropeA; const float* ropeB;
    __device__ __forceinline__ void operator()(const f32x4 (&acc)[2][2][4][2], const Unit& u, int wr, int wc, int fr, int fq) const {
#pragma unroll
        for (int bj = 0; bj < 2; ++bj) {
            const int slot = 4 * u.pn + 2 * bj + (wc >> 1);
            const int c0 = 32 * (wc & 1) + 8 * fq;
            int kind = 0; float sc = 1.f;
            if (slot < 8) { kind = 1; if (slot < 4) sc = QSC_A; }
            else if (slot >= 12 && slot < 24) { kind = 2; if (slot < 18) sc = QSC_B; }
            else if (slot >= 30 && slot < 36) sc = QSC_B;
#pragma unroll
            for (int ai = 0; ai < 2; ++ai)
#pragma unroll
                for (int m = 0; m < 4; ++m) {
                    const int row = u.pm * BM + ai * HALF + wr * 64 + m * 16 + fr, b = row >> 13, t = row & (T - 1);
                    f32x4 v0 = acc[ai][bj][m][0], v1 = acc[ai][bj][m][1];
                    if (kind) {
                        const float* tb = (kind == 1) ? ropeA + ((size_t)t * 16 + 4 * fq) * 2 : ropeB + ((size_t)t * 32 + 16 * (wc & 1) + 4 * fq) * 2;
                        const f32x4 c01 = *(const f32x4*)tb, c23 = *(const f32x4*)(tb + 4);
                        f32x4 w0, w1;
                        w0[0] = v0[0] * c01[0] - v0[1] * c01[1]; w0[1] = v0[1] * c01[0] + v0[0] * c01[1];
                        w0[2] = v0[2] * c01[2] - v0[3] * c01[3]; w0[3] = v0[3] * c01[2] + v0[2] * c01[3];
                        w1[0] = v1[0] * c23[0] - v1[1] * c23[1]; w1[1] = v1[1] * c23[0] + v1[0] * c23[1];
                        w1[2] = v1[2] * c23[2] - v1[3] * c23[3]; w1[3] = v1[3] * c23[2] + v1[2] * c23[3];
                        v0 = w0; v1 = w1;
                    }
                    v0 = v0 * sc; v1 = v1 * sc;
                    u32x4 w; w.x = cvt_pk_bf16(v0[0], v0[1]); w.y = cvt_pk_bf16(v0[2], v0[3]); w.z = cvt_pk_bf16(v1[0], v1[1]); w.w = cvt_pk_bf16(v1[2], v1[3]);
                    const size_t sb = (size_t)(b * NSLOT + slot) * T * 64;
                    const size_t off = (kind == 1) ? sb + (size_t)(wc & 1) * T * 32 + (size_t)t * 32 + 8 * fq : sb + (size_t)t * 64 + c0;
                    __builtin_nontemporal_store(w, (u32x4*)(QKV + off));
                }
        }
    }
};
template <bool NORM> struct EpiRes {
    static constexpr bool PERM = true, AFTER_DRAIN = false;
    const bf16_t* bh; bf16_t* xo; const float* gate;
    bf16_t* XA; unsigned long long* ssq; const float* gnorm; const float* scale;
    __device__ __forceinline__ void operator()(const f32x4 (&acc)[2][2][4][2], const Unit& u, int wr, int wc, int fr, int fq) const {
        const int b = (u.pm * BM) >> 13;
        float sq[2][4];
#pragma unroll
        for (int ai = 0; ai < 2; ++ai)
#pragma unroll
            for (int m = 0; m < 4; ++m) sq[ai][m] = 0.f;
#pragma unroll
        for (int bj = 0; bj < 2; ++bj) {
            const int col = u.pn * BM + bj * HALF + wc * 32 + 8 * fq;
            const f32x4 g0 = *(const f32x4*)(gate + (size_t)b * NMOD + col), g1 = *(const f32x4*)(gate + (size_t)b * NMOD + col + 4);
            f32x4 a0 = (f32x4){0.f, 0.f, 0.f, 0.f}, a1 = a0;
            if (NORM) { a0 = *(const f32x4*)(gnorm + col) * (*(const f32x4*)(scale + (size_t)b * NMOD + col) + 1.0f); a1 = *(const f32x4*)(gnorm + col + 4) * (*(const f32x4*)(scale + (size_t)b * NMOD + col + 4) + 1.0f); }
#pragma unroll
            for (int ai = 0; ai < 2; ++ai)
#pragma unroll
                for (int m = 0; m < 4; ++m) {
                    const size_t off = (size_t)(u.pm * BM + ai * HALF + wr * 64 + m * 16 + fr) * DM + col;
                    const u32x4 r = *(const u32x4*)(bh + off);
                    const f32x2v q0 = h2f2(r.x), q1 = h2f2(r.y), q2 = h2f2(r.z), q3 = h2f2(r.w);
                    const f32x4 x0 = (f32x4){q0[0], q0[1], q1[0], q1[1]}, x1 = (f32x4){q2[0], q2[1], q3[0], q3[1]};
                    const f32x4 y0 = x0 + g0 * acc[ai][bj][m][0], y1 = x1 + g1 * acc[ai][bj][m][1];
                    { u32x4 w; w.x = f2h2(y0[0], y0[1]); w.y = f2h2(y0[2], y0[3]); w.z = f2h2(y1[0], y1[1]); w.w = f2h2(y1[2], y1[3]); *(u32x4*)(xo + off) = w; }
                    if (NORM) {
                        sq[ai][m] += ((y0[0] * y0[0] + y0[1] * y0[1]) + (y0[2] * y0[2] + y0[3] * y0[3])) + ((y1[0] * y1[0] + y1[1] * y1[1]) + (y1[2] * y1[2] + y1[3] * y1[3]));
                        const f32x4 z0 = y0 * a0, z1 = y1 * a1;
                        u32x4 w; w.x = cvt_pk_bf16(z0[0], z0[1]); w.y = cvt_pk_bf16(z0[2], z0[3]); w.z = cvt_pk_bf16(z1[0], z1[1]); w.w = cvt_pk_bf16(z1[2], z1[3]);
                        { const int row = u.pm * BM + ai * HALF + wr * 64 + m * 16 + fr;
                          const int prow = (row & ~63) | (16 * (row & 3) + ((row >> 2) & 15));
                          *(u32x4*)(XA + (size_t)prow * DM + col) = w; }
                    }
                }
        }
        if (NORM) {
#pragma unroll
            for (int ai = 0; ai < 2; ++ai)
#pragma unroll
                for (int m = 0; m < 4; ++m) {
                    float s = sq[ai][m]; s += __shfl_xor(s, 16); s += __shfl_xor(s, 32);
                    if (fq == 0) atomicAdd(ssq + (u.pm * BM + ai * HALF + wr * 64 + m * 16 + fr), (unsigned long long)(s * 16777216.f));
                }
        }
    }
};
struct EpiUp {
    static constexpr bool PERM = true, AFTER_DRAIN = false;
    bf16_t* ACT; unsigned char* FIXP; unsigned char* FIXT2; const float* cw; const float* cb; const unsigned long long* ssq; const float* cup;
    __device__ __forceinline__ void operator()(const f32x4 (&acc)[2][2][4][2], const Unit& u, int wr, int wc, int fr, int fq) const {
        const int lane = fq * 16 + fr;
        const int srcp = (lane & 48) | ((fr - 1) & 15);
        const float* cp = cup + (size_t)((u.pm * BM) >> 13) * NUP + u.pn * BM + wc * 32 + 8 * fq;
        f32x4 rsv[2];
#pragma unroll
        for (int ai = 0; ai < 2; ++ai) { const unsigned long long* sp = ssq + u.pm * BM + ai * HALF + wr * 64 + 4 * fr;
#pragma unroll
            for (int i = 0; i < 4; ++i) rsv[ai][i] = 1.0f / sqrtf((float)sp[i] * (1.f / (16777216.f * DM)) + 1e-6f); }
        unsigned long long keep[2][4];
#pragma unroll
        for (int hh = 0; hh < 2; ++hh) {
            const int f0 = u.pn * HALF + wc * 32 + 8 * fq + 4 * hh;
            const f32x4 w0 = *(const f32x4*)(cw + f0), w1 = *(const f32x4*)(cw + DFF + f0), w2 = *(const f32x4*)(cw + 2 * DFF + f0), bb = *(const f32x4*)(cb + f0);
            const f32x4 cu = *(const f32x4*)(cp + 4 * hh), cg = *(const f32x4*)(cp + HALF + 4 * hh);
#pragma unroll
            for (int ai = 0; ai < 2; ++ai) {
                const int tok0 = u.pm * BM + ai * HALF + wr * 64, grp = tok0 >> 6;
                f32x4 g[4], uu[4], pv3, pv2;
#pragma unroll
                for (int m = 0; m < 4; ++m) { g[m] = acc[ai][1][m][hh] * rsv[ai][m] + cg; uu[m] = acc[ai][0][m][hh] * rsv[ai][m] + cu; }
#pragma unroll
                for (int e = 0; e < 4; ++e) { pv3[e] = __shfl(g[3][e], srcp); pv2[e] = __shfl(g[2][e], srcp); }
#pragma unroll
                for (int j = 0; j < 2; ++j) {
                    const bool isT = (fr == 15);
                    const f32x4 sa = isT ? g[j + 2] : uu[j], sb = g[j];
                    u32x4 w; w.x = cvt_pk_bf16(sa[0], sa[1]); w.y = cvt_pk_bf16(sa[2], sa[3]); w.z = cvt_pk_bf16(sb[0], sb[1]); w.w = cvt_pk_bf16(sb[2], sb[3]);
                    unsigned char* dst = (isT ? FIXT2 : FIXP) + (((size_t)grp * 2 + j) * DFF + f0) * 4;
                    if (fr == 0 || fr == 15) *(u32x4*)dst = w;
                }
#pragma unroll
                for (int m = 0; m < 4; ++m) {
                    const f32x4 gm1 = (m == 0) ? pv3 : g[(m + 3) & 3], gm2 = (m == 0) ? pv2 : (m == 1) ? pv3 : g[(m + 2) & 3];
                    f32x4 av;
#pragma unroll
                    for (int e = 0; e < 4; ++e) {
                        const float y = bb[e] + w0[e] * gm2[e] + w1[e] * gm1[e] + w2[e] * g[m][e];
                        av[e] = y * __builtin_amdgcn_rcpf(1.f + __expf(-y)) * uu[m][e];
                    }
                    const int row = tok0 + 4 * fr + m;
                    const bool fixrow = (fr == 0) && (m < 2);
                    const unsigned long long pk = (unsigned long long)cvt_pk_bf16(av[0], av[1]) | ((unsigned long long)cvt_pk_bf16(av[2], av[3]) << 32);
                    if (hh == 0) keep[ai][m] = pk;
                    else if (!fixrow) { u32x4 w; w.x = (unsigned)keep[ai][m]; w.y = (unsigned)(keep[ai][m] >> 32); w.z = (unsigned)pk; w.w = (unsigned)(pk >> 32); __builtin_nontemporal_store(w, (u32x4*)(ACT + (size_t)row * DFF + f0 - 4)); }
                }
            }
        }
    }
};
}

template <int MAPK> __device__ __forceinline__ int colmap(int n) {
    if (MAPK == 1) {
        const int slot = n >> 6, c = n & 63;
        if (slot < 8) { const int m = c >> 5, cc = c & 31; return slot * 64 + m * 32 + ((cc & 1) ? (cc >> 1) + 16 : (cc >> 1)); }
        if (slot >= 12 && slot < 24) return slot * 64 + ((c & 1) ? (c >> 1) + 32 : (c >> 1));
        return n;
    }
    if (MAPK == 2) { const int pn = n >> 8, r = n & 255; return (r < 128) ? 128 * pn + r : DFF + 128 * pn + (r - 128); }
    return n;
}
template <int MAPK> __device__ __forceinline__ void transpose_item(const float* W, int K, int N, int ldw, bf16_t* WT, float* scr, int item, int lane) {
    const int nblk = N / 32, kb = item / nblk, nb = item % nblk, k0 = 64 * kb, n0 = 32 * nb;
    const int sc = colmap<MAPK>(n0 + (lane & 31));
    float tv[32];
#pragma unroll
    for (int i = 0; i < 32; ++i) tv[i] = W[(size_t)(k0 + 2 * i + (lane >> 5)) * ldw + sc];
#pragma unroll
    for (int i = 0; i < 32; ++i) scr[(2 * i + (lane >> 5)) * 33 + (lane & 31)] = tv[i];
    LDS_FENCE();
    const int c = lane & 7;
#pragma unroll
    for (int j = 0; j < 4; ++j) { const int n = (lane >> 3) + 8 * j; const float* s = scr + (8 * c) * 33 + n;
        u32x4 o; o.x = pk2(s[0 * 33], s[1 * 33]); o.y = pk2(s[2 * 33], s[3 * 33]); o.z = pk2(s[4 * 33], s[5 * 33]); o.w = pk2(s[6 * 33], s[7 * 33]);
        *(u32x4*)(WT + (size_t)(n0 + n) * K + k0 + 8 * c) = o; }
    LDS_FENCE();
}

__device__ __forceinline__ void prologue(const Args& a, unsigned char* lds, int tid, int G) {
    unsigned char* ws = a.ws;
    const int lane = tid & 63, wave = tid >> 6;
    const float* c_in = a.in[1]; const float* w_mod = a.in[2]; const float* b_mod = a.in[3];
    {
        float* sc = (float*)lds;
        float* red = (float*)(lds + 32768);
        for (int i = tid; i < NB * DM; i += 512) { const float v = c_in[i]; sc[i] = v / (1.f + __expf(-v)); }
        __syncthreads();
        float* MOD = (float*)(ws + WS_MOD);
        for (int item = blockIdx.x; item < DEPTH * (NMOD / 32); item += G) {
            const int l = item / (NMOD / 32), jb = item % (NMOD / 32), kg = tid >> 5, col = tid & 31;
            const float* wp = w_mod + ((size_t)l * DM + kg * 64) * NMOD + jb * 32 + col;
            float acc[8];
#pragma unroll
            for (int b = 0; b < 8; ++b) acc[b] = 0.f;
#pragma unroll 16
            for (int k = 0; k < 64; ++k) { const float w = wp[(size_t)k * NMOD];
#pragma unroll
                for (int b = 0; b < 8; ++b) acc[b] += sc[b * DM + kg * 64 + k] * w; }
#pragma unroll
            for (int b = 0; b < 8; ++b) red[(kg * 8 + b) * 32 + col] = acc[b];
            __syncthreads();
            if (tid < 256) { const int b = tid >> 5; float s = b_mod[(size_t)l * NMOD + jb * 32 + col];
#pragma unroll
              for (int g = 0; g < 16; ++g) s += red[(g * 8 + b) * 32 + col];
              MOD[((size_t)l * NB + b) * NMOD + jb * 32 + col] = s; }
            __syncthreads();
        }
    }
    __syncthreads();
    {
        const int gt = blockIdx.x * 512 + tid, NT_ = G * 512;
        float* RA = (float*)(ws + WS_ROPEA); float* RB = (float*)(ws + WS_ROPEB);
        for (int i = gt; i < T * 48; i += NT_) {
            const int t = i / 48, j = i % 48; const bool isA = j < 16; const int fi = isA ? j : j - 16; const float dim = isA ? 32.f : 64.f;
            const float e = (float)(2 * fi) / dim;
            const float pw = (float)exp2((double)e * 13.287712379549449);
            const float inv = 1.0f / pw;
            const float ang = (float)t * inv;
            const double x = (double)ang, k = rint(x * 0.15915494309189535);
            double r = fma(-k, 6.283185307179586, x); r = fma(-k, 2.4492935982947064e-16, r);
            const float rf = (float)r;
            const float cs = cosf(rf), sn = sinf(rf);
            float* dst = isA ? RA + ((size_t)t * 16 + fi) * 2 : RB + ((size_t)t * 32 + fi) * 2;
            dst[0] = cs; dst[1] = sn;
        }
        float* WFZ = (float*)(ws + WS_WFZ); const float* w_in = a.in[5];
        for (int i = gt; i < DEPTH * 6 * DM; i += NT_) { const int l = i / (6 * DM), r = i % (6 * DM), j = r / DM, k = r % DM; WFZ[i] = w_in[((size_t)l * DM + k) * INC + NIN + j]; }
    }
    {
        float* scr = (float*)(lds + wave * 16384);
        const int gw = blockIdx.x * 8 + wave, NGW = G * 8;
        constexpr int I_IN = (DM / 64) * (NIN / 32), I_OUT = (DM / 64) * (DM / 32), I_UP = (DM / 64) * (NUP / 32), I_DN = (DFF / 64) * (DM / 32), I_L = I_IN + I_OUT + I_UP + I_DN;
        for (int it = gw; it < DEPTH * I_L; it += NGW) {
            const int l = it / I_L; int r = it % I_L;
            bf16_t* WT = (bf16_t*)(ws + WS_WT) + (size_t)l * WL_ELEMS;
            if (r < I_IN) { transpose_item<1>(a.in[5] + (size_t)l * DM * INC, DM, NIN, INC, WT + WL_IN, scr, r, lane); continue; } r -= I_IN;
            if (r < I_OUT) { transpose_item<0>(a.in[9] + (size_t)l * DM * DM, DM, DM, DM, WT + WL_OUT, scr, r, lane); continue; } r -= I_OUT;
            if (r < I_UP) { transpose_item<2>(a.in[11] + (size_t)l * DM * NUP, DM, NUP, NUP, WT + WL_UP, scr, r, lane); continue; } r -= I_UP;
            transpose_item<0>(a.in[14] + (size_t)l * DFF * DM, DFF, DM, DM, WT + WL_DN, scr, r, lane);
        }
    }
}

template <bool FZ> __device__ __forceinline__ void norm_phase(const float* x, const bf16_t* xh, bf16_t* xcopy, bf16_t* H, const float* gw_, const float* modl, int shift_off, int scale_off,
                                                              const float* wfz, const float* fbias, float* LOGF, int tid, int G) {
    const int lane = tid & 63, wave = tid >> 6, gw = blockIdx.x * 8 + wave, NGW = G * 8;
    const int rpw = (MROWS + NGW - 1) / NGW;
    int r0 = gw * rpw, r1 = r0 + rpw; if (r1 > MROWS) r1 = MROWS;
    f32x4 A[4], B[4]; f32x4 wz[FZ ? 6 : 1][4]; float fb[6];
    if (FZ) {
#pragma unroll
        for (int j = 0; j < 6; ++j) { fb[j] = fbias[j];
#pragma unroll
            for (int q = 0; q < 4; ++q) wz[j][q] = *(const f32x4*)(wfz + j * DM + 4 * lane + 256 * q); }
    }
    int curb = -1;
    for (int r = r0; r < r1; ++r) {
        const int b = r >> 13;
        if (b != curb) { curb = b;
#pragma unroll
            for (int q = 0; q < 4; ++q) { const int c = 4 * lane + 256 * q; const f32x4 g4 = *(const f32x4*)(gw_ + c), s4 = *(const f32x4*)(modl + (size_t)b * NMOD + scale_off + c);
                A[q] = g4 * (s4 + 1.0f); B[q] = *(const f32x4*)(modl + (size_t)b * NMOD + shift_off + c); } }
        f32x4 v[4]; float s = 0.f;
        if (x) { const f32x4* xr = (const f32x4*)(x + (size_t)r * DM) + lane;
            unsigned long long* c8 = (unsigned long long*)(xcopy + (size_t)r * DM) + lane;
#pragma unroll
            for (int q = 0; q < 4; ++q) { v[q] = xr[64 * q]; c8[64 * q] = (unsigned long long)f2h2(v[q][0], v[q][1]) | ((unsigned long long)f2h2(v[q][2], v[q][3]) << 32); } }
        else { const unsigned long long* xr = (const unsigned long long*)(xh + (size_t)r * DM) + lane;
#pragma unroll
            for (int q = 0; q < 4; ++q) { const unsigned long long w = xr[64 * q]; const f32x2v a2 = h2f2((unsigned)w), b2 = h2f2((unsigned)(w >> 32));
                v[q] = (f32x4){a2[0], a2[1], b2[0], b2[1]}; } }
#pragma unroll
        for (int q = 0; q < 4; ++q) s += (v[q][0] * v[q][0] + v[q][1] * v[q][1]) + (v[q][2] * v[q][2] + v[q][3] * v[q][3]);
        const float rs = 1.0f / sqrtf(wave_sum(s) * (1.f / DM) + 1e-6f);
#pragma unroll
        for (int q = 0; q < 4; ++q) v[q] = v[q] * rs * A[q] + B[q];
        unsigned long long* o8 = (unsigned long long*)(H + (size_t)r * DM) + lane;
#pragma unroll
        for (int q = 0; q < 4; ++q) o8[64 * q] = (unsigned long long)pk2(v[q][0], v[q][1]) | ((unsigned long long)pk2(v[q][2], v[q][3]) << 32);
        if (FZ) {
            float z = 0.f;
#pragma unroll
            for (int j = 0; j < 6; ++j) { float d = 0.f;
#pragma unroll
                for (int q = 0; q < 4; ++q) d += (v[q][0] * wz[j][q][0] + v[q][1] * wz[j][q][1]) + (v[q][2] * wz[j][q][2] + v[q][3] * wz[j][q][3]);
                d = wave_sum(d) + fb[j]; if (lane == j) z = d; }
            if (lane < 6) { const float lf = fminf(z, 0.f) - log1pf(__expf(-fabsf(z))); LOGF[((size_t)b * 6 + lane) * T + (r & (T - 1))] = lf; }
        }
    }
}
__device__ __forceinline__ void final_norm(const bf16_t* xh, float* out, const float* g, int tid, int G) {
    const int lane = tid & 63, wave = tid >> 6, gw = blockIdx.x * 8 + wave, NGW = G * 8;
    f32x4 A[4];
#pragma unroll
    for (int q = 0; q < 4; ++q) A[q] = *(const f32x4*)(g + 4 * lane + 256 * q);
    for (int r = gw; r < MROWS; r += NGW) {
        const unsigned long long* xr = (const unsigned long long*)(xh + (size_t)r * DM) + lane;
        f32x4 v[4]; float s = 0.f;
#pragma unroll
        for (int q = 0; q < 4; ++q) { const unsigned long long w = xr[64 * q]; const f32x2v a2 = h2f2((unsigned)w), b2 = h2f2((unsigned)(w >> 32));
            v[q] = (f32x4){a2[0], a2[1], b2[0], b2[1]};
            s += (v[q][0] * v[q][0] + v[q][1] * v[q][1]) + (v[q][2] * v[q][2] + v[q][3] * v[q][3]); }
        const float rs = 1.0f / sqrtf(wave_sum(s) * (1.f / DM) + 1e-6f);
        f32x4* orow = (f32x4*)(out + (size_t)r * DM) + lane;
#pragma unroll
        for (int q = 0; q < 4; ++q) orow[64 * q] = v[q] * rs * A[q];
    }
}

__device__ __forceinline__ void cvec_phase(unsigned char* ws, int tid, int G) {
    const int lane = tid & 63, wave = tid >> 6, gw = blockIdx.x * 8 + wave, NGW = G * 8;
    const float* MOD = (const float*)(ws + WS_MOD); float* CUP = (float*)(ws + WS_CUP);
    for (int l = 0; l < DEPTH; ++l) {
        const bf16_t* WT = (const bf16_t*)(ws + WS_WT) + (size_t)l * WL_ELEMS + WL_UP;
        for (int n = gw; n < NUP; n += NGW) {
            const u32x4 w0 = *(const u32x4*)(WT + (size_t)n * DM + lane * 16), w1 = *(const u32x4*)(WT + (size_t)n * DM + lane * 16 + 8);
            float wv[16];
#pragma unroll
            for (int q = 0; q < 4; ++q) { wv[2 * q] = bf2f((unsigned short)(w0[q] & 0xffffu)); wv[2 * q + 1] = bf2f((unsigned short)(w0[q] >> 16)); wv[8 + 2 * q] = bf2f((unsigned short)(w1[q] & 0xffffu)); wv[8 + 2 * q + 1] = bf2f((unsigned short)(w1[q] >> 16)); }
            float mine = 0.f;
#pragma unroll
            for (int b = 0; b < NB; ++b) {
                const float* sp = MOD + ((size_t)l * NB + b) * NMOD + 3 * DM + lane * 16;
                float d = 0.f;
#pragma unroll
                for (int q = 0; q < 4; ++q) { const f32x4 s4 = *(const f32x4*)(sp + 4 * q); d += (s4[0] * wv[4 * q] + s4[1] * wv[4 * q + 1]) + (s4[2] * wv[4 * q + 2] + s4[3] * wv[4 * q + 3]); }
                d = wave_sum(d); if (lane == b) mine = d;
            }
            if (lane < NB) CUP[((size_t)l * NB + lane) * NUP + n] = mine;
        }
    }
}
__device__ __forceinline__ void scan_phase(float* LOGF, unsigned char* lds, int tid, int G) {
    float* wt = (float*)lds;
    for (int seq = blockIdx.x; seq < NB * 6; seq += G) {
        f32x4* p = (f32x4*)(LOGF + (size_t)seq * T) + tid * 4;
        f32x4 v[4]; float run = 0.f;
#pragma unroll
        for (int q = 0; q < 4; ++q) { v[q] = p[q];
#pragma unroll
            for (int i = 0; i < 4; ++i) { run += v[q][i]; v[q][i] = run; } }
        float inc = run;
        const int lane = tid & 63, wave = tid >> 6;
#pragma unroll
        for (int o = 1; o < 64; o <<= 1) { const float n = __shfl_up(inc, o); if (lane >= o) inc += n; }
        if (lane == 63) wt[wave] = inc;
        __syncthreads();
        float off = inc - run;
        for (int w = 0; w < wave; ++w) off += wt[w];
#pragma unroll
        for (int q = 0; q < 4; ++q) p[q] = (v[q] + off) * LOG2E;
        __syncthreads();
    }
}

__device__ __forceinline__ int crow(int r, int hi) { return (r & 3) + 8 * (r >> 2) + 4 * hi; }
typedef float f32x2_t __attribute__((ext_vector_type(2))); typedef __bf16 bf16x2_t __attribute__((ext_vector_type(2)));
__device__ __forceinline__ unsigned cvtpk(float lo, float hi) { f32x2_t v = {lo, hi}; bf16x2_t b = __builtin_convertvector(v, bf16x2_t); return __builtin_bit_cast(unsigned, b); }
__device__ __forceinline__ float max3f(float a, float b, float c) { float r; asm("v_max3_f32 %0, %1, %2, %3" : "=v"(r) : "v"(a), "v"(b), "v"(c)); return r; }
__device__ __forceinline__ float half_max(float m) { auto rr = __builtin_amdgcn_permlane32_swap(__float_as_uint(m), __float_as_uint(m), false, false); return fmaxf(__uint_as_float(rr[0]), __uint_as_float(rr[1])); }

template <int DK, int MODE>
__device__ __forceinline__ void attn_qk(const unsigned char* B, const unsigned char* qslot, int r32, int hi, int kfs, const bf16x8& qones, const f32x16& negm, f32x16& s0, f32x16& s1,
                                        const bf16x8* qreg = nullptr) {
    constexpr int ROWB = DK * 2, ND = DK / 16;
    bf16x8 kb0, kb1;
    if (MODE == 1) { kb0 = *(const bf16x8*)(B + AT_BIAS + r32 * 16); kb1 = *(const bf16x8*)(B + AT_BIAS + (32 + r32) * 16); }
#pragma unroll
    for (int h2 = 0; h2 < ND; h2 += 2) {
        bf16x8 kf[2][2], qf[2];
#pragma unroll
        for (int e = 0; e < 2; ++e) {
            const int d0 = h2 + e, ch = ((2 * d0 + hi) ^ kfs) << 4;
            kf[e][0] = *(const bf16x8*)(B + AT_K + r32 * ROWB + ch); kf[e][1] = *(const bf16x8*)(B + AT_K + (32 + r32) * ROWB + ch);
            qf[e] = (DK == 32 && qreg) ? qreg[d0] : *(const bf16x8*)(qslot + d0 * 1024);
        }
        __builtin_amdgcn_sched_barrier(0);
#pragma unroll
        for (int e = 0; e < 2; ++e) {
            if (h2 + e == 0) { s0 = __builtin_amdgcn_mfma_f32_32x32x16_bf16(kf[e][0], qf[e], negm, 0, 0, 0); s1 = __builtin_amdgcn_mfma_f32_32x32x16_bf16(kf[e][1], qf[e], negm, 0, 0, 0); }
            else { s0 = __builtin_amdgcn_mfma_f32_32x32x16_bf16(kf[e][0], qf[e], s0, 0, 0, 0); s1 = __builtin_amdgcn_mfma_f32_32x32x16_bf16(kf[e][1], qf[e], s1, 0, 0, 0); }
        }
    }
    if (MODE == 1) { s0 = __builtin_amdgcn_mfma_f32_32x32x16_bf16(kb0, qones, s0, 0, 0, 0); s1 = __builtin_amdgcn_mfma_f32_32x32x16_bf16(kb1, qones, s1, 0, 0, 0); }
}
template <int MODE>
__device__ __forceinline__ void attn_pv(bool fixn, const unsigned char* B, int key0, int qw, int qi, int r32, int hi, int vad0, int vad1, const bf16x8& ones, float* wsf,
                                        f32x16& p0, f32x16& p1, f32x16& n0, f32x16& n1, float& mref, f32x16& negm, f32x16& ol, f32x16& oa, f32x16& ob) {
    v4i16_t vl0[4], vh0[4], vl1[4], vh1[4];
#pragma unroll
    for (int j = 0; j < 2; ++j) {
        vl0[j] = __builtin_amdgcn_ds_read_tr16_b64_v4i16((LAS v4i16_t*)(B + vad0 + j * 2048)); vh0[j] = __builtin_amdgcn_ds_read_tr16_b64_v4i16((LAS v4i16_t*)(B + vad0 + j * 2048 + 1024));
        vl1[j] = __builtin_amdgcn_ds_read_tr16_b64_v4i16((LAS v4i16_t*)(B + vad1 + j * 2048)); vh1[j] = __builtin_amdgcn_ds_read_tr16_b64_v4i16((LAS v4i16_t*)(B + vad1 + j * 2048 + 1024));
    }
    if (MODE == 2) {
#pragma unroll
        for (int r = 0; r < 16; ++r) { const int dlt = qi - (key0 + crow(r, hi)); if (dlt < 0 || dlt > 128) p0[r] = -INFINITY; if (dlt - 32 < 0 || dlt - 32 > 128) p1[r] = -INFINITY; }
    } else if (key0 + 63 > qw) {
        asm volatile("" ::: "memory");
        const int lim = qi - key0 - 4 * hi;
#pragma unroll
        for (int r = 0; r < 16; ++r) { const int cr = (r & 3) + 8 * (r >> 2); if (cr > lim) p0[r] = -INFINITY; if (cr + 32 > lim) p1[r] = -INFINITY; }
    }
#define MX3(a, b, c) __builtin_fmaxf(__builtin_fmaxf((a), (b)), (c))
    float ra = MX3(p0[0], p0[1], p1[0]), rb = MX3(p0[2], p0[3], p1[1]); ra = MX3(ra, p1[2], p1[3]);
#pragma unroll
    for (int r = 4; r < 16; r += 4) { ra = MX3(ra, p0[r], p0[r + 1]); rb = MX3(rb, p0[r + 2], p0[r + 3]); ra = MX3(ra, p1[r], p1[r + 1]); rb = MX3(rb, p1[r + 2], p1[r + 3]); }
#undef MX3
    const float rm = half_max(__builtin_fmaxf(ra, rb));
    if (__any(rm > 8.f)) {
        const float dl = fmaxf(rm, 0.f); mref += dl;
#pragma unroll
        for (int r = 0; r < 16; ++r) { p0[r] -= dl; p1[r] -= dl; negm[r] = -mref; }
        if (fixn) {
#pragma unroll
            for (int r = 0; r < 16; ++r) { n0[r] -= dl; n1[r] -= dl; } }
        const float f = __builtin_amdgcn_exp2f(-dl);
        if (hi == 0) wsf[r32] = f;
        LDS_FENCE();
#pragma unroll
        for (int g = 0; g < 4; ++g) { const f32x4 fv = *(const f32x4*)(wsf + 8 * g + 4 * hi);
#pragma unroll
            for (int i = 0; i < 4; ++i) { oa[4 * g + i] *= fv[i]; ob[4 * g + i] *= fv[i]; ol[4 * g + i] *= fv[i]; } }
        LDS_FENCE();
    }
#pragma unroll
    for (int r = 0; r < 16; ++r) { p0[r] = __builtin_amdgcn_exp2f(p0[r]); p1[r] = __builtin_amdgcn_exp2f(p1[r]); }
#pragma unroll
    for (int j = 0; j < 4; ++j) {
        u32x4 pw;
        if (j < 2) { const int bs = 8 * (j & 1); pw = (u32x4){cvtpk(p0[bs], p0[bs + 1]), cvtpk(p0[bs + 2], p0[bs + 3]), cvtpk(p0[bs + 4], p0[bs + 5]), cvtpk(p0[bs + 6], p0[bs + 7])}; }
        else { const int bs = 8 * (j & 1); pw = (u32x4){cvtpk(p1[bs], p1[bs + 1]), cvtpk(p1[bs + 2], p1[bs + 3]), cvtpk(p1[bs + 4], p1[bs + 5]), cvtpk(p1[bs + 6], p1[bs + 7])}; }
        const bf16x8 pa = __builtin_bit_cast(bf16x8, pw);
        if (j < 2) {
            vl0[j + 2] = __builtin_amdgcn_ds_read_tr16_b64_v4i16((LAS v4i16_t*)(B + vad0 + (j + 2) * 2048)); vh0[j + 2] = __builtin_amdgcn_ds_read_tr16_b64_v4i16((LAS v4i16_t*)(B + vad0 + (j + 2) * 2048 + 1024));
            vl1[j + 2] = __builtin_amdgcn_ds_read_tr16_b64_v4i16((LAS v4i16_t*)(B + vad1 + (j + 2) * 2048)); vh1[j + 2] = __builtin_amdgcn_ds_read_tr16_b64_v4i16((LAS v4i16_t*)(B + vad1 + (j + 2) * 2048 + 1024));
        }
        { const bf16x8 vf = (bf16x8){vl0[j][0], vl0[j][1], vl0[j][2], vl0[j][3], vh0[j][0], vh0[j][1], vh0[j][2], vh0[j][3]};
          oa = __builtin_amdgcn_mfma_f32_32x32x16_bf16(pa, vf, oa, 0, 0, 0); }
        { const bf16x8 vf = (bf16x8){vl1[j][0], vl1[j][1], vl1[j][2], vl1[j][3], vh1[j][0], vh1[j][1], vh1[j][2], vh1[j][3]};
          ob = __builtin_amdgcn_mfma_f32_32x32x16_bf16(pa, vf, ob, 0, 0, 0); }
        ol = __builtin_amdgcn_mfma_f32_32x32x16_bf16(pa, ones, ol, 0, 0, 0);
    }
}

template <int DK, int MODE>
__device__ __forceinline__ void attn_core(unsigned char* lds, int tid_in, const bf16_t* Qg, long qrs, const bf16_t* Kg, long krs, const bf16_t* Vg, long vrs,
                                          const float* Fg, float fref, int q0, int kt_lo, int kt_hi, int korg,
                                          float& mref_out, f32x16& ol_out, f32x16& o0, f32x16& o1) {
    constexpr int ROWB = DK * 2, ND = DK / 16;
    int tid = tid_in; asm volatile("" : "+v"(tid));
    const int lane = tid & 63, wid = __builtin_amdgcn_readfirstlane(tid >> 6), r32 = lane & 31, hi = lane >> 5;
    const int qw = q0 + 32 * wid, qi = qw + r32;
    unsigned char* qslot = lds + AT_Q + wid * 4096 + lane * 16;
    bf16x8 qrr[2];
#pragma unroll
    for (int d0 = 0; d0 < ND; ++d0) { const bf16x8 qv = *(const bf16x8*)(Qg + (long)qi * qrs + d0 * 16 + hi * 8); if (DK == 32) qrr[d0] = qv; else *(bf16x8*)(qslot + d0 * 1024) = qv; }
    const bf16x8* qreg = (DK == 32) ? qrr : nullptr;
    f32x16 oa, ob, ol, negm, sa0, sa1, sb0, sb1;
#pragma unroll
    for (int r = 0; r < 16; ++r) { oa[r] = 0.f; ob[r] = 0.f; ol[r] = 0.f; negm[r] = 0.f; sa0[r] = 0.f; sa1[r] = 0.f; sb0[r] = 0.f; sb1[r] = 0.f; }
    float mref = 0.f;
    float* wsf = (float*)(lds + AT_WS + wid * 256);
    const bf16x8 ones = (bf16x8){0x3F80, 0x3F80, 0x3F80, 0x3F80, 0x3F80, 0x3F80, 0x3F80, 0x3F80};
    const bf16x8 qones = hi ? (bf16x8){0, 0, 0, 0, 0, 0, 0, 0} : (bf16x8){0x3F80, 0x3F80, 0x3F80, 0, 0, 0, 0, 0};
    const int krow = (DK == 64) ? (tid >> 3) : ((tid & 255) >> 2), kch = (DK == 64) ? (tid & 7) : (tid & 3);
    const int kswz = (DK == 64) ? ((krow >> 1) & 7) : ((krow >> 2) & 3);
    const bool kact = (DK == 64) || (tid < 256);
    const int vrow = tid >> 3, vch = tid & 7, vswz = (vrow & 2) << 1;
    const int koff = AT_K + krow * ROWB + ((kch ^ kswz) << 4), voff = AT_V + vrow * 128 + ((vch ^ vswz) << 4);
    const bf16_t* kptr = Kg + (long)(korg + 64 * kt_lo + krow) * krs + kch * 8; const bf16_t* vptr = Vg + (long)(korg + 64 * kt_lo + vrow) * vrs + vch * 8; const float* fptr = Fg + korg + 64 * kt_lo + (tid & 63);
    const int NT = kt_hi - kt_lo;
    u32x4 kreg0 = (u32x4){0u, 0u, 0u, 0u}, vreg0 = kreg0, kreg1 = kreg0, vreg1 = kreg0; float breg0 = 0.f, breg1 = 0.f;
#define AT_LOADK(S, i) do { if (kact) kreg##S = *(const u32x4*)(kptr + (long)(64 * (i)) * krs); if (MODE == 1 && tid < 64) breg##S = fref - fptr[64 * (i)]; } while (0)
#define AT_LOADV(S, i) do { vreg##S = *(const u32x4*)(vptr + (long)(64 * (i)) * vrs); } while (0)
#define AT_STOREK(S, buf) do { unsigned char* B_ = lds + (buf) * AT_BUF; if (kact) *(u32x4*)(B_ + koff) = kreg##S; \
        if (MODE == 1 && tid < 64) { const unsigned bh_ = f2bf(breg##S); const float r1_ = breg##S - __builtin_bit_cast(float, bh_ << 16); const unsigned bm_ = f2bf(r1_); \
            const float r2_ = r1_ - __builtin_bit_cast(float, bm_ << 16); const unsigned bl_ = f2bf(r2_); \
            *(u32x4*)(B_ + AT_BIAS + tid * 16) = (u32x4){bh_ | (bm_ << 16), bl_, 0u, 0u}; } } while (0)
#define AT_STOREV(S, buf) do { *(u32x4*)(lds + (buf) * AT_BUF + voff) = vreg##S; } while (0)
    const int kfs = (DK == 64) ? ((r32 >> 1) & 7) : ((r32 >> 2) & 3);
    const int q4 = (lane & 15) >> 2, p4 = lane & 3, dh = (lane >> 4) & 1;
    const int vs = (q4 & 2) >> 1;
    const int vbase = AT_V + (4 * hi + q4) * 128 + (p4 & 1) * 8;
    const int vc = 2 * dh + (p4 >> 1);
    const int vad0 = vbase + ((((0 ^ vs) << 2) | vc) << 4), vad1 = vbase + ((((1 ^ vs) << 2) | vc) << 4);
    const int kbase0 = 64 * kt_lo + korg;
#define AT_ACTIVE(i) ((MODE == 2) ? !((kbase0 + 64 * (i)) > qw + 31 || (kbase0 + 64 * (i)) + 63 < qw - 128) : !((kbase0 + 64 * (i)) > qw + 31))

    AT_LOADK(0, 0); AT_LOADV(0, 0); if (NT > 1) AT_LOADK(1, 1);
    AT_STOREK(0, 0); AT_STOREV(0, 0); if (NT > 1) AT_STOREK(1, 1);
    if (NT > 2) AT_LOADK(0, 2); if (NT > 3) AT_LOADK(1, 3); if (NT > 1) AT_LOADV(0, 1); if (NT > 2) AT_LOADV(1, 2);
    __syncthreads();
    if (AT_ACTIVE(0)) attn_qk<DK, MODE>(lds, qslot, r32, hi, kfs, qones, negm, sa0, sa1, qreg);
    __syncthreads();
#define AT_ITER(i, PAR, C0, C1, N0, N1) do { \
        const bool an_ = ((i) + 1 < NT) && AT_ACTIVE((i) + 1); \
        if (an_) attn_qk<DK, MODE>(lds + (1 - (PAR)) * AT_BUF, qslot, r32, hi, kfs, qones, negm, N0, N1, qreg); \
        if (AT_ACTIVE(i)) attn_pv<MODE>(true, lds + (PAR) * AT_BUF, kbase0 + 64 * (i), qw, qi, r32, hi, vad0, vad1, ones, wsf, C0, C1, N0, N1, mref, negm, ol, oa, ob); \
        if ((i) + 2 < NT) AT_STOREK(PAR, PAR); \
        if ((i) + 1 < NT) AT_STOREV(PAR, 1 - (PAR)); \
        if ((i) + 4 < NT) AT_LOADK(PAR, (i) + 4); \
        if ((i) + 3 < NT) AT_LOADV(PAR, (i) + 3); \
        __syncthreads(); } while (0)
    for (int i = 0; i < NT; i += 2) {
        AT_ITER(i, 0, sa0, sa1, sb0, sb1);
        if (i + 1 >= NT) break;
        AT_ITER(i + 1, 1, sb0, sb1, sa0, sa1);
    }
#undef AT_ITER
#undef AT_LOADK
#undef AT_LOADV
#undef AT_STOREK
#undef AT_STOREV
#undef AT_ACTIVE
    mref_out = mref; ol_out = ol; o0 = oa; o1 = ob;
}


constexpr int ATB_WS = 6 * AT_BUF, ATB_Q = ATB_WS + 2048;
static_assert(ATB_Q + 32768 <= LDS_BYTES - 4096, "B-unit LDS map");
__device__ __forceinline__ void attn_core_band(unsigned char* lds, int tid_in, const bf16_t* Qg, const bf16_t* Kg, const bf16_t* Vg, long rs, int q0, int kt_lo, int korg,
                                               float& mref_out, f32x16& ol_out, f32x16& o0, f32x16& o1) {
    int tid = tid_in; asm volatile("" : "+v"(tid));
    const int lane = tid & 63, wid = __builtin_amdgcn_readfirstlane(tid >> 6), r32 = lane & 31, hi = lane >> 5;
    const int qw = q0 + 32 * wid, qi = qw + r32;
    unsigned char* qslot = lds + ATB_Q + wid * 4096 + lane * 16;
#pragma unroll
    for (int d0 = 0; d0 < 4; ++d0) *(bf16x8*)(qslot + d0 * 1024) = *(const bf16x8*)(Qg + (long)qi * rs + d0 * 16 + hi * 8);
    const int krow = tid >> 3, kch = tid & 7, kswz = (krow >> 1) & 7, vswz = (krow & 2) << 1;
    const int koff = AT_K + krow * 128 + ((kch ^ kswz) << 4), voff = AT_V + krow * 128 + ((kch ^ vswz) << 4);
    const int NT = 6 - kt_lo;
    const bf16_t* kptr = Kg + (long)(korg + 64 * kt_lo + krow) * rs + kch * 8; const bf16_t* vptr = Vg + (long)(korg + 64 * kt_lo + krow) * rs + kch * 8;
    u32x4 kr[6], vr[6];
#pragma unroll
    for (int i = 0; i < 6; ++i) if (i < NT) { kr[i] = *(const u32x4*)(kptr + (long)(64 * i) * rs); vr[i] = *(const u32x4*)(vptr + (long)(64 * i) * rs); }
#pragma unroll
    for (int i = 0; i < 6; ++i) if (i < NT) { *(u32x4*)(lds + i * AT_BUF + koff) = kr[i]; *(u32x4*)(lds + i * AT_BUF + voff) = vr[i]; }
    f32x16 oa, ob, ol, negm, s0, s1;
#pragma unroll
    for (int r = 0; r < 16; ++r) { oa[r] = 0.f; ob[r] = 0.f; ol[r] = 0.f; negm[r] = 0.f; s0[r] = 0.f; s1[r] = 0.f; }
    float mref = 0.f;
    float* wsf = (float*)(lds + ATB_WS + wid * 256);
    const bf16x8 ones = (bf16x8){0x3F80, 0x3F80, 0x3F80, 0x3F80, 0x3F80, 0x3F80, 0x3F80, 0x3F80};
    const bf16x8 qones = (bf16x8){0, 0, 0, 0, 0, 0, 0, 0};
    const int kfs = (r32 >> 1) & 7;
    const int q4 = (lane & 15) >> 2, p4 = lane & 3, dh = (lane >> 4) & 1, vs = (q4 & 2) >> 1;
    const int vbase = AT_V + (4 * hi + q4) * 128 + (p4 & 1) * 8, vc = 2 * dh + (p4 >> 1);
    const int vad0 = vbase + ((((0 ^ vs) << 2) | vc) << 4), vad1 = vbase + ((((1 ^ vs) << 2) | vc) << 4);
    const int kbase0 = 64 * kt_lo + korg;
    __syncthreads();
    for (int i = 0; i < NT; ++i) {
        const int key0 = kbase0 + 64 * i;
        if (!(key0 > qw + 31 || key0 + 63 < qw - 128)) {
            attn_qk<64, 2>(lds + i * AT_BUF, qslot, r32, hi, kfs, qones, negm, s0, s1);
            attn_pv<2>(false, lds + i * AT_BUF, key0, qw, qi, r32, hi, vad0, vad1, ones, wsf, s0, s1, s0, s1, mref, negm, ol, oa, ob);
        }
    }
    mref_out = mref; ol_out = ol; o0 = oa; o1 = ob;
}

__device__ __forceinline__ void row_bcast(float* wsf, float val, int r32, int hi, float (&out)[16]) {
    LDS_FENCE();
    if (hi == 0) wsf[r32] = val;
    LDS_FENCE();
#pragma unroll
    for (int g = 0; g < 4; ++g) { const f32x4 fv = *(const f32x4*)(wsf + 8 * g + 4 * hi);
#pragma unroll
        for (int i = 0; i < 4; ++i) out[4 * g + i] = fv[i]; }
    LDS_FENCE();
}

#ifndef PROBE_MASK
#define PROBE_MASK 0
#endif
#define TIC(id) unsigned long long t0_##id = 0; if ((PROBE_MASK >> (id)) & 1) t0_##id = __builtin_amdgcn_s_memrealtime()
#define TOC(id) if ((PROBE_MASK >> (id)) & 1) tacc += __builtin_amdgcn_s_memrealtime() - t0_##id
#define STG_BASE(stg) bf16_t* sp_; { int l_ = lane; asm volatile("" : "+v"(l_)); sp_ = (stg) + (l_ >> 5) * 256 + (l_ & 31); }
#define STG_PUT(r, a, b) do { const int o_ = (((r) & 3) + 8 * ((r) >> 2)) * 64; sp_[o_] = (bf16_t)f2bf(a); sp_[o_ + 32] = (bf16_t)f2bf(b); } while (0)
__device__ __forceinline__ void stage_flush(const bf16_t* stg, int lane_in, bf16_t* gbase, long grs) {
    int lane = lane_in; asm volatile("" : "+v"(lane));
    LDS_FENCE();
#pragma unroll
    for (int i = 0; i < 4; ++i) { const int row = i * 8 + (lane >> 3), ch = lane & 7; const u32x4 w = *(const u32x4*)(stg + row * 64 + ch * 8); *(u32x4*)(gbase + (long)row * grs + ch * 8) = w; }
    LDS_FENCE();
}

constexpr int N_AC = 32 * 80, N_BU = 3 * NB * 6 * 32, N_UNITS = N_AC + N_BU;

__device__ __forceinline__ void attn_phase(const Args& a, unsigned char* lds, int tid, int layer, unsigned long long& tacc) {
    unsigned char* ws = a.ws;
    const bf16_t* QKV = (const bf16_t*)(ws + WS_QKV);
    bf16_t* O = (bf16_t*)(ws + WS_O);
    bf16_t* OBP = (bf16_t*)(ws + WS_OBP);
    float* LSEB = (float*)(ws + WS_LSEB);
    const float* F2 = (const float*)(ws + WS_LOGF);
    const int lane = tid & 63, wid = __builtin_amdgcn_readfirstlane(tid >> 6), r32 = lane & 31, hi = lane >> 5;
    float* wsf = (float*)(lds + AT_WS + wid * 256);
    bf16_t* stg = (bf16_t*)(lds + AT_Q + wid * 4096);
    const float lam_init = 0.8f - 0.6f * __expf(-0.3f * (float)layer);
    float lam;
    { const float* lp = a.in[6] + (size_t)layer * 128; float s1 = 0.f, s2 = 0.f; if (lane < 32) { s1 = lp[lane] * lp[32 + lane]; s2 = lp[64 + lane] * lp[96 + lane]; }
      s1 = wave_sum(s1); s2 = wave_sum(s2); lam = expf(s1) - expf(s2) + lam_init; }
    const int G = gridDim.x, bx = blockIdx.x;
    const int vcu = (G % 8 == 0) ? (bx % 8) * (G / 8) + bx / 8 : bx;
    for (int it = vcu; it < 256 * 28; it += G) {
        const int s = it & 255, step = it >> 8, team = s >> 5, c = s & 31;
        int u;
        if (step < 6) { const int hd = team * 6 + step, qb = (step & 1) ? 31 - c : c; u = (31 - qb) * 80 + hd; }
        else if (step < 10) { const int st = step - 6, hd = team * 4 + st, qb = (st & 1) ? 31 - c : c; u = (31 - qb) * 80 + 48 + hd; }
        else { const int k = step - 10, hd = team * 6 + k / 3, p = k % 3; u = N_AC + ((p * 48 + hd) << 5) + c; }
        __syncthreads();
        float mref; f32x16 ol, o0, o1;
        if (u < N_AC) {
            const int qb = 31 - u / 80, j = u % 80, q0 = qb * 256;
            if (j < 48) {
#ifndef NO_VC
                TIC(13);
                const int b = j / 6, h = j % 6;
                const bf16_t* Qg = QKV + (size_t)(b * NSLOT + 30 + h) * T * 64; const bf16_t* Kg = QKV + (size_t)(b * NSLOT + 36 + h) * T * 64; const bf16_t* Vg = QKV + (size_t)(b * NSLOT + 42 + h) * T * 64;
                const float* Fg = F2 + (size_t)(b * 6 + h) * T;
                attn_core<64, 1>(lds, tid, Qg, 64, Kg, 64, Vg, 64, Fg, Fg[q0], q0, 0, 4 * qb + 4, 0, mref, ol, o0, o1);
                STG_BASE(stg);
#pragma unroll
                for (int r = 0; r < 16; ++r) { const float rl = __builtin_amdgcn_rcpf(ol[r]); STG_PUT(r, o0[r] * rl, o1[r] * rl); }
                stage_flush(stg, lane, O + (size_t)(b * T + q0 + 32 * wid) * DM + 640 + h * 64, DM);
                TOC(13);
#endif
            } else {
#ifndef NO_VA
                const int jj = j - 48, b = jj / 4, h = jj % 4;
                const bf16_t* Qg = QKV + (size_t)(b * NSLOT + h) * T * 64; const bf16_t* Kg = QKV + (size_t)(b * NSLOT + 4 + h) * T * 64; const bf16_t* Vg = QKV + (size_t)(b * NSLOT + 8 + h) * T * 64;
                attn_core<32, 0>(lds, tid, Qg, 32, Kg, 32, Vg, 64, nullptr, 0.f, q0, 0, 4 * qb + 4, 0, mref, ol, o0, o1);
                float* stash = (float*)(lds + AT_STASH + wid * 8192) + lane;
#pragma unroll
                for (int r = 0; r < 16; ++r) { const float rl = __builtin_amdgcn_rcpf(ol[r]); stash[r * 64] = o0[r] * rl; stash[(16 + r) * 64] = o1[r] * rl; }
                attn_core<32, 0>(lds, tid, Qg + (size_t)T * 32, 32, Kg + (size_t)T * 32, 32, Vg, 64, nullptr, 0.f, q0, 0, 4 * qb + 4, 0, mref, ol, o0, o1);
                const float* sg = a.in[7] + (size_t)layer * 64;
                const float g0 = sg[r32] * (1.0f - lam_init), g1 = sg[32 + r32] * (1.0f - lam_init);
                STG_BASE(stg);
#pragma unroll
                for (int r = 0; r < 16; ++r) {
                    const float rl = __builtin_amdgcn_rcpf(ol[r]);
                    const float a0 = stash[r * 64] - lam * (o0[r] * rl), a1 = stash[(16 + r) * 64] - lam * (o1[r] * rl);
                    float ss = a0 * a0 + a1 * a1;
                    ss += __shfl_xor(ss, 1); ss += __shfl_xor(ss, 2); ss += __shfl_xor(ss, 4); ss += __shfl_xor(ss, 8); ss += __shfl_xor(ss, 16);
                    const float rs = 1.0f / sqrtf(ss * (1.f / 64.f) + 1e-5f);
                    STG_PUT(r, a0 * rs * g0, a1 * rs * g1);
                }
                stage_flush(stg, lane, O + (size_t)(b * T + q0 + 32 * wid) * DM + h * 64, DM);
#endif
            }
        } else {
#ifndef NO_VB
            TIC(15);
            const int v = u - N_AC, k = v & 31, bhp = v >> 5, h = bhp % 6, b = (bhp / 6) % NB, p = bhp / (6 * NB);
            const int d = (p == 0) ? 1 : (p == 1) ? 4 : 16, bpc = 32 / d, cls = k / bpc, nb = k % bpc, q0 = nb * 256;
            const bf16_t* Qg = QKV + ((size_t)(b * NSLOT + 12 + h) * T + cls) * 64; const bf16_t* Kg = QKV + ((size_t)(b * NSLOT + 18 + h) * T + cls) * 64; const bf16_t* Vg = QKV + ((size_t)(b * NSLOT + 24 + h) * T + cls) * 64;
            const long rs_ = (long)d * 64;
            attn_core_band(lds, tid, Qg, Kg, Vg, rs_, q0, (nb == 0) ? 2 : 0, q0 - 128, mref, ol, o0, o1);
            float mr[16];
            row_bcast((float*)(lds + ATB_WS + wid * 256), mref, r32, hi, mr);
            const size_t pb = ((size_t)(p * NB + b) * 6 + h) * T;
            bf16_t* stgb = (bf16_t*)(lds + ATB_Q + wid * 4096);
            STG_BASE(stgb);
#pragma unroll
            for (int r = 0; r < 16; ++r) {
                const size_t tok = pb + cls + (size_t)d * (q0 + 32 * wid + crow(r, hi));
                const float rl = __builtin_amdgcn_rcpf(ol[r]);
                if (r32 == 0) LSEB[tok] = mr[r] + __log2f(ol[r]);
                STG_PUT(r, o0[r] * rl, o1[r] * rl);
            }
            stage_flush(stgb, lane, OBP + (pb + cls + (size_t)d * (q0 + 32 * wid)) * 64, rs_);
            TOC(15);
#endif
        }
    }
}

__device__ __forceinline__ void combine_phase(unsigned char* ws, int tid, int G) {
    const bf16_t* OBP = (const bf16_t*)(ws + WS_OBP); const float* LSEB = (const float*)(ws + WS_LSEB); bf16_t* O = (bf16_t*)(ws + WS_O);
    const size_t NI = (size_t)MROWS * 48, PS = (size_t)NB * 6 * T;
    for (size_t i = (size_t)blockIdx.x * 512 + tid; i < NI; i += (size_t)G * 512) {
        const int row = (int)(i / 48), rem = (int)(i % 48), h = rem >> 3, ch = rem & 7, b = row >> 13, t = row & (T - 1);
        const size_t e = ((size_t)b * 6 + h) * T + t;
        const float l0 = LSEB[e], l1 = LSEB[PS + e], l2 = LSEB[2 * PS + e];
        const float mx = fmaxf(l0, fmaxf(l1, l2));
        float w0 = __builtin_amdgcn_exp2f(l0 - mx), w1 = __builtin_amdgcn_exp2f(l1 - mx), w2 = __builtin_amdgcn_exp2f(l2 - mx);
        const float inv = 1.0f / (w0 + w1 + w2); w0 *= inv; w1 *= inv; w2 *= inv;
        const u32x4 a0 = *(const u32x4*)(OBP + e * 64 + ch * 8), a1 = *(const u32x4*)(OBP + (PS + e) * 64 + ch * 8), a2 = *(const u32x4*)(OBP + (2 * PS + e) * 64 + ch * 8);
        u32x4 o;
#pragma unroll
        for (int q = 0; q < 4; ++q) {
            const float x0 = w0 * bf2f((unsigned short)(a0[q] & 0xffffu)) + w1 * bf2f((unsigned short)(a1[q] & 0xffffu)) + w2 * bf2f((unsigned short)(a2[q] & 0xffffu));
            const float x1 = w0 * bf2f((unsigned short)(a0[q] >> 16)) + w1 * bf2f((unsigned short)(a1[q] >> 16)) + w2 * bf2f((unsigned short)(a2[q] >> 16));
            o[q] = pk2(x0, x1);
        }
        *(u32x4*)(O + (size_t)row * DM + 256 + h * 64 + ch * 8) = o;
    }
}
__device__ __forceinline__ void fix_phase(unsigned char* ws, const float* cw, const float* cb, int tid, int G) {
    const unsigned char* FIXP = (const unsigned char*)(ws + WS_FIX); const unsigned char* FIXT2 = FIXP + FIX_ELEMS * 4; bf16_t* ACT = (bf16_t*)(ws + WS_ACT);
    constexpr int F4 = DFF / 4; const int NI = 1024 * 2 * F4;
    for (int i = blockIdx.x * 512 + tid; i < NI; i += G * 512) {
        const int grp = i / (2 * F4), rem = i % (2 * F4), rr = rem / F4, f = (rem % F4) * 4;
        const int row = grp * 64 + rr, t = row & (T - 1);
#define FX_U2F(w, hi_) ((hi_) ? __builtin_bit_cast(float, (w) & 0xffff0000u) : __builtin_bit_cast(float, (w) << 16))
        const u32x4 own = *(const u32x4*)(FIXP + (((size_t)grp * 2 + rr) * DFF + f) * 4);
        const f32x4 uu = (f32x4){FX_U2F(own.x, 0), FX_U2F(own.x, 1), FX_U2F(own.y, 0), FX_U2F(own.y, 1)}, g0 = (f32x4){FX_U2F(own.z, 0), FX_U2F(own.z, 1), FX_U2F(own.w, 0), FX_U2F(own.w, 1)};
        f32x4 gm1 = (f32x4){0.f, 0.f, 0.f, 0.f}, gm2 = gm1;
        typedef unsigned u32x2t __attribute__((ext_vector_type(2)));
        const u32x2t t1 = (t >= 2 - rr && grp > 0) ? *(const u32x2t*)(FIXT2 + (((size_t)(grp - 1) * 2 + 1) * DFF + f) * 4) : (u32x2t){0u, 0u};
        const f32x4 tail1 = (f32x4){FX_U2F(t1.x, 0), FX_U2F(t1.x, 1), FX_U2F(t1.y, 0), FX_U2F(t1.y, 1)};
        if (rr == 0) {
            if (t >= 1) gm1 = tail1;
            if (t >= 2) { const u32x2t t0 = *(const u32x2t*)(FIXT2 + (((size_t)(grp - 1) * 2 + 0) * DFF + f) * 4); gm2 = (f32x4){FX_U2F(t0.x, 0), FX_U2F(t0.x, 1), FX_U2F(t0.y, 0), FX_U2F(t0.y, 1)}; }
        } else {
            const u32x4 p0 = *(const u32x4*)(FIXP + (((size_t)grp * 2 + 0) * DFF + f) * 4);
            gm1 = (f32x4){FX_U2F(p0.z, 0), FX_U2F(p0.z, 1), FX_U2F(p0.w, 0), FX_U2F(p0.w, 1)};
            if (t >= 2) gm2 = tail1;
        }
#undef FX_U2F
        const f32x4 w0 = *(const f32x4*)(cw + f), w1 = *(const f32x4*)(cw + DFF + f), w2 = *(const f32x4*)(cw + 2 * DFF + f), bb = *(const f32x4*)(cb + f);
        float av[4];
#pragma unroll
        for (int q = 0; q < 4; ++q) { const float y = bb[q] + w0[q] * gm2[q] + w1[q] * gm1[q] + w2[q] * g0[q]; av[q] = y * __builtin_amdgcn_rcpf(1.f + __expf(-y)) * uu[q]; }
        *(unsigned long long*)(ACT + (size_t)row * DFF + f) = (unsigned long long)pk2(av[0], av[1]) | ((unsigned long long)pk2(av[2], av[3]) << 32);
    }
}

#define XB_TMO      128
#define XB_XCNT(j)  (256  + 64 * (j))
#define XB_XSUB(j)  (1280 + 64 * (j))
#define XB_XGEN(j)  (2304 + 64 * (j))
#define XB_TOP      3328
#define XB_TOPGEN   3392
#define XCD_BAR_WORDS 3456
#define XB_SPIN_CAP (1u << 18)

__device__ __forceinline__ unsigned xb_ld(unsigned* p)              { return __hip_atomic_load(p, __ATOMIC_RELAXED, __HIP_MEMORY_SCOPE_AGENT); }
__device__ __forceinline__ unsigned xb_add(unsigned* p, unsigned v) { return __hip_atomic_fetch_add(p, v, __ATOMIC_RELAXED, __HIP_MEMORY_SCOPE_AGENT); }
__device__ __forceinline__ unsigned xb_xcc_id() { return (unsigned)__builtin_amdgcn_s_getreg((3 << 11) | 20) & 0xFu; }
#define XB_SPIN(cond, bar) do { unsigned _sp = 0; while (cond) { __builtin_amdgcn_s_sleep(1); \
    if ((++_sp & 255u) == 0u) { if (xb_ld(&(bar)[XB_TMO])) break; if (_sp > XB_SPIN_CAP) { atomicAdd(&(bar)[XB_TMO], 1u); break; } } } } while (0)

struct XcdBarrier {
    unsigned* bar; unsigned x;
    volatile LAS unsigned* st;
};

__device__ __forceinline__ XcdBarrier xcd_barrier_post(unsigned* bar, volatile LAS unsigned* st) {
    XcdBarrier b; b.bar = bar; b.x = xb_xcc_id(); b.st = st;
    if (threadIdx.x == 0) (void)xb_add(&bar[XB_XCNT(b.x)], 1u);
    return b;
}
__device__ __forceinline__ void xcd_barrier_complete(unsigned* bar, unsigned x, unsigned& nloc, unsigned& nx) {
    const unsigned G = gridDim.x * gridDim.y * gridDim.z;
    unsigned sum, cnt, mine, sp = 0u;
    for (;;) {
        sum = 0u; cnt = 0u; mine = 0u;
#pragma unroll
        for (unsigned j = 0; j < 16; ++j) { const unsigned c = xb_ld(&bar[XB_XCNT(j)]); sum += c; cnt += (c > 0u) ? 1u : 0u; mine = (j == x) ? c : mine; }
        if (sum == G) break;
        __builtin_amdgcn_s_sleep(1);
        if ((++sp & 255u) == 0u) { if (xb_ld(&bar[XB_TMO])) break; if (sp > XB_SPIN_CAP) { atomicAdd(&bar[XB_TMO], 1u); break; } }
    }
    nloc = mine > 0u ? mine : 1u; nx = cnt > 0u ? cnt : 1u;
}

__device__ __forceinline__ void xcd_barrier(const XcdBarrier& b) {
    asm volatile("s_waitcnt vmcnt(0)" ::: "memory");
    __syncthreads();
    if (threadIdx.x == 0) {
        unsigned* bar = b.bar;
        __builtin_amdgcn_s_waitcnt(0);
        unsigned nloc = b.st[0], nx = b.st[1];
        if (nloc == 0u) { xcd_barrier_complete(bar, b.x, nloc, nx); b.st[0] = nloc; b.st[1] = nx; }
        const unsigned old = xb_add(&bar[XB_XSUB(b.x)], 1u);
        const unsigned gen = old / nloc;
        if (old + 1u == (gen + 1u) * nloc) {
            __builtin_amdgcn_fence(__ATOMIC_RELEASE, "agent");
            asm volatile("s_waitcnt vmcnt(0)" ::: "memory");
            const unsigned og = xb_add(&bar[XB_TOP], 1u);
            const unsigned tg = og / nx;
            if (og + 1u == (tg + 1u) * nx) xb_add(&bar[XB_TOPGEN], 1u);
            else XB_SPIN(xb_ld(&bar[XB_TOPGEN]) == tg, bar);
            __builtin_amdgcn_fence(__ATOMIC_ACQUIRE, "agent");
            xb_add(&bar[XB_XGEN(b.x)], 1u);
            asm volatile("s_waitcnt vmcnt(0)" ::: "memory");
        } else {
            XB_SPIN(xb_ld(&bar[XB_XGEN(b.x)]) == gen, bar);
            __builtin_amdgcn_fence(__ATOMIC_ACQUIRE, "agent");
            asm volatile("s_waitcnt vmcnt(0)" ::: "memory");
        }
    }
    __syncthreads();
}

#define GSYNC() do { TIC(12); xcd_barrier(xbar); TOC(12); } while (0)
__global__ void __launch_bounds__(512, 2) fwd_mega(Args a) {
    extern __shared__ __attribute__((aligned(16))) unsigned char lds[];
    cg::grid_group grid = cg::this_grid();
    const int tid0 = threadIdx.x, G = gridDim.x;
#define LAUNDER_TID() int tid = tid0; asm volatile("" : "+v"(tid))
    unsigned char* ws = a.ws;
    PG8_LAS unsigned char* ldsl = (PG8_LAS unsigned char*)lds;
    bf16_t* H = (bf16_t*)(ws + WS_H);
    float* MOD = (float*)(ws + WS_MOD);
    unsigned* ctl = (unsigned*)(ws + WS_CTL);
    unsigned long long tacc = 0;
    if (tid0 < 64) ((volatile LAS unsigned*)(lds + LDS_BYTES - 4096))[tid0] = 0u;
    __syncthreads();
    XcdBarrier xbar = xcd_barrier_post(ctl + 4096, (volatile LAS unsigned*)(lds + LDS_BYTES - 4096) + 8);

#ifndef SK_PRO
    { TIC(1); LAUNDER_TID(); prologue(a, lds, tid, G); TOC(1); }
#endif
    grid.sync();
#pragma unroll 1
    for (int layer = 0; layer < DEPTH; ++layer) {
        const float* xin = (layer == 0) ? a.in[0] : nullptr;
        bf16_t* XB = (bf16_t*)(ws + WS_XB); bf16_t* XA = (bf16_t*)(ws + WS_XA);
        const float* modl = MOD + (size_t)layer * NB * NMOD;
        const bf16_t* WT = (const bf16_t*)(ws + WS_WT) + (size_t)layer * WL_ELEMS;
#ifndef SK_N1
        if (layer == 0) { LAUNDER_TID(); cvec_phase(ws, tid, G); }
        { TIC(2); LAUNDER_TID(); norm_phase<true>(xin, XB, XB, H, a.in[4] + (size_t)layer * DM, modl, 0, DM, (const float*)(ws + WS_WFZ) + (size_t)layer * 6 * DM, a.in[8] + (size_t)layer * 6, (float*)(ws + WS_LOGF), tid, G); TOC(2); }
#endif
        GSYNC();
#ifndef SK_SCAN
        { LAUNDER_TID(); scan_phase((float*)(ws + WS_LOGF), lds, tid, G); }
#endif
        __syncthreads();
#ifndef SK_GIN
        { TIC(3); pg8::Gemm g{H, WT + WL_IN, MROWS, NIN, DM}; pg8::StaticOrder S; S.init(MROWS, NIN, G, (int)blockIdx.x);
          pg8::EpiIn E{(bf16_t*)(ws + WS_QKV), (const float*)(ws + WS_ROPEA), (const float*)(ws + WS_ROPEB)};
          pg8::gemm_phase<pg8::EpiIn, pg8::StaticOrder, true, true>(ldsl, g, S, E); TOC(3); }
#endif
        GSYNC();
#ifndef SK_ATT
        { TIC(4); LAUNDER_TID(); attn_phase(a, lds, tid, layer, tacc); TOC(4); }
#endif
        GSYNC();
#ifndef SK_CMB
        { TIC(5); LAUNDER_TID(); combine_phase(ws, tid, G); TOC(5); }
#endif
        GSYNC();
#ifndef SK_GOUT
        { TIC(6); pg8::Gemm g{(const bf16_t*)(ws + WS_O), WT + WL_OUT, MROWS, DM, DM}; pg8::StaticOrder S; S.init(MROWS, DM, G, (int)blockIdx.x);
          pg8::EpiRes<true> E{XB, XB, modl + 2 * DM, XA, (unsigned long long*)(ws + WS_SSQ) + (size_t)layer * MROWS, a.in[10] + (size_t)layer * DM, modl + 4 * DM};
          pg8::gemm_phase<pg8::EpiRes<true>, pg8::StaticOrder, true, true>(ldsl, g, S, E); TOC(6); }
#endif
        GSYNC();
#ifndef SK_GUP
        { TIC(8); pg8::Gemm g{XA, WT + WL_UP, MROWS, NUP, DM}; pg8::StaticOrder S; S.init(MROWS, NUP, G, (int)blockIdx.x);
          float* FX = (float*)(ws + WS_FIX);
          pg8::EpiUp E{(bf16_t*)(ws + WS_ACT), (unsigned char*)FX, (unsigned char*)FX + FIX_ELEMS * 4, a.in[12] + (size_t)layer * 3 * DFF, a.in[13] + (size_t)layer * DFF,
                       (const unsigned long long*)(ws + WS_SSQ) + (size_t)layer * MROWS, (const float*)(ws + WS_CUP) + (size_t)layer * NB * NUP};
          pg8::gemm_phase<pg8::EpiUp, pg8::StaticOrder, true, true>(ldsl, g, S, E); TOC(8); }
#endif
        GSYNC();
#ifndef SK_FIX
        { TIC(9); LAUNDER_TID(); fix_phase(ws, a.in[12] + (size_t)layer * 3 * DFF, a.in[13] + (size_t)layer * DFF, tid, G); TOC(9); }
#endif
        GSYNC();
#ifndef SK_GDN
        { TIC(10); pg8::Gemm g{(const bf16_t*)(ws + WS_ACT), WT + WL_DN, MROWS, DM, DFF}; pg8::StaticOrder S; S.init(MROWS, DM, G, (int)blockIdx.x);
          pg8::EpiRes<false> E{XB, XB, modl + 5 * DM, nullptr, nullptr, nullptr, nullptr};
          pg8::gemm_phase<pg8::EpiRes<false>, pg8::StaticOrder, true, true>(ldsl, g, S, E); TOC(10); }
#endif
        GSYNC();
    }
    { TIC(11); LAUNDER_TID(); final_norm((const bf16_t*)(ws + WS_XB), a.out, a.in[15], tid, G); TOC(11); }
    if (PROBE_MASK != 0 && blockIdx.x == 0) { const unsigned long long ts = __builtin_amdgcn_s_memrealtime(); while (__builtin_amdgcn_s_memrealtime() - ts < tacc) __builtin_amdgcn_s_sleep(8); }
}

extern "C" void kernel_launch(void* const* d_in, const int* in_sizes, int n_in, void* d_out, int out_size, void* d_ws, size_t ws_size, hipStream_t stream) {
    static int grid = 0;
    if (grid == 0) {
        if (n_in != 16 || ws_size < WS_END) { fprintf(stderr, "kernel_launch: unexpected inputs (n_in %d, ws %zu)\n", n_in, ws_size); grid = -1; return; }
        int dev = 0, cus = 0, per_cu = 0;
        hipGetDevice(&dev);
        hipDeviceGetAttribute(&cus, hipDeviceAttributeMultiprocessorCount, dev);
        hipFuncSetAttribute((const void*)fwd_mega, hipFuncAttributeMaxDynamicSharedMemorySize, LDS_BYTES);
        hipOccupancyMaxActiveBlocksPerMultiprocessor(&per_cu, (const void*)fwd_mega, 512, LDS_BYTES);
        if (per_cu < 1) per_cu = 1;
        (void)hipGetLastError();
        grid = cus * per_cu;
    }
    if (grid < 0) return;
    hipMemsetAsync((char*)d_ws + WS_CTL, 0, CTL_BYTES, stream);
    hipMemsetAsync((char*)d_ws + WS_SSQ, 0, (size_t)DEPTH * MROWS * 8, stream);
    Args a{};
    for (int i = 0; i < 16; ++i) a.in[i] = (const float*)d_in[i];
    a.out = (float*)d_out; a.ws = (unsigned char*)d_ws;
    void* args[] = {&a};
    hipError_t e = hipLaunchCooperativeKernel((const void*)fwd_mega, dim3(grid), dim3(512), args, LDS_BYTES, stream);
    if (e != hipSuccess) fprintf(stderr, "cooperative launch failed: %s (grid %d)\n", hipGetErrorString(e), grid);
}
```

```cpp
#include <hip/hip_runtime.h>
#include <hip/hip_cooperative_groups.h>
#include <cstdio>
#include <cstdint>
namespace cg = cooperative_groups;
namespace pg8 {
#define PG8_LAS __attribute__((address_space(3)))
typedef unsigned short bf16_t;
typedef short bf16x8 __attribute__((ext_vector_type(8)));
typedef float f32x4 __attribute__((ext_vector_type(4)));
typedef unsigned u32x4 __attribute__((ext_vector_type(4)));
constexpr int BM = 256, BK = 64, HALF = 128, HTB = HALF * BK * 2  , STAGE_BYTES = 8 * HTB, NXCD = 8, WGM = 8;

__host__ __device__ __forceinline__ int lds_byte(int r, int c) { const int st = (r >> 4) * 2 + (c >> 5), rr = r & 15, cc = c & 31, ob = rr * 64 + cc * 2; return st * 1024 + (ob ^ (((ob >> 9) & 1) << 5)); }
__host__ __device__ __forceinline__ void stage_rc(int b, int& R, int& C) { const int st = b / 1024, sb = b % 1024, swz = sb ^ (((sb >> 9) & 1) << 5); R = (st >> 1) * 16 + swz / 64; C = (st & 1) * 32 + (swz % 64) / 2; }
__host__ __device__ __forceinline__ int perm32(int rho) { const int n = rho >> 4, i = rho & 15; return 8 * (i >> 2) + 4 * n + (i & 3); }

struct Unit { int pm, pn; };
struct Gemm { const bf16_t* A; const bf16_t* Bt; int M, N, K; };

struct StaticOrder {
    int nM, nN, nwg, G, c;
    __host__ __device__ void init(int M, int N, int G_, int c_) { nM = M / BM; nN = N / BM; nwg = nM * nN; G = G_; c = c_; }
    __host__ __device__ bool next(int i, Unit& u) const {
        const long L = (long)i * G + c; if (L >= nwg) return false;
        int wgid = (int)L; { const int q = nwg / NXCD, r = nwg % NXCD, xcd = wgid % NXCD, off = wgid / NXCD; wgid = (xcd < r ? xcd * (q + 1) : r * (q + 1) + (xcd - r) * q) + off; }
        const int nig = WGM * nN, gid = wgid / nig, fm = gid * WGM, gsz = (nM - fm) < WGM ? (nM - fm) : WGM;
        u.pm = fm + ((wgid % nig) % gsz); u.pn = (wgid % nig) / gsz; return true;
    }
    __device__ __forceinline__ void a_ready(const Unit&) const {}
    __device__ __forceinline__ void done(const Unit&) const {}
};

__device__ __forceinline__ unsigned cvt_pk_bf16(float lo, float hi) { unsigned r; asm volatile("v_cvt_pk_bf16_f32 %0, %1, %2" : "=v"(r) : "v"(lo), "v"(hi)); return r; }
template <class Epi, class Sched, bool ALIGN_EPI = false, bool SP2 = false>
__device__ __forceinline__ void gemm_phase(PG8_LAS unsigned char* lds, const Gemm g, const Sched& S, const Epi& E) {
    int tid_l = threadIdx.x; asm volatile("" : "+v"(tid_l));
    const int tid = tid_l, wid = __builtin_amdgcn_readfirstlane(tid >> 6), lane = tid & 63, wr = wid >> 2, wc = wid & 3, fr = lane & 15, fq = lane >> 4;
    const int K = g.K, nt = K / BK;
    unsigned voffA[2], voffB[2];
#pragma unroll
    for (int i = 0; i < 2; ++i) { int R, C; stage_rc(tid * 16 + i * 8192, R, C); const int Rb = Epi::PERM ? ((R & ~31) + perm32(R & 31)) : R;
        voffA[i] = (unsigned)(R * K + C) * 2u; voffB[i] = (unsigned)(Rb * K + C) * 2u; }
    const size_t kstep = (size_t)(BK * 2);
    const size_t hstep = (size_t)HALF * K * 2;
    const size_t tstep = 2 * hstep;
    const unsigned ldsw = (unsigned)wid * 1024u;
    const int aoff = lds_byte(wr * 64 + fr, fq * 8), boff = lds_byte(wc * 32 + fr, fq * 8);
#define PG8_SA(b, h) (((b) * 2 + (h)) * HTB)
#define PG8_SB(b, h) ((4 + (b) * 2 + (h)) * HTB)
#define PG8_STAGE(bufoff, gbase, voff) do { _Pragma("unroll") for (int _i = 0; _i < 2; ++_i) \
        __builtin_amdgcn_global_load_lds((const unsigned*)((const char*)(gbase) + (voff)[_i]), (PG8_LAS unsigned*)(lds + (bufoff) + ldsw + _i * 8192), 16, 0, 0); } while (0)
#define PG8_LDA(dst, b, h) do { _Pragma("unroll") for (int m = 0; m < 4; ++m) _Pragma("unroll") for (int k = 0; k < 2; ++k) dst[m][k] = *(const PG8_LAS bf16x8*)(lds + PG8_SA(b, h) + aoff + m * 2048 + k * 1024); } while (0)
#define PG8_LDB(dst, b, h) do { _Pragma("unroll") for (int n = 0; n < 2; ++n) _Pragma("unroll") for (int k = 0; k < 2; ++k) dst[n][k] = *(const PG8_LAS bf16x8*)(lds + PG8_SB(b, h) + boff + n * 2048 + k * 1024); } while (0)
#define PG8_MMA(ai, bj, At, Bt) do { __builtin_amdgcn_s_setprio(1); _Pragma("unroll") for (int m = 0; m < 4; ++m) _Pragma("unroll") for (int n = 0; n < 2; ++n) _Pragma("unroll") for (int k = 0; k < 2; ++k) \
        acc[ai][bj][m][n] = __builtin_amdgcn_mfma_f32_16x16x32_bf16(Bt[n][k], At[m][k], acc[ai][bj][m][n], 0, 0, 0); __builtin_amdgcn_s_setprio(0); } while (0)
#define PG8_WAIT_V(n) asm volatile("s_waitcnt vmcnt(" #n ")" ::: "memory")
#define PG8_WAIT_L(n) asm volatile("s_waitcnt lgkmcnt(" #n ")" ::: "memory")
#define PG8_BAR __builtin_amdgcn_s_barrier()
#define PG8_SCHED __builtin_amdgcn_sched_barrier(0)
    Unit cur, nxt; int ui = 0;
    if (!S.next(0, cur)) return;
    f32x4 acc[2][2][4][2];
#pragma unroll
    for (int a = 0; a < 2; ++a)
#pragma unroll
        for (int b = 0; b < 2; ++b)
#pragma unroll
            for (int m = 0; m < 4; ++m)
#pragma unroll
                for (int n = 0; n < 2; ++n) acc[a][b][m][n] = (f32x4){0.f, 0.f, 0.f, 0.f};
    bf16x8 At[4][2], B0[2][2], B1[2][2];
    const char* cA = (const char*)g.A + (size_t)cur.pm * tstep; const char* cB = (const char*)g.Bt + (size_t)cur.pn * tstep;
    S.a_ready(cur);
    if constexpr (SP2) {
        PG8_STAGE(PG8_SB(0, 0), cB, voffB); PG8_STAGE(PG8_SB(0, 1), cB + hstep, voffB); PG8_STAGE(PG8_SA(0, 0), cA, voffA); PG8_STAGE(PG8_SA(0, 1), cA + hstep, voffA);
        if (wr == 1) PG8_BAR;
        PG8_WAIT_V(2); PG8_BAR;
        PG8_STAGE(PG8_SB(1, 0), cB + kstep, voffB); PG8_STAGE(PG8_SA(1, 0), cA + kstep, voffA); PG8_STAGE(PG8_SB(1, 1), cB + hstep + kstep, voffB);
        PG8_WAIT_V(6); PG8_BAR;
    } else {
        PG8_STAGE(PG8_SB(0, 0), cB, voffB); PG8_STAGE(PG8_SA(0, 0), cA, voffA); PG8_STAGE(PG8_SB(0, 1), cB + hstep, voffB); PG8_STAGE(PG8_SA(0, 1), cA + hstep, voffA);
        if (wr == 1) PG8_BAR;
        PG8_WAIT_V(4); PG8_BAR;
        PG8_STAGE(PG8_SB(1, 0), cB + kstep, voffB); PG8_STAGE(PG8_SA(1, 0), cA + kstep, voffA); PG8_STAGE(PG8_SB(1, 1), cB + hstep + kstep, voffB);
        PG8_WAIT_V(6); PG8_BAR;
    }
    for (;;) {
        const bool has_next = S.next(ui + 1, nxt);
        const char* nA = has_next ? (const char*)g.A + (size_t)nxt.pm * tstep : cA; const char* nB = has_next ? (const char*)g.Bt + (size_t)nxt.pn * tstep : cB;
        for (int t = 0; t < nt; t += 2) {
            const bool last = (t == nt - 2);
            const char* a1 = cA + (size_t)(t + 1) * kstep;
            const char* a2 = last ? nA : cA + (size_t)(t + 2) * kstep; const char* b2 = last ? nB : cB + (size_t)(t + 2) * kstep;
            const char* a3 = a2 + kstep; const char* b3 = b2 + kstep;
            if (last && has_next) S.a_ready(nxt);
            if constexpr (SP2) {
            PG8_LDB(B0, 0, 0); PG8_LDB(B1, 0, 1); PG8_SCHED; PG8_LDA(At, 0, 0); PG8_STAGE(PG8_SA(1, 1), a1 + hstep, voffA);
            PG8_WAIT_V(8); PG8_WAIT_L(0); PG8_BAR; PG8_MMA(0, 0, At, B0); PG8_MMA(0, 1, At, B1); PG8_BAR; PG8_SCHED;
            PG8_LDA(At, 0, 1); PG8_STAGE(PG8_SB(0, 0), b2, voffB); PG8_STAGE(PG8_SB(0, 1), b2 + hstep, voffB); PG8_STAGE(PG8_SA(0, 0), a2, voffA);
            PG8_WAIT_V(8); PG8_WAIT_L(0); PG8_BAR; PG8_MMA(1, 0, At, B0); PG8_MMA(1, 1, At, B1); PG8_BAR; PG8_SCHED;
            PG8_LDB(B0, 1, 0); PG8_LDB(B1, 1, 1); PG8_SCHED; PG8_LDA(At, 1, 0); PG8_STAGE(PG8_SA(0, 1), a2 + hstep, voffA);
            PG8_WAIT_V(8); PG8_WAIT_L(0); PG8_BAR; PG8_MMA(0, 0, At, B0); PG8_MMA(0, 1, At, B1); PG8_BAR; PG8_SCHED;
            PG8_LDA(At, 1, 1); PG8_STAGE(PG8_SB(1, 0), b3, voffB); PG8_STAGE(PG8_SB(1, 1), b3 + hstep, voffB); PG8_STAGE(PG8_SA(1, 0), a3, voffA);
            PG8_WAIT_V(8); PG8_WAIT_L(0); PG8_BAR; PG8_MMA(1, 0, At, B0); PG8_MMA(1, 1, At, B1); PG8_BAR; PG8_SCHED;
            } else {
            PG8_LDB(B0, 0, 0); PG8_SCHED; PG8_LDA(At, 0, 0); PG8_STAGE(PG8_SA(1, 1), a1 + hstep, voffA);
            PG8_WAIT_L(8); PG8_BAR; PG8_WAIT_L(0); PG8_MMA(0, 0, At, B0); PG8_BAR; PG8_SCHED;
            PG8_LDB(B1, 0, 1); PG8_STAGE(PG8_SB(0, 0), b2, voffB);
            PG8_BAR; PG8_WAIT_L(0); PG8_MMA(0, 1, At, B1); PG8_BAR;
            PG8_LDA(At, 0, 1); PG8_STAGE(PG8_SA(0, 0), a2, voffA);
            PG8_BAR; PG8_WAIT_L(0); PG8_MMA(1, 0, At, B0); PG8_BAR; PG8_SCHED;
            PG8_STAGE(PG8_SB(0, 1), b2 + hstep, voffB);
            PG8_WAIT_V(6); PG8_BAR; PG8_MMA(1, 1, At, B1); PG8_BAR;
            PG8_LDB(B0, 1, 0); PG8_SCHED; PG8_LDA(At, 1, 0); PG8_STAGE(PG8_SA(0, 1), a2 + hstep, voffA);
            PG8_WAIT_L(8); PG8_BAR; PG8_WAIT_L(0); PG8_MMA(0, 0, At, B0); PG8_BAR; PG8_SCHED;
            PG8_LDB(B1, 1, 1); PG8_STAGE(PG8_SB(1, 0), b3, voffB);
            PG8_BAR; PG8_WAIT_L(0); PG8_MMA(0, 1, At, B1); PG8_BAR;
            PG8_LDA(At, 1, 1); PG8_STAGE(PG8_SA(1, 0), a3, voffA);
            PG8_BAR; PG8_WAIT_L(0); PG8_MMA(1, 0, At, B0); PG8_BAR; PG8_SCHED;
            PG8_STAGE(PG8_SB(1, 1), b3 + hstep, voffB);
            PG8_WAIT_V(6); PG8_BAR; PG8_MMA(1, 1, At, B1); PG8_BAR;
            }
        }
        if constexpr (ALIGN_EPI) { if (wr == 0) PG8_BAR; }
        if constexpr (!Epi::AFTER_DRAIN) { E(acc, cur, wr, wc, fr, fq); S.done(cur); }
        if (!has_next) break;
#pragma unroll
        for (int a = 0; a < 2; ++a)
#pragma unroll
            for (int b = 0; b < 2; ++b)
#pragma unroll
                for (int m = 0; m < 4; ++m)
#pragma unroll
                    for (int n = 0; n < 2; ++n) acc[a][b][m][n] = (f32x4){0.f, 0.f, 0.f, 0.f};
        cur = nxt; cA = nA; cB = nB; ++ui;
        if constexpr (ALIGN_EPI) { if (wr == 1) PG8_BAR; }
    }
    PG8_WAIT_V(0);
    if constexpr (!ALIGN_EPI) { if (wr == 0) PG8_BAR; }
    PG8_BAR;
    if constexpr (Epi::AFTER_DRAIN) { E.fused(acc, cur, wr, wc, fr, fq, lds, wid, lane); S.done(cur); }
#undef PG8_SA
#undef PG8_SB
#undef PG8_STAGE
#undef PG8_LDA
#undef PG8_LDB
#undef PG8_MMA
#undef PG8_WAIT_V
#undef PG8_WAIT_L
#undef PG8_BAR
#undef PG8_SCHED
}
}

using pg8::bf16_t; using pg8::f32x4; using pg8::u32x4; using pg8::bf16x8;
typedef float f32x16 __attribute__((ext_vector_type(16)));
typedef short v4i16_t __attribute__((ext_vector_type(4)));
#define LAS __attribute__((address_space(3)))

constexpr int NB = 8, T = 8192, DM = 1024, DEPTH = 4, MROWS = NB * T;
constexpr int INC = 3078, NIN = 3072, DFF = 2816, NUP = 5632, NSLOT = 48, NMOD = 6 * DM;
constexpr float LOG2E = 1.4426950408889634f;
constexpr float QSC_A = 0.17677669529663687f * LOG2E;
constexpr float QSC_B = 0.125f * LOG2E;

constexpr size_t MiB = 1u << 20;
constexpr size_t WS_CTL = 0, CTL_BYTES = 1 * MiB;
constexpr size_t WS_WT = 2 * MiB;
constexpr size_t WL_IN = 0, WL_OUT = (size_t)NIN * DM, WL_UP = WL_OUT + (size_t)DM * DM, WL_DN = WL_UP + (size_t)NUP * DM, WL_ELEMS = WL_DN + (size_t)DM * DFF;
constexpr size_t WS_MOD = 102 * MiB;
constexpr size_t WS_ROPEA = 103 * MiB;
constexpr size_t WS_ROPEB = 104 * MiB;
constexpr size_t WS_WFZ = 106 * MiB;
constexpr size_t WS_LOGF = 107 * MiB;
constexpr size_t WS_LSEB = 109 * MiB;
constexpr size_t WS_XB = 116 * MiB;
constexpr size_t WS_H = 628 * MiB;
constexpr size_t WS_QKV = 244 * MiB;
constexpr size_t WS_ACT = WS_QKV;
constexpr size_t WS_O = 628 * MiB;
constexpr size_t WS_OBP = 756 * MiB;
constexpr size_t WS_FIX = WS_OBP;
constexpr size_t FIX_ELEMS = (size_t)1024 * 2 * DFF;
constexpr size_t WS_SSQ = 114 * MiB;
constexpr size_t WS_XA = 822 * MiB;
constexpr size_t WS_CUP = 950 * MiB;
constexpr size_t WS_END = 952 * MiB;
static_assert(WS_WT + WL_ELEMS * 2 * DEPTH <= WS_MOD, "weights fit");
static_assert(WS_FIX + 3 * FIX_ELEMS * 4 <= WS_XA && WS_XA + (size_t)65536 * 1024 * 2 <= WS_CUP, "fix / xa fit");

constexpr int LDS_BYTES = 147456;
constexpr int MISC_OFF = 131072;
constexpr int AT_K = 0, AT_V = 8192, AT_BIAS = 16384, AT_BUF = 17408, AT_WS = 2 * AT_BUF, AT_Q = AT_WS + 2048, AT_STASH = AT_Q + 32768;

struct Args { const float* in[16]; float* out; unsigned char* ws; };

__device__ __forceinline__ unsigned f2bf(float f) { unsigned u = __builtin_bit_cast(unsigned, f); return (u + 0x7fffu + ((u >> 16) & 1u)) >> 16; }
__device__ __forceinline__ unsigned pk2(float lo, float hi) { return f2bf(lo) | (f2bf(hi) << 16); }
__device__ __forceinline__ float bf2f(unsigned short h) { return __builtin_bit_cast(float, (unsigned)h << 16); }
typedef _Float16 h16x2 __attribute__((ext_vector_type(2))); typedef float f32x2v __attribute__((ext_vector_type(2)));
__device__ __forceinline__ unsigned f2h2(float lo, float hi) { const f32x2v v = {lo, hi}; const h16x2 h = __builtin_convertvector(v, h16x2); return __builtin_bit_cast(unsigned, h); }
__device__ __forceinline__ f32x2v h2f2(unsigned w) { const h16x2 h = __builtin_bit_cast(h16x2, w); return __builtin_convertvector(h, f32x2v); }
__device__ __forceinline__ float wave_sum(float v) {
#pragma unroll
    for (int o = 1; o < 64; o <<= 1) v += __shfl_xor(v, o);
    return v;
}
#define LDS_FENCE() asm volatile("s_waitcnt lgkmcnt(0)" ::: "memory")

namespace pg8 {
struct EpiIn {
    static constexpr bool PERM = true, AFTER_DRAIN = false;
    bf16_t* QKV; const float* ropeA; const float* ropeB;
    __device__ __forceinline__ void operator()(const f32x4 (&acc)[2][2][4][2], const Unit& u, int wr, int wc, int fr, int fq) const {
#pragma unroll
        for (int bj = 0; bj < 2; ++bj) {
            const int slot = 4 * u.pn + 2 * bj + (wc >> 1);
            const int c0 = 32 * (wc & 1) + 8 * fq;
            int kind = 0; float sc = 1.f;
            if (slot < 8) { kind = 1; if (slot < 4) sc = QSC_A; }
            else if (slot >= 12 && slot < 24) { kind = 2; if (slot < 18) sc = QSC_B; }
            else if (slot >= 30 && slot < 36) sc = QSC_B;
#pragma unroll
            for (int ai = 0; ai < 2; ++ai)
#pragma unroll
                for (int m = 0; m < 4; ++m) {
                    const int row = u.pm * BM + ai * HALF + wr * 64 + m * 16 + fr, b = row >> 13, t = row & (T - 1);
                    f32x4 v0 = acc[ai][bj][m][0], v1 = acc[ai][bj][m][1];
                    if (kind) {
                        const float* tb = (kind == 1) ? ropeA + ((size_t)t * 16 + 4 * fq) * 2 : ropeB + ((size_t)t * 32 + 16 * (wc & 1) + 4 * fq) * 2;
                        const f32x4 c01 = *(const f32x4*)tb, c23 = *(const f32x4*)(tb + 4);
                        f32x4 w0, w1;
                        w0[0] = v0[0] * c01[0] - v0[1] * c01[1]; w0[1] = v0[1] * c01[0] + v0[0] * c01[1];
                        w0[2] = v0[2] * c01[2] - v0[3] * c01[3]; w0[3] = v0[3] * c01[2] + v0[2] * c01[3];
                        w1[0] = v1[0] * c23[0] - v1[1] * c23[1]; w1[1] = v1[1] * c23[0] + v1[0] * c23[1];
                        w1[2] = v1[2] * c23[2] - v1[3] * c23[3]; w1[3] = v1[3] * c23[2] + v1[2] * c23[3];
                        v0 = w0; v1 = w1;
                    }
                    v0 = v0 * sc; v1 = v1 * sc;
                    u32x4 w; w.x = cvt_pk_bf16(v0[0], v0[1]); w.y = cvt_pk_bf16(v0[2], v0[3]); w.z = cvt_pk_bf16(v1[0], v1[1]); w.w = cvt_pk_bf16(v1[2], v1[3]);
                    const size_t sb = (size_t)(b * NSLOT + slot) * T * 64;
                    const size_t off = (kind == 1) ? sb + (size_t)(wc & 1) * T * 32 + (size_t)t * 32 + 8 * fq : sb + (size_t)t * 64 + c0;
                    __builtin_nontemporal_store(w, (u32x4*)(QKV + off));
                }
        }
    }
};
template <bool NORM> struct EpiRes {
    static constexpr bool PERM = true, AFTER_DRAIN = false;
    const bf16_t* bh; bf16_t* xo; const float* gate;
    bf16_t* XA; unsigned long long* ssq; const float* gnorm; const float* scale;
    __device__ __forceinline__ void operator()(const f32x4 (&acc)[2][2][4][2], const Unit& u, int wr, int wc, int fr, int fq) const {
        const int b = (u.pm * BM) >> 13;
        float sq[2][4];
#pragma unroll
        for (int ai = 0; ai < 2; ++ai)
#pragma unroll
            for (int m = 0; m < 4; ++m) sq[ai][m] = 0.f;
#pragma unroll
        for (int bj = 0; bj < 2; ++bj) {
            const int col = u.pn * BM + bj * HALF + wc * 32 + 8 * fq;
            const f32x4 g0 = *(const f32x4*)(gate + (size_t)b * NMOD + col), g1 = *(const f32x4*)(gate + (size_t)b * NMOD + col + 4);
            f32x4 a0 = (f32x4){0.f, 0.f, 0.f, 0.f}, a1 = a0;
            if (NORM) { a0 = *(const f32x4*)(gnorm + col) * (*(const f32x4*)(scale + (size_t)b * NMOD + col) + 1.0f); a1 = *(const f32x4*)(gnorm + col + 4) * (*(const f32x4*)(scale + (size_t)b * NMOD + col + 4) + 1.0f); }
#pragma unroll
            for (int ai = 0; ai < 2; ++ai)
#pragma unroll
                for (int m = 0; m < 4; ++m) {
                    const size_t off = (size_t)(u.pm * BM + ai * HALF + wr * 64 + m * 16 + fr) * DM + col;
                    const u32x4 r = *(const u32x4*)(bh + off);
                    const f32x2v q0 = h2f2(r.x), q1 = h2f2(r.y), q2 = h2f2(r.z), q3 = h2f2(r.w);
                    const f32x4 x0 = (f32x4){q0[0], q0[1], q1[0], q1[1]}, x1 = (f32x4){q2[0], q2[1], q3[0], q3[1]};
                    const f32x4 y0 = x0 + g0 * acc[ai][bj][m][0], y1 = x1 + g1 * acc[ai][bj][m][1];
                    { u32x4 w; w.x = f2h2(y0[0], y0[1]); w.y = f2h2(y0[2], y0[3]); w.z = f2h2(y1[0], y1[1]); w.w = f2h2(y1[2], y1[3]); *(u32x4*)(xo + off) = w; }
                    if (NORM) {
                        sq[ai][m] += ((y0[0] * y0[0] + y0[1] * y0[1]) + (y0[2] * y0[2] + y0[3] * y0[3])) + ((y1[0] * y1[0] + y1[1] * y1[1]) + (y1[2] * y1[2] + y1[3] * y1[3]));
                        const f32x4 z0 = y0 * a0, z1 = y1 * a1;
                        u32x4 w; w.x = cvt_pk_bf16(z0[0], z0[1]); w.y = cvt_pk_bf16(z0[2], z0[3]); w.z = cvt_pk_bf16(z1[0], z1[1]); w.w = cvt_pk_bf16(z1[2], z1[3]);
                        { const int row = u.pm * BM + ai * HALF + wr * 64 + m * 16 + fr;
                          const int prow = (row & ~63) | (16 * (row & 3) + ((row >> 2) & 15));
                          *(u32x4*)(XA + (size_t)prow * DM + col) = w; }
                    }
                }
        }
        if (NORM) {
#pragma unroll
            for (int ai = 0; ai < 2; ++ai)
#pragma unroll
                for (int m = 0; m < 4; ++m) {
                    float s = sq[ai][m]; s += __shfl_xor(s, 16); s += __shfl_xor(s, 32);
                    if (fq == 0) atomicAdd(ssq + (u.pm * BM + ai * HALF + wr * 64 + m * 16 + fr), (unsigned long long)(s * 16777216.f));
                }
        }
    }
};
struct EpiUp {
    static constexpr bool PERM = true, AFTER_DRAIN = false;
    bf16_t* ACT; unsigned char* FIXP; unsigned char* FIXT2; const float* cw; const float* cb; const unsigned long long* ssq; const float* cup;
    __device__ __forceinline__ void operator()(const f32x4 (&acc)[2][2][4][2], const Unit& u, int wr, int wc, int fr, int fq) const {
        const int lane = fq * 16 + fr;
        const int srcp = (lane & 48) | ((fr - 1) & 15);
        const float* cp = cup + (size_t)((u.pm * BM) >> 13) * NUP + u.pn * BM + wc * 32 + 8 * fq;
        f32x4 rsv[2];
#pragma unroll
        for (int ai = 0; ai < 2; ++ai) { const unsigned long long* sp = ssq + u.pm * BM + ai * HALF + wr * 64 + 4 * fr;
#pragma unroll
            for (int i = 0; i < 4; ++i) rsv[ai][i] = 1.0f / sqrtf((float)sp[i] * (1.f / (16777216.f * DM)) + 1e-6f); }
        unsigned long long keep[2][4];
#pragma unroll
        for (int hh = 0; hh < 2; ++hh) {
            const int f0 = u.pn * HALF + wc * 32 + 8 * fq + 4 * hh;
            const f32x4 w0 = *(const f32x4*)(cw + f0), w1 = *(const f32x4*)(cw + DFF + f0), w2 = *(const f32x4*)(cw + 2 * DFF + f0), bb = *(const f32x4*)(cb + f0);
            const f32x4 cu = *(const f32x4*)(cp + 4 * hh), cg = *(const f32x4*)(cp + HALF + 4 * hh);
#pragma unroll
            for (int ai = 0; ai < 2; ++ai) {
                const int tok0 = u.pm * BM + ai * HALF + wr * 64, grp = tok0 >> 6;
                f32x4 g[4], uu[4], pv3, pv2;
#pragma unroll
                for (int m = 0; m < 4; ++m) { g[m] = acc[ai][1][m][hh] * rsv[ai][m] + cg; uu[m] = acc[ai][0][m][hh] * rsv[ai][m] + cu; }
#pragma unroll
                for (int e = 0; e < 4; ++e) { pv3[e] = __shfl(g[3][e], srcp); pv2[e] = __shfl(g[2][e], srcp); }
#pragma unroll
                for (int j = 0; j < 2; ++j) {
                    const bool isT = (fr == 15);
                    const f32x4 sa = isT ? g[j + 2] : uu[j], sb = g[j];
                    u32x4 w; w.x = cvt_pk_bf16(sa[0], sa[1]); w.y = cvt_pk_bf16(sa[2], sa[3]); w.z = cvt_pk_bf16(sb[0], sb[1]); w.w = cvt_pk_bf16(sb[2], sb[3]);
                    unsigned char* dst = (isT ? FIXT2 : FIXP) + (((size_t)grp * 2 + j) * DFF + f0) * 4;
                    if (fr == 0 || fr == 15) *(u32x4*)dst = w;
                }
#pragma unroll
                for (int m = 0; m < 4; ++m) {
                    const f32x4 gm1 = (m == 0) ? pv3 : g[(m + 3) & 3], gm2 = (m == 0) ? pv2 : (m == 1) ? pv3 : g[(m + 2) & 3];
                    f32x4 av;
#pragma unroll
                    for (int e = 0; e < 4; ++e) {
                        const float y = bb[e] + w0[e] * gm2[e] + w1[e] * gm1[e] + w2[e] * g[m][e];
                        av[e] = y * __builtin_amdgcn_rcpf(1.f + __expf(-y)) * uu[m][e];
                    }
                    const int row = tok0 + 4 * fr + m;
                    const bool fixrow = (fr == 0) && (m < 2);
                    const unsigned long long pk = (unsigned long long)cvt_pk_bf16(av[0], av[1]) | ((unsigned long long)cvt_pk_bf16(av[2], av[3]) << 32);
                    if (hh == 0) keep[ai][m] = pk;
                    else if (!fixrow) { u32x4 w; w.x = (unsigned)keep[ai][m]; w.y = (unsigned)(keep[ai][m] >> 32); w.z = (unsigned)pk; w.w = (unsigned)(pk >> 32); __builtin_nontemporal_store(w, (u32x4*)(ACT + (size_t)row * DFF + f0 - 4)); }
                }
            }
        }
    }
};
}

template <int MAPK> __device__ __forceinline__ int colmap(int n) {
    if (MAPK == 1) {
        const int slot = n >> 6, c = n & 63;
        if (slot < 8) { const int m = c >> 5, cc = c & 31; return slot * 64 + m * 32 + ((cc & 1) ? (cc >> 1) + 16 : (cc >> 1)); }
        if (slot >= 12 && slot < 24) return slot * 64 + ((c & 1) ? (c >> 1) + 32 : (c >> 1));
        return n;
    }
    if (MAPK == 2) { const int pn = n >> 8, r = n & 255; return (r < 128) ? 128 * pn + r : DFF + 128 * pn + (r - 128); }
    return n;
}
template <int MAPK> __device__ __forceinline__ void transpose_item(const float* W, int K, int N, int ldw, bf16_t* WT, float* scr, int item, int lane) {
    const int nblk = N / 32, kb = item / nblk, nb = item % nblk, k0 = 64 * kb, n0 = 32 * nb;
    const int sc = colmap<MAPK>(n0 + (lane & 31));
    float tv[32];
#pragma unroll
    for (int i = 0; i < 32; ++i) tv[i] = W[(size_t)(k0 + 2 * i + (lane >> 5)) * ldw + sc];
#pragma unroll
    for (int i = 0; i < 32; ++i) scr[(2 * i + (lane >> 5)) * 33 + (lane & 31)] = tv[i];
    LDS_FENCE();
    const int c = lane & 7;
#pragma unroll
    for (int j = 0; j < 4; ++j) { const int n = (lane >> 3) + 8 * j; const float* s = scr + (8 * c) * 33 + n;
        u32x4 o; o.x = pk2(s[0 * 33], s[1 * 33]); o.y = pk2(s[2 * 33], s[3 * 33]); o.z = pk2(s[4 * 33], s[5 * 33]); o.w = pk2(s[6 * 33], s[7 * 33]);
        *(u32x4*)(WT + (size_t)(n0 + n) * K + k0 + 8 * c) = o; }
    LDS_FENCE();
}

__device__ __forceinline__ void prologue(const Args& a, unsigned char* lds, int tid, int G) {
    unsigned char* ws = a.ws;
    const int lane = tid & 63, wave = tid >> 6;
    const float* c_in = a.in[1]; const float* w_mod = a.in[2]; const float* b_mod = a.in[3];
    {
        float* sc = (float*)lds;
        float* red = (float*)(lds + 32768);
        for (int i = tid; i < NB * DM; i += 512) { const float v = c_in[i]; sc[i] = v / (1.f + __expf(-v)); }
        __syncthreads();
        float* MOD = (float*)(ws + WS_MOD);
        for (int item = blockIdx.x; item < DEPTH * (NMOD / 32); item += G) {
            const int l = item / (NMOD / 32), jb = item % (NMOD / 32), kg = tid >> 5, col = tid & 31;
            const float* wp = w_mod + ((size_t)l * DM + kg * 64) * NMOD + jb * 32 + col;
            float acc[8];
#pragma unroll
            for (int b = 0; b < 8; ++b) acc[b] = 0.f;
#pragma unroll 16
            for (int k = 0; k < 64; ++k) { const float w = wp[(size_t)k * NMOD];
#pragma unroll
                for (int b = 0; b < 8; ++b) acc[b] += sc[b * DM + kg * 64 + k] * w; }
#pragma unroll
            for (int b = 0; b < 8; ++b) red[(kg * 8 + b) * 32 + col] = acc[b];
            __syncthreads();
            if (tid < 256) { const int b = tid >> 5; float s = b_mod[(size_t)l * NMOD + jb * 32 + col];
#pragma unroll
              for (int g = 0; g < 16; ++g) s += red[(g * 8 + b) * 32 + col];
              MOD[((size_t)l * NB + b) * NMOD + jb * 32 + col] = s; }
            __syncthreads();
        }
    }
    __syncthreads();
    {
        const int gt = blockIdx.x * 512 + tid, NT_ = G * 512;
        float* RA = (float*)(ws + WS_ROPEA); float* RB = (float*)(ws + WS_ROPEB);
        for (int i = gt; i < T * 48; i += NT_) {
            const int t = i / 48, j = i % 48; const bool isA = j < 16; const int fi = isA ? j : j - 16; const float dim = isA ? 32.f : 64.f;
            const float e = (float)(2 * fi) / dim;
            const float pw = (float)exp2((double)e * 13.287712379549449);
            const float inv = 1.0f / pw;
            const float ang = (float)t * inv;
            const double x = (double)ang, k = rint(x * 0.15915494309189535);
            double r = fma(-k, 6.283185307179586, x); r = fma(-k, 2.4492935982947064e-16, r);
            const float rf = (float)r;
            const float cs = cosf(rf), sn = sinf(rf);
            float* dst = isA ? RA + ((size_t)t * 16 + fi) * 2 : RB + ((size_t)t * 32 + fi) * 2;
            dst[0] = cs; dst[1] = sn;
        }
        float* WFZ = (float*)(ws + WS_WFZ); const float* w_in = a.in[5];
        for (int i = gt; i < DEPTH * 6 * DM; i += NT_) { const int l = i / (6 * DM), r = i % (6 * DM), j = r / DM, k = r % DM; WFZ[i] = w_in[((size_t)l * DM + k) * INC + NIN + j]; }
    }
    {
        float* scr = (float*)(lds + wave * 16384);
        const int gw = blockIdx.x * 8 + wave, NGW = G * 8;
        constexpr int I_IN = (DM / 64) * (NIN / 32), I_OUT = (DM / 64) * (DM / 32), I_UP = (DM / 64) * (NUP / 32), I_DN = (DFF / 64) * (DM / 32), I_L = I_IN + I_OUT + I_UP + I_DN;
        for (int it = gw; it < DEPTH * I_L; it += NGW) {
            const int l = it / I_L; int r = it % I_L;
            bf16_t* WT = (bf16_t*)(ws + WS_WT) + (size_t)l * WL_ELEMS;
            if (r < I_IN) { transpose_item<1>(a.in[5] + (size_t)l * DM * INC, DM, NIN, INC, WT + WL_IN, scr, r, lane); continue; } r -= I_IN;
            if (r < I_OUT) { transpose_item<0>(a.in[9] + (size_t)l * DM * DM, DM, DM, DM, WT + WL_OUT, scr, r, lane); continue; } r -= I_OUT;
            if (r < I_UP) { transpose_item<2>(a.in[11] + (size_t)l * DM * NUP, DM, NUP, NUP, WT + WL_UP, scr, r, lane); continue; } r -= I_UP;
            transpose_item<0>(a.in[14] + (size_t)l * DFF * DM, DFF, DM, DM, WT + WL_DN, scr, r, lane);
        }
    }
}

template <bool FZ> __device__ __forceinline__ void norm_phase(const float* x, const bf16_t* xh, bf16_t* xcopy, bf16_t* H, const float* gw_, const float* modl, int shift_off, int scale_off,
                                                              const float* wfz, const float* fbias, float* LOGF, int tid, int G) {
    const int lane = tid & 63, wave = tid >> 6, gw = blockIdx.x * 8 + wave, NGW = G * 8;
    const int rpw = (MROWS + NGW - 1) / NGW;
    int r0 = gw * rpw, r1 = r0 + rpw; if (r1 > MROWS) r1 = MROWS;
    f32x4 A[4], B[4]; f32x4 wz[FZ ? 6 : 1][4]; float fb[6];
    if (FZ) {
#pragma unroll
        for (int j = 0; j < 6; ++j) { fb[j] = fbias[j];
#pragma unroll
            for (int q = 0; q < 4; ++q) wz[j][q] = *(const f32x4*)(wfz + j * DM + 4 * lane + 256 * q); }
    }
    int curb = -1;
    for (int r = r0; r < r1; ++r) {
        const int b = r >> 13;
        if (b != curb) { curb = b;
#pragma unroll
            for (int q = 0; q < 4; ++q) { const int c = 4 * lane + 256 * q; const f32x4 g4 = *(const f32x4*)(gw_ + c), s4 = *(const f32x4*)(modl + (size_t)b * NMOD + scale_off + c);
                A[q] = g4 * (s4 + 1.0f); B[q] = *(const f32x4*)(modl + (size_t)b * NMOD + shift_off + c); } }
        f32x4 v[4]; float s = 0.f;
        if (x) { const f32x4* xr = (const f32x4*)(x + (size_t)r * DM) + lane;
            unsigned long long* c8 = (unsigned long long*)(xcopy + (size_t)r * DM) + lane;
#pragma unroll
            for (int q = 0; q < 4; ++q) { v[q] = xr[64 * q]; c8[64 * q] = (unsigned long long)f2h2(v[q][0], v[q][1]) | ((unsigned long long)f2h2(v[q][2], v[q][3]) << 32); } }
        else { const unsigned long long* xr = (const unsigned long long*)(xh + (size_t)r * DM) + lane;
#pragma unroll
            for (int q = 0; q < 4; ++q) { const unsigned long long w = xr[64 * q]; const f32x2v a2 = h2f2((unsigned)w), b2 = h2f2((unsigned)(w >> 32));
                v[q] = (f32x4){a2[0], a2[1], b2[0], b2[1]}; } }
#pragma unroll
        for (int q = 0; q < 4; ++q) s += (v[q][0] * v[q][0] + v[q][1] * v[q][1]) + (v[q][2] * v[q][2] + v[q][3] * v[q][3]);
        const float rs = 1.0f / sqrtf(wave_sum(s) * (1.f / DM) + 1e-6f);
#pragma unroll
        for (int q = 0; q < 4; ++q) v[q] = v[q] * rs * A[q] + B[q];
        unsigned long long* o8 = (unsigned long long*)(H + (size_t)r * DM) + lane;
#pragma unroll
        for (int q = 0; q < 4; ++q) o8[64 * q] = (unsigned long long)pk2(v[q][0], v[q][1]) | ((unsigned long long)pk2(v[q][2], v[q][3]) << 32);
        if (FZ) {
            float z = 0.f;
#pragma unroll
            for (int j = 0; j < 6; ++j) { float d = 0.f;
#pragma unroll
                for (int q = 0; q < 4; ++q) d += (v[q][0] * wz[j][q][0] + v[q][1] * wz[j][q][1]) + (v[q][2] * wz[j][q][2] + v[q][3] * wz[j][q][3]);
                d = wave_sum(d) + fb[j]; if (lane == j) z = d; }
            if (lane < 6) { const float lf = fminf(z, 0.f) - log1pf(__expf(-fabsf(z))); LOGF[((size_t)b * 6 + lane) * T + (r & (T - 1))] = lf; }
        }
    }
}
__device__ __forceinline__ void final_norm(const bf16_t* xh, float* out, const float* g, int tid, int G) {
    const int lane = tid & 63, wave = tid >> 6, gw = blockIdx.x * 8 + wave, NGW = G * 8;
    f32x4 A[4];
#pragma unroll
    for (int q = 0; q < 4; ++q) A[q] = *(const f32x4*)(g + 4 * lane + 256 * q);
    for (int r = gw; r < MROWS; r += NGW) {
        const unsigned long long* xr = (const unsigned long long*)(xh + (size_t)r * DM) + lane;
        f32x4 v[4]; float s = 0.f;
#pragma unroll
        for (int q = 0; q < 4; ++q) { const unsigned long long w = xr[64 * q]; const f32x2v a2 = h2f2((unsigned)w), b2 = h2f2((unsigned)(w >> 32));
            v[q] = (f32x4){a2[0], a2[1], b2[0], b2[1]};
            s += (v[q][0] * v[q][0] + v[q][1] * v[q][1]) + (v[q][2] * v[q][2] + v[q][3] * v[q][3]); }
        const float rs = 1.0f / sqrtf(wave_sum(s) * (1.f / DM) + 1e-6f);
        f32x4* orow = (f32x4*)(out + (size_t)r * DM) + lane;
#pragma unroll
        for (int q = 0; q < 4; ++q) orow[64 * q] = v[q] * rs * A[q];
    }
}

__device__ __forceinline__ void cvec_phase(unsigned char* ws, int tid, int G) {
    const int lane = tid & 63, wave = tid >> 6, gw = blockIdx.x * 8 + wave, NGW = G * 8;
    const float* MOD = (const float*)(ws + WS_MOD); float* CUP = (float*)(ws + WS_CUP);
    for (int l = 0; l < DEPTH; ++l) {
        const bf16_t* WT = (const bf16_t*)(ws + WS_WT) + (size_t)l * WL_ELEMS + WL_UP;
        for (int n = gw; n < NUP; n += NGW) {
            const u32x4 w0 = *(const u32x4*)(WT + (size_t)n * DM + lane * 16), w1 = *(const u32x4*)(WT + (size_t)n * DM + lane * 16 + 8);
            float wv[16];
#pragma unroll
            for (int q = 0; q < 4; ++q) { wv[2 * q] = bf2f((unsigned short)(w0[q] & 0xffffu)); wv[2 * q + 1] = bf2f((unsigned short)(w0[q] >> 16)); wv[8 + 2 * q] = bf2f((unsigned short)(w1[q] & 0xffffu)); wv[8 + 2 * q + 1] = bf2f((unsigned short)(w1[q] >> 16)); }
            float mine = 0.f;
#pragma unroll
            for (int b = 0; b < NB; ++b) {
                const float* sp = MOD + ((size_t)l * NB + b) * NMOD + 3 * DM + lane * 16;
                float d = 0.f;
#pragma unroll
                for (int q = 0; q < 4; ++q) { const f32x4 s4 = *(const f32x4*)(sp + 4 * q); d += (s4[0] * wv[4 * q] + s4[1] * wv[4 * q + 1]) + (s4[2] * wv[4 * q + 2] + s4[3] * wv[4 * q + 3]); }
                d = wave_sum(d); if (lane == b) mine = d;
            }
            if (lane < NB) CUP[((size_t)l * NB + lane) * NUP + n] = mine;
        }
    }
}
__device__ __forceinline__ void scan_phase(float* LOGF, unsigned char* lds, int tid, int G) {
    float* wt = (float*)lds;
    for (int seq = blockIdx.x; seq < NB * 6; seq += G) {
        f32x4* p = (f32x4*)(LOGF + (size_t)seq * T) + tid * 4;
        f32x4 v[4]; float run = 0.f;
#pragma unroll
        for (int q = 0; q < 4; ++q) { v[q] = p[q];
#pragma unroll
            for (int i = 0; i < 4; ++i) { run += v[q][i]; v[q][i] = run; } }
        float inc = run;
        const int lane = tid & 63, wave = tid >> 6;
#pragma unroll
        for (int o = 1; o < 64; o <<= 1) { const float n = __shfl_up(inc, o); if (lane >= o) inc += n; }
        if (lane == 63) wt[wave] = inc;
        __syncthreads();
        float off = inc - run;
        for (int w = 0; w < wave; ++w) off += wt[w];
#pragma unroll
        for (int q = 0; q < 4; ++q) p[q] = (v[q] + off) * LOG2E;
        __syncthreads();
    }
}

__device__ __forceinline__ int crow(int r, int hi) { return (r & 3) + 8 * (r >> 2) + 4 * hi; }
typedef float f32x2_t __attribute__((ext_vector_type(2))); typedef __bf16 bf16x2_t __attribute__((ext_vector_type(2)));
__device__ __forceinline__ unsigned cvtpk(float lo, float hi) { f32x2_t v = {lo, hi}; bf16x2_t b = __builtin_convertvector(v, bf16x2_t); return __builtin_bit_cast(unsigned, b); }
__device__ __forceinline__ float max3f(float a, float b, float c) { float r; asm("v_max3_f32 %0, %1, %2, %3" : "=v"(r) : "v"(a), "v"(b), "v"(c)); return r; }
__device__ __forceinline__ float half_max(float m) { auto rr = __builtin_amdgcn_permlane32_swap(__float_as_uint(m), __float_as_uint(m), false, false); return fmaxf(__uint_as_float(rr[0]), __uint_as_float(rr[1])); }

template <int DK, int MODE>
__device__ __forceinline__ void attn_qk(const unsigned char* B, const unsigned char* qslot, int r32, int hi, int kfs, const bf16x8& qones, const f32x16& negm, f32x16& s0, f32x16& s1) {
    constexpr int ROWB = DK * 2, ND = DK / 16;
    bf16x8 kb0, kb1;
    if (MODE == 1) { kb0 = *(const bf16x8*)(B + AT_BIAS + r32 * 16); kb1 = *(const bf16x8*)(B + AT_BIAS + (32 + r32) * 16); }
#pragma unroll
    for (int h2 = 0; h2 < ND; h2 += 2) {
        bf16x8 kf[2][2], qf[2];
#pragma unroll
        for (int e = 0; e < 2; ++e) {
            const int d0 = h2 + e, ch = ((2 * d0 + hi) ^ kfs) << 4;
            kf[e][0] = *(const bf16x8*)(B + AT_K + r32 * ROWB + ch); kf[e][1] = *(const bf16x8*)(B + AT_K + (32 + r32) * ROWB + ch);
            qf[e] = *(const bf16x8*)(qslot + d0 * 1024);
        }
        __builtin_amdgcn_sched_barrier(0);
#pragma unroll
        for (int e = 0; e < 2; ++e) {
            if (h2 + e == 0) { s0 = __builtin_amdgcn_mfma_f32_32x32x16_bf16(kf[e][0], qf[e], negm, 0, 0, 0); s1 = __builtin_amdgcn_mfma_f32_32x32x16_bf16(kf[e][1], qf[e], negm, 0, 0, 0); }
            else { s0 = __builtin_amdgcn_mfma_f32_32x32x16_bf16(kf[e][0], qf[e], s0, 0, 0, 0); s1 = __builtin_amdgcn_mfma_f32_32x32x16_bf16(kf[e][1], qf[e], s1, 0, 0, 0); }
        }
    }
    if (MODE == 1) { s0 = __builtin_amdgcn_mfma_f32_32x32x16_bf16(kb0, qones, s0, 0, 0, 0); s1 = __builtin_amdgcn_mfma_f32_32x32x16_bf16(kb1, qones, s1, 0, 0, 0); }
}
template <int MODE>
__device__ __forceinline__ void attn_pv(bool fixn, const unsigned char* B, int key0, int qw, int qi, int r32, int hi, int vad0, int vad1, const bf16x8& ones, float* wsf,
                                        f32x16& p0, f32x16& p1, f32x16& n0, f32x16& n1, float& mref, f32x16& negm, f32x16& ol, f32x16& oa, f32x16& ob) {
    v4i16_t vl0[4], vh0[4], vl1[4], vh1[4];
#pragma unroll
    for (int j = 0; j < 2; ++j) {
        vl0[j] = __builtin_amdgcn_ds_read_tr16_b64_v4i16((LAS v4i16_t*)(B + vad0 + j * 2048)); vh0[j] = __builtin_amdgcn_ds_read_tr16_b64_v4i16((LAS v4i16_t*)(B + vad0 + j * 2048 + 1024));
        vl1[j] = __builtin_amdgcn_ds_read_tr16_b64_v4i16((LAS v4i16_t*)(B + vad1 + j * 2048)); vh1[j] = __builtin_amdgcn_ds_read_tr16_b64_v4i16((LAS v4i16_t*)(B + vad1 + j * 2048 + 1024));
    }
    if (MODE == 2) {
#pragma unroll
        for (int r = 0; r < 16; ++r) { const int dlt = qi - (key0 + crow(r, hi)); if (dlt < 0 || dlt > 128) p0[r] = -INFINITY; if (dlt - 32 < 0 || dlt - 32 > 128) p1[r] = -INFINITY; }
    } else if (key0 + 63 > qw) {
        asm volatile("" ::: "memory");
        const int lim = qi - key0 - 4 * hi;
#pragma unroll
        for (int r = 0; r < 16; ++r) { const int cr = (r & 3) + 8 * (r >> 2); if (cr > lim) p0[r] = -INFINITY; if (cr + 32 > lim) p1[r] = -INFINITY; }
    }
#define MX3(a, b, c) __builtin_fmaxf(__builtin_fmaxf((a), (b)), (c))
    float ra = MX3(p0[0], p0[1], p1[0]), rb = MX3(p0[2], p0[3], p1[1]); ra = MX3(ra, p1[2], p1[3]);
#pragma unroll
    for (int r = 4; r < 16; r += 4) { ra = MX3(ra, p0[r], p0[r + 1]); rb = MX3(rb, p0[r + 2], p0[r + 3]); ra = MX3(ra, p1[r], p1[r + 1]); rb = MX3(rb, p1[r + 2], p1[r + 3]); }
#undef MX3
    const float rm = half_max(__builtin_fmaxf(ra, rb));
    if (__any(rm > 8.f)) {
        const float dl = fmaxf(rm, 0.f); mref += dl;
#pragma unroll
        for (int r = 0; r < 16; ++r) { p0[r] -= dl; p1[r] -= dl; negm[r] = -mref; }
        if (fixn) {
#pragma unroll
            for (int r = 0; r < 16; ++r) { n0[r] -= dl; n1[r] -= dl; } }
        const float f = __builtin_amdgcn_exp2f(-dl);
        if (hi == 0) wsf[r32] = f;
        LDS_FENCE();
#pragma unroll
        for (int g = 0; g < 4; ++g) { const f32x4 fv = *(const f32x4*)(wsf + 8 * g + 4 * hi);
#pragma unroll
            for (int i = 0; i < 4; ++i) { oa[4 * g + i] *= fv[i]; ob[4 * g + i] *= fv[i]; ol[4 * g + i] *= fv[i]; } }
        LDS_FENCE();
    }
#pragma unroll
    for (int r = 0; r < 16; ++r) { p0[r] = __builtin_amdgcn_exp2f(p0[r]); p1[r] = __builtin_amdgcn_exp2f(p1[r]); }
#pragma unroll
    for (int j = 0; j < 4; ++j) {
        u32x4 pw;
        if (j < 2) { const int bs = 8 * (j & 1); pw = (u32x4){cvtpk(p0[bs], p0[bs + 1]), cvtpk(p0[bs + 2], p0[bs + 3]), cvtpk(p0[bs + 4], p0[bs + 5]), cvtpk(p0[bs + 6], p0[bs + 7])}; }
        else { const int bs = 8 * (j & 1); pw = (u32x4){cvtpk(p1[bs], p1[bs + 1]), cvtpk(p1[bs + 2], p1[bs + 3]), cvtpk(p1[bs + 4], p1[bs + 5]), cvtpk(p1[bs + 6], p1[bs + 7])}; }
        const bf16x8 pa = __builtin_bit_cast(bf16x8, pw);
        if (j < 2) {
            vl0[j + 2] = __builtin_amdgcn_ds_read_tr16_b64_v4i16((LAS v4i16_t*)(B + vad0 + (j + 2) * 2048)); vh0[j + 2] = __builtin_amdgcn_ds_read_tr16_b64_v4i16((LAS v4i16_t*)(B + vad0 + (j + 2) * 2048 + 1024));
            vl1[j + 2] = __builtin_amdgcn_ds_read_tr16_b64_v4i16((LAS v4i16_t*)(B + vad1 + (j + 2) * 2048)); vh1[j + 2] = __builtin_amdgcn_ds_read_tr16_b64_v4i16((LAS v4i16_t*)(B + vad1 + (j + 2) * 2048 + 1024));
        }
        { const bf16x8 vf = (bf16x8){vl0[j][0], vl0[j][1], vl0[j][2], vl0[j][3], vh0[j][0], vh0[j][1], vh0[j][2], vh0[j][3]};
          oa = __builtin_amdgcn_mfma_f32_32x32x16_bf16(pa, vf, oa, 0, 0, 0); }
        { const bf16x8 vf = (bf16x8){vl1[j][0], vl1[j][1], vl1[j][2], vl1[j][3], vh1[j][0], vh1[j][1], vh1[j][2], vh1[j][3]};
          ob = __builtin_amdgcn_mfma_f32_32x32x16_bf16(pa, vf, ob, 0, 0, 0); }
        ol = __builtin_amdgcn_mfma_f32_32x32x16_bf16(pa, ones, ol, 0, 0, 0);
    }
}

template <int DK, int MODE>
__device__ __forceinline__ void attn_core(unsigned char* lds, int tid_in, const bf16_t* Qg, long qrs, const bf16_t* Kg, long krs, const bf16_t* Vg, long vrs,
                                          const float* Fg, float fref, int q0, int kt_lo, int kt_hi, int korg,
                                          float& mref_out, f32x16& ol_out, f32x16& o0, f32x16& o1) {
    constexpr int ROWB = DK * 2, ND = DK / 16;
    int tid = tid_in; asm volatile("" : "+v"(tid));
    const int lane = tid & 63, wid = __builtin_amdgcn_readfirstlane(tid >> 6), r32 = lane & 31, hi = lane >> 5;
    const int qw = q0 + 32 * wid, qi = qw + r32;
    unsigned char* qslot = lds + AT_Q + wid * 4096 + lane * 16;
#pragma unroll
    for (int d0 = 0; d0 < ND; ++d0) *(bf16x8*)(qslot + d0 * 1024) = *(const bf16x8*)(Qg + (long)qi * qrs + d0 * 16 + hi * 8);
    f32x16 oa, ob, ol, negm, sa0, sa1, sb0, sb1;
#pragma unroll
    for (int r = 0; r < 16; ++r) { oa[r] = 0.f; ob[r] = 0.f; ol[r] = 0.f; negm[r] = 0.f; sa0[r] = 0.f; sa1[r] = 0.f; sb0[r] = 0.f; sb1[r] = 0.f; }
    float mref = 0.f;
    float* wsf = (float*)(lds + AT_WS + wid * 256);
    const bf16x8 ones = (bf16x8){0x3F80, 0x3F80, 0x3F80, 0x3F80, 0x3F80, 0x3F80, 0x3F80, 0x3F80};
    const bf16x8 qones = hi ? (bf16x8){0, 0, 0, 0, 0, 0, 0, 0} : (bf16x8){0x3F80, 0x3F80, 0x3F80, 0, 0, 0, 0, 0};
    const int krow = (DK == 64) ? (tid >> 3) : ((tid & 255) >> 2), kch = (DK == 64) ? (tid & 7) : (tid & 3);
    const int kswz = (DK == 64) ? ((krow >> 1) & 7) : ((krow >> 2) & 3);
    const bool kact = (DK == 64) || (tid < 256);
    const int vrow = tid >> 3, vch = tid & 7, vswz = (vrow & 2) << 1;
    const int koff = AT_K + krow * ROWB + ((kch ^ kswz) << 4), voff = AT_V + vrow * 128 + ((vch ^ vswz) << 4);
    const bf16_t* kptr = Kg + (long)(korg + 64 * kt_lo + krow) * krs + kch * 8; const bf16_t* vptr = Vg + (long)(korg + 64 * kt_lo + vrow) * vrs + vch * 8; const float* fptr = Fg + korg + 64 * kt_lo + (tid & 63);
    const int NT = kt_hi - kt_lo;
    u32x4 kreg0 = (u32x4){0u, 0u, 0u, 0u}, vreg0 = kreg0, kreg1 = kreg0, vreg1 = kreg0; float breg0 = 0.f, breg1 = 0.f;
#define AT_LOADK(S, i) do { if (kact) kreg##S = *(const u32x4*)(kptr + (long)(64 * (i)) * krs); if (MODE == 1 && tid < 64) breg##S = fref - fptr[64 * (i)]; } while (0)
#define AT_LOADV(S, i) do { vreg##S = *(const u32x4*)(vptr + (long)(64 * (i)) * vrs); } while (0)
#define AT_STOREK(S, buf) do { unsigned char* B_ = lds + (buf) * AT_BUF; if (kact) *(u32x4*)(B_ + koff) = kreg##S; \
        if (MODE == 1 && tid < 64) { const unsigned bh_ = f2bf(breg##S); const float r1_ = breg##S - __builtin_bit_cast(float, bh_ << 16); const unsigned bm_ = f2bf(r1_); \
            const float r2_ = r1_ - __builtin_bit_cast(float, bm_ << 16); const unsigned bl_ = f2bf(r2_); \
            *(u32x4*)(B_ + AT_BIAS + tid * 16) = (u32x4){bh_ | (bm_ << 16), bl_, 0u, 0u}; } } while (0)
#define AT_STOREV(S, buf) do { *(u32x4*)(lds + (buf) * AT_BUF + voff) = vreg##S; } while (0)
    const int kfs = (DK == 64) ? ((r32 >> 1) & 7) : ((r32 >> 2) & 3);
    const int q4 = (lane & 15) >> 2, p4 = lane & 3, dh = (lane >> 4) & 1;
    const int vs = (q4 & 2) >> 1;
    const int vbase = AT_V + (4 * hi + q4) * 128 + (p4 & 1) * 8;
    const int vc = 2 * dh + (p4 >> 1);
    const int vad0 = vbase + ((((0 ^ vs) << 2) | vc) << 4), vad1 = vbase + ((((1 ^ vs) << 2) | vc) << 4);
    const int kbase0 = 64 * kt_lo + korg;
#define AT_ACTIVE(i) ((MODE == 2) ? !((kbase0 + 64 * (i)) > qw + 31 || (kbase0 + 64 * (i)) + 63 < qw - 128) : !((kbase0 + 64 * (i)) > qw + 31))

    AT_LOADK(0, 0); AT_LOADV(0, 0); if (NT > 1) AT_LOADK(1, 1);
    AT_STOREK(0, 0); AT_STOREV(0, 0); if (NT > 1) AT_STOREK(1, 1);
    if (NT > 2) AT_LOADK(0, 2); if (NT > 3) AT_LOADK(1, 3); if (NT > 1) AT_LOADV(0, 1); if (NT > 2) AT_LOADV(1, 2);
    __syncthreads();
    if (AT_ACTIVE(0)) attn_qk<DK, MODE>(lds, qslot, r32, hi, kfs, qones, negm, sa0, sa1);
    __syncthreads();
#define AT_ITER(i, PAR, C0, C1, N0, N1) do { \
          \
        if ((i) + 2 < NT) AT_STOREK(PAR, PAR); \
        if ((i) + 1 < NT) AT_STOREV(PAR, 1 - (PAR)); \
        if ((i) + 4 < NT) AT_LOADK(PAR, (i) + 4); \
        if ((i) + 3 < NT) AT_LOADV(PAR, (i) + 3); \
        const bool an_ = ((i) + 1 < NT) && AT_ACTIVE((i) + 1); \
        if (an_) attn_qk<DK, MODE>(lds + (1 - (PAR)) * AT_BUF, qslot, r32, hi, kfs, qones, negm, N0, N1); \
        if (AT_ACTIVE(i)) attn_pv<MODE>(true, lds + (PAR) * AT_BUF, kbase0 + 64 * (i), qw, qi, r32, hi, vad0, vad1, ones, wsf, C0, C1, N0, N1, mref, negm, ol, oa, ob); \
        __syncthreads(); } while (0)
    for (int i = 0; i < NT; i += 2) {
        AT_ITER(i, 0, sa0, sa1, sb0, sb1);
        if (i + 1 >= NT) break;
        AT_ITER(i + 1, 1, sb0, sb1, sa0, sa1);
    }
#undef AT_ITER
#undef AT_LOADK
#undef AT_LOADV
#undef AT_STOREK
#undef AT_STOREV
#undef AT_ACTIVE
    mref_out = mref; ol_out = ol; o0 = oa; o1 = ob;
}


constexpr int ATB_WS = 6 * AT_BUF, ATB_Q = ATB_WS + 2048;
static_assert(ATB_Q + 32768 <= LDS_BYTES - 4096, "B-unit LDS map");
__device__ __forceinline__ void attn_core_band(unsigned char* lds, int tid_in, const bf16_t* Qg, const bf16_t* Kg, const bf16_t* Vg, long rs, int q0, int kt_lo, int korg,
                                               float& mref_out, f32x16& ol_out, f32x16& o0, f32x16& o1) {
    int tid = tid_in; asm volatile("" : "+v"(tid));
    const int lane = tid & 63, wid = __builtin_amdgcn_readfirstlane(tid >> 6), r32 = lane & 31, hi = lane >> 5;
    const int qw = q0 + 32 * wid, qi = qw + r32;
    unsigned char* qslot = lds + ATB_Q + wid * 4096 + lane * 16;
#pragma unroll
    for (int d0 = 0; d0 < 4; ++d0) *(bf16x8*)(qslot + d0 * 1024) = *(const bf16x8*)(Qg + (long)qi * rs + d0 * 16 + hi * 8);
    const int krow = tid >> 3, kch = tid & 7, kswz = (krow >> 1) & 7, vswz = (krow & 2) << 1;
    const int koff = AT_K + krow * 128 + ((kch ^ kswz) << 4), voff = AT_V + krow * 128 + ((kch ^ vswz) << 4);
    const int NT = 6 - kt_lo;
    const bf16_t* kptr = Kg + (long)(korg + 64 * kt_lo + krow) * rs + kch * 8; const bf16_t* vptr = Vg + (long)(korg + 64 * kt_lo + krow) * rs + kch * 8;
    u32x4 kr[6], vr[6];
#pragma unroll
    for (int i = 0; i < 6; ++i) if (i < NT) { kr[i] = *(const u32x4*)(kptr + (long)(64 * i) * rs); vr[i] = *(const u32x4*)(vptr + (long)(64 * i) * rs); }
#pragma unroll
    for (int i = 0; i < 6; ++i) if (i < NT) { *(u32x4*)(lds + i * AT_BUF + koff) = kr[i]; *(u32x4*)(lds + i * AT_BUF + voff) = vr[i]; }
    f32x16 oa, ob, ol, negm, s0, s1;
#pragma unroll
    for (int r = 0; r < 16; ++r) { oa[r] = 0.f; ob[r] = 0.f; ol[r] = 0.f; negm[r] = 0.f; s0[r] = 0.f; s1[r] = 0.f; }
    float mref = 0.f;
    float* wsf = (float*)(lds + ATB_WS + wid * 256);
    const bf16x8 ones = (bf16x8){0x3F80, 0x3F80, 0x3F80, 0x3F80, 0x3F80, 0x3F80, 0x3F80, 0x3F80};
    const bf16x8 qones = (bf16x8){0, 0, 0, 0, 0, 0, 0, 0};
    const int kfs = (r32 >> 1) & 7;
    const int q4 = (lane & 15) >> 2, p4 = lane & 3, dh = (lane >> 4) & 1, vs = (q4 & 2) >> 1;
    const int vbase = AT_V + (4 * hi + q4) * 128 + (p4 & 1) * 8, vc = 2 * dh + (p4 >> 1);
    const int vad0 = vbase + ((((0 ^ vs) << 2) | vc) << 4), vad1 = vbase + ((((1 ^ vs) << 2) | vc) << 4);
    const int kbase0 = 64 * kt_lo + korg;
    __syncthreads();
    for (int i = 0; i < NT; ++i) {
        const int key0 = kbase0 + 64 * i;
        if (!(key0 > qw + 31 || key0 + 63 < qw - 128)) {
            attn_qk<64, 2>(lds + i * AT_BUF, qslot, r32, hi, kfs, qones, negm, s0, s1);
            attn_pv<2>(false, lds + i * AT_BUF, key0, qw, qi, r32, hi, vad0, vad1, ones, wsf, s0, s1, s0, s1, mref, negm, ol, oa, ob);
        }
    }
    mref_out = mref; ol_out = ol; o0 = oa; o1 = ob;
}

__device__ __forceinline__ void row_bcast(float* wsf, float val, int r32, int hi, float (&out)[16]) {
    LDS_FENCE();
    if (hi == 0) wsf[r32] = val;
    LDS_FENCE();
#pragma unroll
    for (int g = 0; g < 4; ++g) { const f32x4 fv = *(const f32x4*)(wsf + 8 * g + 4 * hi);
#pragma unroll
        for (int i = 0; i < 4; ++i) out[4 * g + i] = fv[i]; }
    LDS_FENCE();
}

#ifndef PROBE_MASK
#define PROBE_MASK 0
#endif
#define TIC(id) unsigned long long t0_##id = 0; if ((PROBE_MASK >> (id)) & 1) t0_##id = __builtin_amdgcn_s_memrealtime()
#define TOC(id) if ((PROBE_MASK >> (id)) & 1) tacc += __builtin_amdgcn_s_memrealtime() - t0_##id
#define STG_BASE(stg) bf16_t* sp_; { int l_ = lane; asm volatile("" : "+v"(l_)); sp_ = (stg) + (l_ >> 5) * 256 + (l_ & 31); }
#define STG_PUT(r, a, b) do { const int o_ = (((r) & 3) + 8 * ((r) >> 2)) * 64; sp_[o_] = (bf16_t)f2bf(a); sp_[o_ + 32] = (bf16_t)f2bf(b); } while (0)
__device__ __forceinline__ void stage_flush(const bf16_t* stg, int lane_in, bf16_t* gbase, long grs) {
    int lane = lane_in; asm volatile("" : "+v"(lane));
    LDS_FENCE();
#pragma unroll
    for (int i = 0; i < 4; ++i) { const int row = i * 8 + (lane >> 3), ch = lane & 7; const u32x4 w = *(const u32x4*)(stg + row * 64 + ch * 8); *(u32x4*)(gbase + (long)row * grs + ch * 8) = w; }
    LDS_FENCE();
}

constexpr int N_AC = 32 * 80, N_BU = 3 * NB * 6 * 32, N_UNITS = N_AC + N_BU;

__device__ __forceinline__ void attn_phase(const Args& a, unsigned char* lds, int tid, int layer, unsigned long long& tacc) {
    unsigned char* ws = a.ws;
    const bf16_t* QKV = (const bf16_t*)(ws + WS_QKV);
    bf16_t* O = (bf16_t*)(ws + WS_O);
    bf16_t* OBP = (bf16_t*)(ws + WS_OBP);
    float* LSEB = (float*)(ws + WS_LSEB);
    const float* F2 = (const float*)(ws + WS_LOGF);
    const int lane = tid & 63, wid = __builtin_amdgcn_readfirstlane(tid >> 6), r32 = lane & 31, hi = lane >> 5;
    float* wsf = (float*)(lds + AT_WS + wid * 256);
    bf16_t* stg = (bf16_t*)(lds + AT_Q + wid * 4096);
    const float lam_init = 0.8f - 0.6f * __expf(-0.3f * (float)layer);
    float lam;
    { const float* lp = a.in[6] + (size_t)layer * 128; float s1 = 0.f, s2 = 0.f; if (lane < 32) { s1 = lp[lane] * lp[32 + lane]; s2 = lp[64 + lane] * lp[96 + lane]; }
      s1 = wave_sum(s1); s2 = wave_sum(s2); lam = expf(s1) - expf(s2) + lam_init; }
    const int G = gridDim.x, bx = blockIdx.x;
    const int vcu = (G % 8 == 0) ? (bx % 8) * (G / 8) + bx / 8 : bx;
    for (int it = vcu; it < 256 * 28; it += G) {
        const int s = it & 255, step = it >> 8, team = s >> 5, c = s & 31;
        int u;
        if (step < 6) { const int hd = team * 6 + step, qb = (step & 1) ? 31 - c : c; u = (31 - qb) * 80 + hd; }
        else if (step < 10) { const int st = step - 6, hd = team * 4 + st, qb = (st & 1) ? 31 - c : c; u = (31 - qb) * 80 + 48 + hd; }
        else { const int k = step - 10, hd = team * 6 + k / 3, p = k % 3; u = N_AC + ((p * 48 + hd) << 5) + c; }
        __syncthreads();
        float mref; f32x16 ol, o0, o1;
        if (u < N_AC) {
            const int qb = 31 - u / 80, j = u % 80, q0 = qb * 256;
            if (j < 48) {
#ifndef NO_VC
                TIC(13);
                const int b = j / 6, h = j % 6;
                const bf16_t* Qg = QKV + (size_t)(b * NSLOT + 30 + h) * T * 64; const bf16_t* Kg = QKV + (size_t)(b * NSLOT + 36 + h) * T * 64; const bf16_t* Vg = QKV + (size_t)(b * NSLOT + 42 + h) * T * 64;
                const float* Fg = F2 + (size_t)(b * 6 + h) * T;
                attn_core<64, 1>(lds, tid, Qg, 64, Kg, 64, Vg, 64, Fg, Fg[q0], q0, 0, 4 * qb + 4, 0, mref, ol, o0, o1);
                STG_BASE(stg);
#pragma unroll
                for (int r = 0; r < 16; ++r) { const float rl = __builtin_amdgcn_rcpf(ol[r]); STG_PUT(r, o0[r] * rl, o1[r] * rl); }
                stage_flush(stg, lane, O + (size_t)(b * T + q0 + 32 * wid) * DM + 640 + h * 64, DM);
                TOC(13);
#endif
            } else {
#ifndef NO_VA
                const int jj = j - 48, b = jj / 4, h = jj % 4;
                const bf16_t* Qg = QKV + (size_t)(b * NSLOT + h) * T * 64; const bf16_t* Kg = QKV + (size_t)(b * NSLOT + 4 + h) * T * 64; const bf16_t* Vg = QKV + (size_t)(b * NSLOT + 8 + h) * T * 64;
                attn_core<32, 0>(lds, tid, Qg, 32, Kg, 32, Vg, 64, nullptr, 0.f, q0, 0, 4 * qb + 4, 0, mref, ol, o0, o1);
                float* stash = (float*)(lds + AT_STASH + wid * 8192) + lane;
#pragma unroll
                for (int r = 0; r < 16; ++r) { const float rl = __builtin_amdgcn_rcpf(ol[r]); stash[r * 64] = o0[r] * rl; stash[(16 + r) * 64] = o1[r] * rl; }
                attn_core<32, 0>(lds, tid, Qg + (size_t)T * 32, 32, Kg + (size_t)T * 32, 32, Vg, 64, nullptr, 0.f, q0, 0, 4 * qb + 4, 0, mref, ol, o0, o1);
                const float* sg = a.in[7] + (size_t)layer * 64;
                const float g0 = sg[r32] * (1.0f - lam_init), g1 = sg[32 + r32] * (1.0f - lam_init);
                STG_BASE(stg);
#pragma unroll
                for (int r = 0; r < 16; ++r) {
                    const float rl = __builtin_amdgcn_rcpf(ol[r]);
                    const float a0 = stash[r * 64] - lam * (o0[r] * rl), a1 = stash[(16 + r) * 64] - lam * (o1[r] * rl);
                    float ss = a0 * a0 + a1 * a1;
                    ss += __shfl_xor(ss, 1); ss += __shfl_xor(ss, 2); ss += __shfl_xor(ss, 4); ss += __shfl_xor(ss, 8); ss += __shfl_xor(ss, 16);
                    const float rs = 1.0f / sqrtf(ss * (1.f / 64.f) + 1e-5f);
                    STG_PUT(r, a0 * rs * g0, a1 * rs * g1);
                }
                stage_flush(stg, lane, O + (size_t)(b * T + q0 + 32 * wid) * DM + h * 64, DM);
#endif
            }
        } else {
#ifndef NO_VB
            TIC(15);
            const int v = u - N_AC, k = v & 31, bhp = v >> 5, h = bhp % 6, b = (bhp / 6) % NB, p = bhp / (6 * NB);
            const int d = (p == 0) ? 1 : (p == 1) ? 4 : 16, bpc = 32 / d, cls = k / bpc, nb = k % bpc, q0 = nb * 256;
            const bf16_t* Qg = QKV + ((size_t)(b * NSLOT + 12 + h) * T + cls) * 64; const bf16_t* Kg = QKV + ((size_t)(b * NSLOT + 18 + h) * T + cls) * 64; const bf16_t* Vg = QKV + ((size_t)(b * NSLOT + 24 + h) * T + cls) * 64;
            const long rs_ = (long)d * 64;
            attn_core_band(lds, tid, Qg, Kg, Vg, rs_, q0, (nb == 0) ? 2 : 0, q0 - 128, mref, ol, o0, o1);
            float mr[16];
            row_bcast((float*)(lds + ATB_WS + wid * 256), mref, r32, hi, mr);
            const size_t pb = ((size_t)(p * NB + b) * 6 + h) * T;
            bf16_t* stgb = (bf16_t*)(lds + ATB_Q + wid * 4096);
            STG_BASE(stgb);
#pragma unroll
            for (int r = 0; r < 16; ++r) {
                const size_t tok = pb + cls + (size_t)d * (q0 + 32 * wid + crow(r, hi));
                const float rl = __builtin_amdgcn_rcpf(ol[r]);
                if (r32 == 0) LSEB[tok] = mr[r] + __log2f(ol[r]);
                STG_PUT(r, o0[r] * rl, o1[r] * rl);
            }
            stage_flush(stgb, lane, OBP + (pb + cls + (size_t)d * (q0 + 32 * wid)) * 64, rs_);
            TOC(15);
#endif
        }
    }
}

__device__ __forceinline__ void combine_phase(unsigned char* ws, int tid, int G) {
    const bf16_t* OBP = (const bf16_t*)(ws + WS_OBP); const float* LSEB = (const float*)(ws + WS_LSEB); bf16_t* O = (bf16_t*)(ws + WS_O);
    const size_t NI = (size_t)MROWS * 48, PS = (size_t)NB * 6 * T;
    for (size_t i = (size_t)blockIdx.x * 512 + tid; i < NI; i += (size_t)G * 512) {
        const int row = (int)(i / 48), rem = (int)(i % 48), h = rem >> 3, ch = rem & 7, b = row >> 13, t = row & (T - 1);
        const size_t e = ((size_t)b * 6 + h) * T + t;
        const float l0 = LSEB[e], l1 = LSEB[PS + e], l2 = LSEB[2 * PS + e];
        const float mx = fmaxf(l0, fmaxf(l1, l2));
        float w0 = __builtin_amdgcn_exp2f(l0 - mx), w1 = __builtin_amdgcn_exp2f(l1 - mx), w2 = __builtin_amdgcn_exp2f(l2 - mx);
        const float inv = 1.0f / (w0 + w1 + w2); w0 *= inv; w1 *= inv; w2 *= inv;
        const u32x4 a0 = *(const u32x4*)(OBP + e * 64 + ch * 8), a1 = *(const u32x4*)(OBP + (PS + e) * 64 + ch * 8), a2 = *(const u32x4*)(OBP + (2 * PS + e) * 64 + ch * 8);
        u32x4 o;
#pragma unroll
        for (int q = 0; q < 4; ++q) {
            const float x0 = w0 * bf2f((unsigned short)(a0[q] & 0xffffu)) + w1 * bf2f((unsigned short)(a1[q] & 0xffffu)) + w2 * bf2f((unsigned short)(a2[q] & 0xffffu));
            const float x1 = w0 * bf2f((unsigned short)(a0[q] >> 16)) + w1 * bf2f((unsigned short)(a1[q] >> 16)) + w2 * bf2f((unsigned short)(a2[q] >> 16));
            o[q] = pk2(x0, x1);
        }
        *(u32x4*)(O + (size_t)row * DM + 256 + h * 64 + ch * 8) = o;
    }
}
__device__ __forceinline__ void fix_phase(unsigned char* ws, const float* cw, const float* cb, int tid, int G) {
    const unsigned char* FIXP = (const unsigned char*)(ws + WS_FIX); const unsigned char* FIXT2 = FIXP + FIX_ELEMS * 4; bf16_t* ACT = (bf16_t*)(ws + WS_ACT);
    constexpr int F4 = DFF / 4; const int NI = 1024 * 2 * F4;
    for (int i = blockIdx.x * 512 + tid; i < NI; i += G * 512) {
        const int grp = i / (2 * F4), rem = i % (2 * F4), rr = rem / F4, f = (rem % F4) * 4;
        const int row = grp * 64 + rr, t = row & (T - 1);
#define FX_U2F(w, hi_) ((hi_) ? __builtin_bit_cast(float, (w) & 0xffff0000u) : __builtin_bit_cast(float, (w) << 16))
        const u32x4 own = *(const u32x4*)(FIXP + (((size_t)grp * 2 + rr) * DFF + f) * 4);
        const f32x4 uu = (f32x4){FX_U2F(own.x, 0), FX_U2F(own.x, 1), FX_U2F(own.y, 0), FX_U2F(own.y, 1)}, g0 = (f32x4){FX_U2F(own.z, 0), FX_U2F(own.z, 1), FX_U2F(own.w, 0), FX_U2F(own.w, 1)};
        f32x4 gm1 = (f32x4){0.f, 0.f, 0.f, 0.f}, gm2 = gm1;
        typedef unsigned u32x2t __attribute__((ext_vector_type(2)));
        const u32x2t t1 = (t >= 2 - rr && grp > 0) ? *(const u32x2t*)(FIXT2 + (((size_t)(grp - 1) * 2 + 1) * DFF + f) * 4) : (u32x2t){0u, 0u};
        const f32x4 tail1 = (f32x4){FX_U2F(t1.x, 0), FX_U2F(t1.x, 1), FX_U2F(t1.y, 0), FX_U2F(t1.y, 1)};
        if (rr == 0) {
            if (t >= 1) gm1 = tail1;
            if (t >= 2) { const u32x2t t0 = *(const u32x2t*)(FIXT2 + (((size_t)(grp - 1) * 2 + 0) * DFF + f) * 4); gm2 = (f32x4){FX_U2F(t0.x, 0), FX_U2F(t0.x, 1), FX_U2F(t0.y, 0), FX_U2F(t0.y, 1)}; }
        } else {
            const u32x4 p0 = *(const u32x4*)(FIXP + (((size_t)grp * 2 + 0) * DFF + f) * 4);
            gm1 = (f32x4){FX_U2F(p0.z, 0), FX_U2F(p0.z, 1), FX_U2F(p0.w, 0), FX_U2F(p0.w, 1)};
            if (t >= 2) gm2 = tail1;
        }
#undef FX_U2F
        const f32x4 w0 = *(const f32x4*)(cw + f), w1 = *(const f32x4*)(cw + DFF + f), w2 = *(const f32x4*)(cw + 2 * DFF + f), bb = *(const f32x4*)(cb + f);
        float av[4];
#pragma unroll
        for (int q = 0; q < 4; ++q) { const float y = bb[q] + w0[q] * gm2[q] + w1[q] * gm1[q] + w2[q] * g0[q]; av[q] = y * __builtin_amdgcn_rcpf(1.f + __expf(-y)) * uu[q]; }
        *(unsigned long long*)(ACT + (size_t)row * DFF + f) = (unsigned long long)pk2(av[0], av[1]) | ((unsigned long long)pk2(av[2], av[3]) << 32);
    }
}

#define XB_TMO      128
#define XB_XCNT(j)  (256  + 64 * (j))
#define XB_XSUB(j)  (1280 + 64 * (j))
#define XB_XGEN(j)  (2304 + 64 * (j))
#define XB_TOP      3328
#define XB_TOPGEN   3392
#define XCD_BAR_WORDS 3456
#define XB_SPIN_CAP (1u << 18)

__device__ __forceinline__ unsigned xb_ld(unsigned* p)              { return __hip_atomic_load(p, __ATOMIC_RELAXED, __HIP_MEMORY_SCOPE_AGENT); }
__device__ __forceinline__ unsigned xb_add(unsigned* p, unsigned v) { return __hip_atomic_fetch_add(p, v, __ATOMIC_RELAXED, __HIP_MEMORY_SCOPE_AGENT); }
__device__ __forceinline__ unsigned xb_xcc_id() { return (unsigned)__builtin_amdgcn_s_getreg((3 << 11) | 20) & 0xFu; }
#define XB_SPIN(cond, bar) do { unsigned _sp = 0; while (cond) { __builtin_amdgcn_s_sleep(1); \
    if ((++_sp & 255u) == 0u) { if (xb_ld(&(bar)[XB_TMO])) break; if (_sp > XB_SPIN_CAP) { atomicAdd(&(bar)[XB_TMO], 1u); break; } } } } while (0)

struct XcdBarrier {
    unsigned* bar; unsigned x;
    volatile LAS unsigned* st;
};

__device__ __forceinline__ XcdBarrier xcd_barrier_post(unsigned* bar, volatile LAS unsigned* st) {
    XcdBarrier b; b.bar = bar; b.x = xb_xcc_id(); b.st = st;
    if (threadIdx.x == 0) (void)xb_add(&bar[XB_XCNT(b.x)], 1u);
    return b;
}
__device__ __forceinline__ void xcd_barrier_complete(unsigned* bar, unsigned x, unsigned& nloc, unsigned& nx) {
    const unsigned G = gridDim.x * gridDim.y * gridDim.z;
    unsigned sum, cnt, mine, sp = 0u;
    for (;;) {
        sum = 0u; cnt = 0u; mine = 0u;
#pragma unroll
        for (unsigned j = 0; j < 16; ++j) { const unsigned c = xb_ld(&bar[XB_XCNT(j)]); sum += c; cnt += (c > 0u) ? 1u : 0u; mine = (j == x) ? c : mine; }
        if (sum == G) break;
        __builtin_amdgcn_s_sleep(1);
        if ((++sp & 255u) == 0u) { if (xb_ld(&bar[XB_TMO])) break; if (sp > XB_SPIN_CAP) { atomicAdd(&bar[XB_TMO], 1u); break; } }
    }
    nloc = mine > 0u ? mine : 1u; nx = cnt > 0u ? cnt : 1u;
}

__device__ __forceinline__ void xcd_barrier(const XcdBarrier& b) {
    asm volatile("s_waitcnt vmcnt(0)" ::: "memory");
    __syncthreads();
    if (threadIdx.x == 0) {
        unsigned* bar = b.bar;
        __builtin_amdgcn_s_waitcnt(0);
        unsigned nloc = b.st[0], nx = b.st[1];
        if (nloc == 0u) { xcd_barrier_complete(bar, b.x, nloc, nx); b.st[0] = nloc; b.st[1] = nx; }
        const unsigned old = xb_add(&bar[XB_XSUB(b.x)], 1u);
        const unsigned gen = old / nloc;
        if (old + 1u == (gen + 1u) * nloc) {
            __builtin_amdgcn_fence(__ATOMIC_RELEASE, "agent");
            asm volatile("s_waitcnt vmcnt(0)" ::: "memory");
            const unsigned og = xb_add(&bar[XB_TOP], 1u);
            const unsigned tg = og / nx;
            if (og + 1u == (tg + 1u) * nx) xb_add(&bar[XB_TOPGEN], 1u);
            else XB_SPIN(xb_ld(&bar[XB_TOPGEN]) == tg, bar);
            __builtin_amdgcn_fence(__ATOMIC_ACQUIRE, "agent");
            xb_add(&bar[XB_XGEN(b.x)], 1u);
            asm volatile("s_waitcnt vmcnt(0)" ::: "memory");
        } else {
            XB_SPIN(xb_ld(&bar[XB_XGEN(b.x)]) == gen, bar);
            __builtin_amdgcn_fence(__ATOMIC_ACQUIRE, "agent");
            asm volatile("s_waitcnt vmcnt(0)" ::: "memory");
        }
    }
    __syncthreads();
}

#define GSYNC() do { TIC(12); xcd_barrier(xbar); TOC(12); } while (0)
__global__ void __launch_bounds__(512, 2) fwd_mega(Args a) {
    extern __shared__ __attribute__((aligned(16))) unsigned char lds[];
    cg::grid_group grid = cg::this_grid();
    const int tid0 = threadIdx.x, G = gridDim.x;
#define LAUNDER_TID() int tid = tid0; asm volatile("" : "+v"(tid))
    unsigned char* ws = a.ws;
    PG8_LAS unsigned char* ldsl = (PG8_LAS unsigned char*)lds;
    bf16_t* H = (bf16_t*)(ws + WS_H);
    float* MOD = (float*)(ws + WS_MOD);
    unsigned* ctl = (unsigned*)(ws + WS_CTL);
    unsigned long long tacc = 0;
    if (tid0 < 64) ((volatile LAS unsigned*)(lds + LDS_BYTES - 4096))[tid0] = 0u;
    __syncthreads();
    XcdBarrier xbar = xcd_barrier_post(ctl + 4096, (volatile LAS unsigned*)(lds + LDS_BYTES - 4096) + 8);

#ifndef SK_PRO
    { TIC(1); LAUNDER_TID(); prologue(a, lds, tid, G); TOC(1); }
#endif
    grid.sync();
#pragma unroll 1
    for (int layer = 0; layer < DEPTH; ++layer) {
        const float* xin = (layer == 0) ? a.in[0] : nullptr;
        bf16_t* XB = (bf16_t*)(ws + WS_XB); bf16_t* XA = (bf16_t*)(ws + WS_XA);
        const float* modl = MOD + (size_t)layer * NB * NMOD;
        const bf16_t* WT = (const bf16_t*)(ws + WS_WT) + (size_t)layer * WL_ELEMS;
#ifndef SK_N1
        if (layer == 0) { LAUNDER_TID(); cvec_phase(ws, tid, G); }
        { TIC(2); LAUNDER_TID(); norm_phase<true>(xin, XB, XB, H, a.in[4] + (size_t)layer * DM, modl, 0, DM, (const float*)(ws + WS_WFZ) + (size_t)layer * 6 * DM, a.in[8] + (size_t)layer * 6, (float*)(ws + WS_LOGF), tid, G); TOC(2); }
#endif
        GSYNC();
#ifndef SK_SCAN
        { LAUNDER_TID(); scan_phase((float*)(ws + WS_LOGF), lds, tid, G); }
#endif
        __syncthreads();
#ifndef SK_GIN
        { TIC(3); pg8::Gemm g{H, WT + WL_IN, MROWS, NIN, DM}; pg8::StaticOrder S; S.init(MROWS, NIN, G, (int)blockIdx.x);
          pg8::EpiIn E{(bf16_t*)(ws + WS_QKV), (const float*)(ws + WS_ROPEA), (const float*)(ws + WS_ROPEB)};
          pg8::gemm_phase<pg8::EpiIn, pg8::StaticOrder, true, true>(ldsl, g, S, E); TOC(3); }
#endif
        GSYNC();
#ifndef SK_ATT
        { TIC(4); LAUNDER_TID(); attn_phase(a, lds, tid, layer, tacc); TOC(4); }
#endif
        GSYNC();
#ifndef SK_CMB
        { TIC(5); LAUNDER_TID(); combine_phase(ws, tid, G); TOC(5); }
#endif
        GSYNC();
#ifndef SK_GOUT
        { TIC(6); pg8::Gemm g{(const bf16_t*)(ws + WS_O), WT + WL_OUT, MROWS, DM, DM}; pg8::StaticOrder S; S.init(MROWS, DM, G, (int)blockIdx.x);
          pg8::EpiRes<true> E{XB, XB, modl + 2 * DM, XA, (unsigned long long*)(ws + WS_SSQ) + (size_t)layer * MROWS, a.in[10] + (size_t)layer * DM, modl + 4 * DM};
          pg8::gemm_phase<pg8::EpiRes<true>, pg8::StaticOrder, true, true>(ldsl, g, S, E); TOC(6); }
#endif
        GSYNC();
#ifndef SK_GUP
        { TIC(8); pg8::Gemm g{XA, WT + WL_UP, MROWS, NUP, DM}; pg8::StaticOrder S; S.init(MROWS, NUP, G, (int)blockIdx.x);
          float* FX = (float*)(ws + WS_FIX);
          pg8::EpiUp E{(bf16_t*)(ws + WS_ACT), (unsigned char*)FX, (unsigned char*)FX + FIX_ELEMS * 4, a.in[12] + (size_t)layer * 3 * DFF, a.in[13] + (size_t)layer * DFF,
                       (const unsigned long long*)(ws + WS_SSQ) + (size_t)layer * MROWS, (const float*)(ws + WS_CUP) + (size_t)layer * NB * NUP};
          pg8::gemm_phase<pg8::EpiUp, pg8::StaticOrder, true, true>(ldsl, g, S, E); TOC(8); }
#endif
        GSYNC();
#ifndef SK_FIX
        { TIC(9); LAUNDER_TID(); fix_phase(ws, a.in[12] + (size_t)layer * 3 * DFF, a.in[13] + (size_t)layer * DFF, tid, G); TOC(9); }
#endif
        GSYNC();
#ifndef SK_GDN
        { TIC(10); pg8::Gemm g{(const bf16_t*)(ws + WS_ACT), WT + WL_DN, MROWS, DM, DFF}; pg8::StaticOrder S; S.init(MROWS, DM, G, (int)blockIdx.x);
          pg8::EpiRes<false> E{XB, XB, modl + 5 * DM, nullptr, nullptr, nullptr, nullptr};
          pg8::gemm_phase<pg8::EpiRes<false>, pg8::StaticOrder, true, true>(ldsl, g, S, E); TOC(10); }
#endif
        GSYNC();
    }
    { TIC(11); LAUNDER_TID(); final_norm((const bf16_t*)(ws + WS_XB), a.out, a.in[15], tid, G); TOC(11); }
    if (PROBE_MASK != 0 && blockIdx.x == 0) { const unsigned long long ts = __builtin_amdgcn_s_memrealtime(); while (__builtin_amdgcn_s_memrealtime() - ts < tacc) __builtin_amdgcn_s_sleep(8); }
}

extern "C" void kernel_launch(void* const* d_in, const int* in_sizes, int n_in, void* d_out, int out_size, void* d_ws, size_t ws_size, hipStream_t stream) {
    static int grid = 0;
    if (grid == 0) {
        if (n_in != 16 || ws_size < WS_END) { fprintf(stderr, "kernel_launch: unexpected inputs (n_in %d, ws %zu)\n", n_in, ws_size); grid = -1; return; }
        int dev = 0, cus = 0, per_cu = 0;
        hipGetDevice(&dev);
        hipDeviceGetAttribute(&cus, hipDeviceAttributeMultiprocessorCount, dev);
        hipFuncSetAttribute((const void*)fwd_mega, hipFuncAttributeMaxDynamicSharedMemorySize, LDS_BYTES);
        hipOccupancyMaxActiveBlocksPerMultiprocessor(&per_cu, (const void*)fwd_mega, 512, LDS_BYTES);
        if (per_cu < 1) per_cu = 1;
        (void)hipGetLastError();
        grid = cus * per_cu;
    }
    if (grid < 0) return;
    hipMemsetAsync((char*)d_ws + WS_CTL, 0, CTL_BYTES, stream);
    hipMemsetAsync((char*)d_ws + WS_SSQ, 0, (size_t)DEPTH * MROWS * 8, stream);
    Args a{};
    for (int i = 0; i < 16; ++i) a.in[i] = (const float*)d_in[i];
    a.out = (float*)d_out; a.ws = (unsigned char*)d_ws;
    void* args[] = {&a};
    hipError_t e = hipLaunchCooperativeKernel((const void*)fwd_mega, dim3(grid), dim3(512), args, LDS_BYTES, stream);
    if (e != hipSuccess) fprintf(stderr, "cooperative launch failed: %s (grid %d)\n", hipGetErrorString(e), grid);
}
```

```cpp
#include <hip/hip_runtime.h>
#include <hip/hip_cooperative_groups.h>
#include <cstdio>
#include <cstdint>
namespace cg = cooperative_groups;
namespace pg8 {
#define PG8_LAS __attribute__((address_space(3)))
typedef unsigned short bf16_t;
typedef short bf16x8 __attribute__((ext_vector_type(8)));
typedef float f32x4 __attribute__((ext_vector_type(4)));
typedef unsigned u32x4 __attribute__((ext_vector_type(4)));
constexpr int BM = 256, BK = 64, HALF = 128, HTB = HALF * BK * 2  , STAGE_BYTES = 8 * HTB, NXCD = 8, WGM = 8;

__host__ __device__ __forceinline__ int lds_byte(int r, int c) { const int st = (r >> 4) * 2 + (c >> 5), rr = r & 15, cc = c & 31, ob = rr * 64 + cc * 2; return st * 1024 + (ob ^ (((ob >> 9) & 1) << 5)); }
__host__ __device__ __forceinline__ void stage_rc(int b, int& R, int& C) { const int st = b / 1024, sb = b % 1024, swz = sb ^ (((sb >> 9) & 1) << 5); R = (st >> 1) * 16 + swz / 64; C = (st & 1) * 32 + (swz % 64) / 2; }
__host__ __device__ __forceinline__ int perm32(int rho) { const int n = rho >> 4, i = rho & 15; return 8 * (i >> 2) + 4 * n + (i & 3); }

struct Unit { int pm, pn; };
struct Gemm { const bf16_t* A; const bf16_t* Bt; int M, N, K; };

struct StaticOrder {
    int nM, nN, nwg, G, c;
    __host__ __device__ void init(int M, int N, int G_, int c_) { nM = M / BM; nN = N / BM; nwg = nM * nN; G = G_; c = c_; }
    __host__ __device__ bool next(int i, Unit& u) const {
        const long L = (long)i * G + c; if (L >= nwg) return false;
        int wgid = (int)L; { const int q = nwg / NXCD, r = nwg % NXCD, xcd = wgid % NXCD, off = wgid / NXCD; wgid = (xcd < r ? xcd * (q + 1) : r * (q + 1) + (xcd - r) * q) + off; }
        const int nig = WGM * nN, gid = wgid / nig, fm = gid * WGM, gsz = (nM - fm) < WGM ? (nM - fm) : WGM;
        u.pm = fm + ((wgid % nig) % gsz); u.pn = (wgid % nig) / gsz; return true;
    }
    __device__ __forceinline__ void a_ready(const Unit&) const {}
    __device__ __forceinline__ void done(const Unit&) const {}
};

__device__ __forceinline__ unsigned cvt_pk_bf16(float lo, float hi) { unsigned r; asm volatile("v_cvt_pk_bf16_f32 %0, %1, %2" : "=v"(r) : "v"(lo), "v"(hi)); return r; }
template <class Epi, class Sched, bool ALIGN_EPI = false, bool SP2 = false>
__device__ __forceinline__ void gemm_phase(PG8_LAS unsigned char* lds, const Gemm g, const Sched& S, const Epi& E) {
    int tid_l = threadIdx.x; asm volatile("" : "+v"(tid_l));
    const int tid = tid_l, wid = __builtin_amdgcn_readfirstlane(tid >> 6), lane = tid & 63, wr = wid >> 2, wc = wid & 3, fr = lane & 15, fq = lane >> 4;
    const int K = g.K, nt = K / BK;
    unsigned voffA[2], voffB[2];
#pragma unroll
    for (int i = 0; i < 2; ++i) { int R, C; stage_rc(tid * 16 + i * 8192, R, C); const int Rb = Epi::PERM ? ((R & ~31) + perm32(R & 31)) : R;
        voffA[i] = (unsigned)(R * K + C) * 2u; voffB[i] = (unsigned)(Rb * K + C) * 2u; }
    const size_t kstep = (size_t)(BK * 2);
    const size_t hstep = (size_t)HALF * K * 2;
    const size_t tstep = 2 * hstep;
    const unsigned ldsw = (unsigned)wid * 1024u;
    const int aoff = lds_byte(wr * 64 + fr, fq * 8), boff = lds_byte(wc * 32 + fr, fq * 8);
#define PG8_SA(b, h) (((b) * 2 + (h)) * HTB)
#define PG8_SB(b, h) ((4 + (b) * 2 + (h)) * HTB)
#define PG8_STAGE(bufoff, gbase, voff) do { _Pragma("unroll") for (int _i = 0; _i < 2; ++_i) \
        __builtin_amdgcn_global_load_lds((const unsigned*)((const char*)(gbase) + (voff)[_i]), (PG8_LAS unsigned*)(lds + (bufoff) + ldsw + _i * 8192), 16, 0, 0); } while (0)
#define PG8_LDA(dst, b, h) do { _Pragma("unroll") for (int m = 0; m < 4; ++m) _Pragma("unroll") for (int k = 0; k < 2; ++k) dst[m][k] = *(const PG8_LAS bf16x8*)(lds + PG8_SA(b, h) + aoff + m * 2048 + k * 1024); } while (0)
#define PG8_LDB(dst, b, h) do { _Pragma("unroll") for (int n = 0; n < 2; ++n) _Pragma("unroll") for (int k = 0; k < 2; ++k) dst[n][k] = *(const PG8_LAS bf16x8*)(lds + PG8_SB(b, h) + boff + n * 2048 + k * 1024); } while (0)
#define PG8_MMA(ai, bj, At, Bt) do { __builtin_amdgcn_s_setprio(1); _Pragma("unroll") for (int m = 0; m < 4; ++m) _Pragma("unroll") for (int n = 0; n < 2; ++n) _Pragma("unroll") for (int k = 0; k < 2; ++k) \
        acc[ai][bj][m][n] = __builtin_amdgcn_mfma_f32_16x16x32_bf16(Bt[n][k], At[m][k], acc[ai][bj][m][n], 0, 0, 0); __builtin_amdgcn_s_setprio(0); } while (0)
#define PG8_WAIT_V(n) asm volatile("s_waitcnt vmcnt(" #n ")" ::: "memory")
#define PG8_WAIT_L(n) asm volatile("s_waitcnt lgkmcnt(" #n ")" ::: "memory")
#define PG8_BAR __builtin_amdgcn_s_barrier()
#define PG8_SCHED __builtin_amdgcn_sched_barrier(0)
    Unit cur, nxt; int ui = 0;
    if (!S.next(0, cur)) return;
    f32x4 acc[2][2][4][2];
#pragma unroll
    for (int a = 0; a < 2; ++a)
#pragma unroll
        for (int b = 0; b < 2; ++b)
#pragma unroll
            for (int m = 0; m < 4; ++m)
#pragma unroll
                for (int n = 0; n < 2; ++n) acc[a][b][m][n] = (f32x4){0.f, 0.f, 0.f, 0.f};
    bf16x8 At[4][2], B0[2][2], B1[2][2];
    const char* cA = (const char*)g.A + (size_t)cur.pm * tstep; const char* cB = (const char*)g.Bt + (size_t)cur.pn * tstep;
    S.a_ready(cur);
    if constexpr (SP2) {
        PG8_STAGE(PG8_SB(0, 0), cB, voffB); PG8_STAGE(PG8_SB(0, 1), cB + hstep, voffB); PG8_STAGE(PG8_SA(0, 0), cA, voffA); PG8_STAGE(PG8_SA(0, 1), cA + hstep, voffA);
        if (wr == 1) PG8_BAR;
        PG8_WAIT_V(2); PG8_BAR;
        PG8_STAGE(PG8_SB(1, 0), cB + kstep, voffB); PG8_STAGE(PG8_SA(1, 0), cA + kstep, voffA); PG8_STAGE(PG8_SB(1, 1), cB + hstep + kstep, voffB);
        PG8_WAIT_V(6); PG8_BAR;
    } else {
        PG8_STAGE(PG8_SB(0, 0), cB, voffB); PG8_STAGE(PG8_SA(0, 0), cA, voffA); PG8_STAGE(PG8_SB(0, 1), cB + hstep, voffB); PG8_STAGE(PG8_SA(0, 1), cA + hstep, voffA);
        if (wr == 1) PG8_BAR;
        PG8_WAIT_V(4); PG8_BAR;
        PG8_STAGE(PG8_SB(1, 0), cB + kstep, voffB); PG8_STAGE(PG8_SA(1, 0), cA + kstep, voffA); PG8_STAGE(PG8_SB(1, 1), cB + hstep + kstep, voffB);
        PG8_WAIT_V(6); PG8_BAR;
    }
    for (;;) {
        const bool has_next = S.next(ui + 1, nxt);
        const char* nA = has_next ? (const char*)g.A + (size_t)nxt.pm * tstep : cA; const char* nB = has_next ? (const char*)g.Bt + (size_t)nxt.pn * tstep : cB;
        for (int t = 0; t < nt; t += 2) {
            const bool last = (t == nt - 2);
            const char* a1 = cA + (size_t)(t + 1) * kstep;
            const char* a2 = last ? nA : cA + (size_t)(t + 2) * kstep; const char* b2 = last ? nB : cB + (size_t)(t + 2) * kstep;
            const char* a3 = a2 + kstep; const char* b3 = b2 + kstep;
            if (last && has_next) S.a_ready(nxt);
            if constexpr (SP2) {
            PG8_LDB(B0, 0, 0); PG8_LDB(B1, 0, 1); PG8_SCHED; PG8_LDA(At, 0, 0); PG8_STAGE(PG8_SA(1, 1), a1 + hstep, voffA);
            PG8_WAIT_V(8); PG8_WAIT_L(0); PG8_BAR; PG8_MMA(0, 0, At, B0); PG8_MMA(0, 1, At, B1); PG8_BAR; PG8_SCHED;
            PG8_LDA(At, 0, 1); PG8_STAGE(PG8_SB(0, 0), b2, voffB); PG8_STAGE(PG8_SB(0, 1), b2 + hstep, voffB); PG8_STAGE(PG8_SA(0, 0), a2, voffA);
            PG8_WAIT_V(8); PG8_WAIT_L(0); PG8_BAR; PG8_MMA(1, 0, At, B0); PG8_MMA(1, 1, At, B1); PG8_BAR; PG8_SCHED;
            PG8_LDB(B0, 1, 0); PG8_LDB(B1, 1, 1); PG8_SCHED; PG8_LDA(At, 1, 0); PG8_STAGE(PG8_SA(0, 1), a2 + hstep, voffA);
            PG8_WAIT_V(8); PG8_WAIT_L(0); PG8_BAR; PG8_MMA(0, 0, At, B0); PG8_MMA(0, 1, At, B1); PG8_BAR; PG8_SCHED;
            PG8_LDA(At, 1, 1); PG8_STAGE(PG8_SB(1, 0), b3, voffB); PG8_STAGE(PG8_SB(1, 1), b3 + hstep, voffB); PG8_STAGE(PG8_SA(1, 0), a3, voffA);
            PG8_WAIT_V(8); PG8_WAIT_L(0); PG8_BAR; PG8_MMA(1, 0, At, B0); PG8_MMA(1, 1, At, B1); PG8_BAR; PG8_SCHED;
            } else {
            PG8_LDB(B0, 0, 0); PG8_SCHED; PG8_LDA(At, 0, 0); PG8_STAGE(PG8_SA(1, 1), a1 + hstep, voffA);
            PG8_WAIT_L(8); PG8_BAR; PG8_WAIT_L(0); PG8_MMA(0, 0, At, B0); PG8_BAR; PG8_SCHED;
            PG8_LDB(B1, 0, 1); PG8_STAGE(PG8_SB(0, 0), b2, voffB);
            PG8_BAR; PG8_WAIT_L(0); PG8_MMA(0, 1, At, B1); PG8_BAR;
            PG8_LDA(At, 0, 1); PG8_STAGE(PG8_SA(0, 0), a2, voffA);
            PG8_BAR; PG8_WAIT_L(0); PG8_MMA(1, 0, At, B0); PG8_BAR; PG8_SCHED;
            PG8_STAGE(PG8_SB(0, 1), b2 + hstep, voffB);
            PG8_WAIT_V(6); PG8_BAR; PG8_MMA(1, 1, At, B1); PG8_BAR;
            PG8_LDB(B0, 1, 0); PG8_SCHED; PG8_LDA(At, 1, 0); PG8_STAGE(PG8_SA(0, 1), a2 + hstep, voffA);
            PG8_WAIT_L(8); PG8_BAR; PG8_WAIT_L(0); PG8_MMA(0, 0, At, B0); PG8_BAR; PG8_SCHED;
            PG8_LDB(B1, 1, 1); PG8_STAGE(PG8_SB(1, 0), b3, voffB);
            PG8_BAR; PG8_WAIT_L(0); PG8_MMA(0, 1, At, B1); PG8_BAR;
            PG8_LDA(At, 1, 1); PG8_STAGE(PG8_SA(1, 0), a3, voffA);
            PG8_BAR; PG8_WAIT_L(0); PG8_MMA(1, 0, At, B0); PG8_BAR; PG8_SCHED;
            PG8_STAGE(PG8_SB(1, 1), b3 + hstep, voffB);
            PG8_WAIT_V(6); PG8_BAR; PG8_MMA(1, 1, At, B1); PG8_BAR;
            }
        }
        if constexpr (ALIGN_EPI) { if (wr == 0) PG8_BAR; }
        if constexpr (!Epi::AFTER_DRAIN) { E(acc, cur, wr, wc, fr, fq); S.done(cur); }
        if (!has_next) break;
#pragma unroll
        for (int a = 0; a < 2; ++a)
#pragma unroll
            for (int b = 0; b < 2; ++b)
#pragma unroll
                for (int m = 0; m < 4; ++m)
#pragma unroll
                    for (int n = 0; n < 2; ++n) acc[a][b][m][n] = (f32x4){0.f, 0.f, 0.f, 0.f};
        cur = nxt; cA = nA; cB = nB; ++ui;
        if constexpr (ALIGN_EPI) { if (wr == 1) PG8_BAR; }
    }
    PG8_WAIT_V(0);
    if constexpr (!ALIGN_EPI) { if (wr == 0) PG8_BAR; }
    PG8_BAR;
    if constexpr (Epi::AFTER_DRAIN) { E.fused(acc, cur, wr, wc, fr, fq, lds, wid, lane); S.done(cur); }
#undef PG8_SA
#undef PG8_SB
#undef PG8_STAGE
#undef PG8_LDA
#undef PG8_LDB
#undef PG8_MMA
#undef PG8_WAIT_V
#undef PG8_WAIT_L
#undef PG8_BAR
#undef PG8_SCHED
}
}

using pg8::bf16_t; using pg8::f32x4; using pg8::u32x4; using pg8::bf16x8;
typedef float f32x16 __attribute__((ext_vector_type(16)));
typedef short v4i16_t __attribute__((ext_vector_type(4)));
#define LAS __attribute__((address_space(3)))

constexpr int NB = 8, T = 8192, DM = 1024, DEPTH = 4, MROWS = NB * T;
constexpr int INC = 3078, NIN = 3072, DFF = 2816, NUP = 5632, NSLOT = 48, NMOD = 6 * DM;
constexpr float LOG2E = 1.4426950408889634f;
constexpr float QSC_A = 0.17677669529663687f * LOG2E;
constexpr float QSC_B = 0.125f * LOG2E;

constexpr size_t MiB = 1u << 20;
constexpr size_t WS_CTL = 0, CTL_BYTES = 1 * MiB;
constexpr size_t WS_WT = 2 * MiB;
constexpr size_t WL_IN = 0, WL_OUT = (size_t)NIN * DM, WL_UP = WL_OUT + (size_t)DM * DM, WL_DN = WL_UP + (size_t)NUP * DM, WL_ELEMS = WL_DN + (size_t)DM * DFF;
constexpr size_t WS_MOD = 102 * MiB;
constexpr size_t WS_ROPEA = 103 * MiB;
constexpr size_t WS_ROPEB = 104 * MiB;
constexpr size_t WS_WFZ = 106 * MiB;
constexpr size_t WS_LOGF = 107 * MiB;
constexpr size_t WS_LSEB = 109 * MiB;
constexpr size_t WS_XB = 116 * MiB;
constexpr size_t WS_H = 628 * MiB;
constexpr size_t WS_QKV = 244 * MiB;
constexpr size_t WS_ACT = WS_QKV;
constexpr size_t WS_O = 628 * MiB;
constexpr size_t WS_OBP = 756 * MiB;
constexpr size_t WS_FIX = WS_OBP;
constexpr size_t FIX_ELEMS = (size_t)1024 * 2 * DFF;
constexpr size_t WS_SSQ = 114 * MiB;
constexpr size_t WS_XA = 822 * MiB;
constexpr size_t WS_CUP = 950 * MiB;
constexpr size_t WS_END = 952 * MiB;
static_assert(WS_WT + WL_ELEMS * 2 * DEPTH <= WS_MOD, "weights fit");
static_assert(WS_FIX + 3 * FIX_ELEMS * 4 <= WS_XA && WS_XA + (size_t)65536 * 1024 * 2 <= WS_CUP, "fix / xa fit");

constexpr int LDS_BYTES = 147456;
constexpr int MISC_OFF = 131072;
constexpr int AT_K = 0, AT_V = 8192, AT_BIAS = 16384, AT_BUF = 17408, AT_WS = 2 * AT_BUF, AT_Q = AT_WS + 2048, AT_STASH = AT_Q + 32768;

struct Args { const float* in[16]; float* out; unsigned char* ws; };

__device__ __forceinline__ unsigned f2bf(float f) { unsigned u = __builtin_bit_cast(unsigned, f); return (u + 0x7fffu + ((u >> 16) & 1u)) >> 16; }
__device__ __forceinline__ unsigned pk2(float lo, float hi) { return f2bf(lo) | (f2bf(hi) << 16); }
__device__ __forceinline__ float bf2f(unsigned short h) { return __builtin_bit_cast(float, (unsigned)h << 16); }
typedef _Float16 h16x2 __attribute__((ext_vector_type(2))); typedef float f32x2v __attribute__((ext_vector_type(2)));
__device__ __forceinline__ unsigned f2h2(float lo, float hi) { const f32x2v v = {lo, hi}; const h16x2 h = __builtin_convertvector(v, h16x2); return __builtin_bit_cast(unsigned, h); }
__device__ __forceinline__ f32x2v h2f2(unsigned w) { const h16x2 h = __builtin_bit_cast(h16x2, w); return __builtin_convertvector(h, f32x2v); }
__device__ __forceinline__ float wave_sum(float v) {
#pragma unroll
    for (int o = 1; o < 64; o <<= 1) v += __shfl_xor(v, o);
    return v;
}
#define LDS_FENCE() asm volatile("s_waitcnt lgkmcnt(0)" ::: "memory")

namespace pg8 {
struct EpiIn {
    static constexpr bool PERM = true, AFTER_DRAIN = false;
    bf16_t* QKV; const float* ropeA; const float* ropeB;
    __device__ __forceinline__ void operator()(const f32x4 (&acc)[2][2][4][2], const Unit& u, int wr, int wc, int fr, int fq) const {
        const int c0 = 32 * (wc & 1) + 8 * fq;
        int kind[2]; float sc[2]; int slot[2];
#pragma unroll
        for (int bj = 0; bj < 2; ++bj) {
            const int s = 4 * u.pn + 2 * bj + (wc >> 1); slot[bj] = s; kind[bj] = 0; sc[bj] = 1.f;
            if (s < 8) { kind[bj] = 1; if (s < 4) sc[bj] = QSC_A; }
            else if (s >= 12 && s < 24) { kind[bj] = 2; if (s < 18) sc[bj] = QSC_B; }
            else if (s >= 30 && s < 36) sc[bj] = QSC_B;
        }
        const int kk = kind[0] ? kind[0] : kind[1];
#pragma unroll
        for (int ai = 0; ai < 2; ++ai)
#pragma unroll
            for (int m = 0; m < 4; ++m) {
                const int row = u.pm * BM + ai * HALF + wr * 64 + m * 16 + fr, b = row >> 13, t = row & (T - 1);
                f32x4 c01 = (f32x4){1.f, 0.f, 1.f, 0.f}, c23 = c01;
                if (kk) { const float* tb = (kk == 1) ? ropeA + ((size_t)t * 16 + 4 * fq) * 2 : ropeB + ((size_t)t * 32 + 16 * (wc & 1) + 4 * fq) * 2;
                          c01 = *(const f32x4*)tb; c23 = *(const f32x4*)(tb + 4); }
#pragma unroll
                for (int bj = 0; bj < 2; ++bj) {
                    f32x4 v0 = acc[ai][bj][m][0], v1 = acc[ai][bj][m][1];
                    if (kind[bj]) {
                        f32x4 w0, w1;
                        w0[0] = v0[0] * c01[0] - v0[1] * c01[1]; w0[1] = v0[1] * c01[0] + v0[0] * c01[1];
                        w0[2] = v0[2] * c01[2] - v0[3] * c01[3]; w0[3] = v0[3] * c01[2] + v0[2] * c01[3];
                        w1[0] = v1[0] * c23[0] - v1[1] * c23[1]; w1[1] = v1[1] * c23[0] + v1[0] * c23[1];
                        w1[2] = v1[2] * c23[2] - v1[3] * c23[3]; w1[3] = v1[3] * c23[2] + v1[2] * c23[3];
                        v0 = w0; v1 = w1;
                    }
                    v0 = v0 * sc[bj]; v1 = v1 * sc[bj];
                    u32x4 w; w.x = cvt_pk_bf16(v0[0], v0[1]); w.y = cvt_pk_bf16(v0[2], v0[3]); w.z = cvt_pk_bf16(v1[0], v1[1]); w.w = cvt_pk_bf16(v1[2], v1[3]);
                    const size_t sb = (size_t)(b * NSLOT + slot[bj]) * T * 64;
                    const size_t off = (kind[bj] == 1) ? sb + (size_t)(wc & 1) * T * 32 + (size_t)t * 32 + 8 * fq : sb + (size_t)t * 64 + c0;
                    __builtin_nontemporal_store(w, (u32x4*)(QKV + off));
                }
            }
    }
};
template <bool NORM> struct EpiRes {
    static constexpr bool PERM = true, AFTER_DRAIN = false;
    const bf16_t* bh; bf16_t* xo; const float* gate;
    bf16_t* XA; unsigned long long* ssq; const float* gnorm; const float* scale;
    __device__ __forceinline__ void operator()(const f32x4 (&acc)[2][2][4][2], const Unit& u, int wr, int wc, int fr, int fq) const {
        const int b = (u.pm * BM) >> 13;
        float sq[2][4];
#pragma unroll
        for (int ai = 0; ai < 2; ++ai)
#pragma unroll
            for (int m = 0; m < 4; ++m) sq[ai][m] = 0.f;
#pragma unroll
        for (int bj = 0; bj < 2; ++bj) {
            const int col = u.pn * BM + bj * HALF + wc * 32 + 8 * fq;
            const f32x4 g0 = *(const f32x4*)(gate + (size_t)b * NMOD + col), g1 = *(const f32x4*)(gate + (size_t)b * NMOD + col + 4);
            f32x4 a0 = (f32x4){0.f, 0.f, 0.f, 0.f}, a1 = a0;
            if (NORM) { a0 = *(const f32x4*)(gnorm + col) * (*(const f32x4*)(scale + (size_t)b * NMOD + col) + 1.0f); a1 = *(const f32x4*)(gnorm + col + 4) * (*(const f32x4*)(scale + (size_t)b * NMOD + col + 4) + 1.0f); }
#pragma unroll
            for (int ai = 0; ai < 2; ++ai)
#pragma unroll
                for (int m = 0; m < 4; ++m) {
                    const size_t off = (size_t)(u.pm * BM + ai * HALF + wr * 64 + m * 16 + fr) * DM + col;
                    const u32x4 r = *(const u32x4*)(bh + off);
                    const f32x2v q0 = h2f2(r.x), q1 = h2f2(r.y), q2 = h2f2(r.z), q3 = h2f2(r.w);
                    const f32x4 x0 = (f32x4){q0[0], q0[1], q1[0], q1[1]}, x1 = (f32x4){q2[0], q2[1], q3[0], q3[1]};
                    const f32x4 y0 = x0 + g0 * acc[ai][bj][m][0], y1 = x1 + g1 * acc[ai][bj][m][1];
                    { u32x4 w; w.x = f2h2(y0[0], y0[1]); w.y = f2h2(y0[2], y0[3]); w.z = f2h2(y1[0], y1[1]); w.w = f2h2(y1[2], y1[3]); *(u32x4*)(xo + off) = w; }
                    if (NORM) {
                        sq[ai][m] += ((y0[0] * y0[0] + y0[1] * y0[1]) + (y0[2] * y0[2] + y0[3] * y0[3])) + ((y1[0] * y1[0] + y1[1] * y1[1]) + (y1[2] * y1[2] + y1[3] * y1[3]));
                        const f32x4 z0 = y0 * a0, z1 = y1 * a1;
                        u32x4 w; w.x = cvt_pk_bf16(z0[0], z0[1]); w.y = cvt_pk_bf16(z0[2], z0[3]); w.z = cvt_pk_bf16(z1[0], z1[1]); w.w = cvt_pk_bf16(z1[2], z1[3]);
                        { const int row = u.pm * BM + ai * HALF + wr * 64 + m * 16 + fr;
                          const int prow = (row & ~63) | (16 * (row & 3) + ((row >> 2) & 15));
                          *(u32x4*)(XA + (size_t)prow * DM + col) = w; }
                    }
                }
        }
        if (NORM) {
#pragma unroll
            for (int ai = 0; ai < 2; ++ai)
#pragma unroll
                for (int m = 0; m < 4; ++m) {
                    float s = sq[ai][m]; s += __shfl_xor(s, 16); s += __shfl_xor(s, 32);
                    if (fq == 0) atomicAdd(ssq + (u.pm * BM + ai * HALF + wr * 64 + m * 16 + fr), (unsigned long long)(s * 16777216.f));
                }
        }
    }
};
struct EpiUp {
    static constexpr bool PERM = true, AFTER_DRAIN = false;
    bf16_t* ACT; unsigned char* FIXP; unsigned char* FIXT2; const float* cw; const float* cb; const unsigned long long* ssq; const float* cup;
    __device__ __forceinline__ void operator()(const f32x4 (&acc)[2][2][4][2], const Unit& u, int wr, int wc, int fr, int fq) const {
        const int lane = fq * 16 + fr;
        const int srcp = (lane & 48) | ((fr - 1) & 15);
        const float* cp = cup + (size_t)((u.pm * BM) >> 13) * NUP + u.pn * BM + wc * 32 + 8 * fq;
        f32x4 rsv[2];
#pragma unroll
        for (int ai = 0; ai < 2; ++ai) { const unsigned long long* sp = ssq + u.pm * BM + ai * HALF + wr * 64 + 4 * fr;
#pragma unroll
            for (int i = 0; i < 4; ++i) rsv[ai][i] = 1.0f / sqrtf((float)sp[i] * (1.f / (16777216.f * DM)) + 1e-6f); }
        unsigned long long keep[2][4];
#pragma unroll
        for (int hh = 0; hh < 2; ++hh) {
            const int f0 = u.pn * HALF + wc * 32 + 8 * fq + 4 * hh;
            const f32x4 w0 = *(const f32x4*)(cw + f0), w1 = *(const f32x4*)(cw + DFF + f0), w2 = *(const f32x4*)(cw + 2 * DFF + f0), bb = *(const f32x4*)(cb + f0);
            const f32x4 cu = *(const f32x4*)(cp + 4 * hh), cg = *(const f32x4*)(cp + HALF + 4 * hh);
#pragma unroll
            for (int ai = 0; ai < 2; ++ai) {
                const int tok0 = u.pm * BM + ai * HALF + wr * 64, grp = tok0 >> 6;
                f32x4 g[4], uu[4], pv3, pv2;
#pragma unroll
                for (int m = 0; m < 4; ++m) { g[m] = acc[ai][1][m][hh] * rsv[ai][m] + cg; uu[m] = acc[ai][0][m][hh] * rsv[ai][m] + cu; }
#pragma unroll
                for (int e = 0; e < 4; ++e) { pv3[e] = __shfl(g[3][e], srcp); pv2[e] = __shfl(g[2][e], srcp); }
#pragma unroll
                for (int j = 0; j < 2; ++j) {
                    const bool isT = (fr == 15);
                    const f32x4 sa = isT ? g[j + 2] : uu[j], sb = g[j];
                    u32x4 w; w.x = cvt_pk_bf16(sa[0], sa[1]); w.y = cvt_pk_bf16(sa[2], sa[3]); w.z = cvt_pk_bf16(sb[0], sb[1]); w.w = cvt_pk_bf16(sb[2], sb[3]);
                    unsigned char* dst = (isT ? FIXT2 : FIXP) + (((size_t)grp * 2 + j) * DFF + f0) * 4;
                    if (fr == 0 || fr == 15) *(u32x4*)dst = w;
                }
#pragma unroll
                for (int m = 0; m < 4; ++m) {
                    const f32x4 gm1 = (m == 0) ? pv3 : g[(m + 3) & 3], gm2 = (m == 0) ? pv2 : (m == 1) ? pv3 : g[(m + 2) & 3];
                    f32x4 av;
#pragma unroll
                    for (int e = 0; e < 4; ++e) {
                        const float y = bb[e] + w0[e] * gm2[e] + w1[e] * gm1[e] + w2[e] * g[m][e];
                        av[e] = y * __builtin_amdgcn_rcpf(1.f + __expf(-y)) * uu[m][e];
                    }
                    const int row = tok0 + 4 * fr + m;
                    const bool fixrow = (fr == 0) && (m < 2);
                    const unsigned long long pk = (unsigned long long)cvt_pk_bf16(av[0], av[1]) | ((unsigned long long)cvt_pk_bf16(av[2], av[3]) << 32);
                    if (hh == 0) keep[ai][m] = pk;
                    else if (!fixrow) { u32x4 w; w.x = (unsigned)keep[ai][m]; w.y = (unsigned)(keep[ai][m] >> 32); w.z = (unsigned)pk; w.w = (unsigned)(pk >> 32); __builtin_nontemporal_store(w, (u32x4*)(ACT + (size_t)row * DFF + f0 - 4)); }
                }
            }
        }
    }
};
}

template <int MAPK> __device__ __forceinline__ int colmap(int n) {
    if (MAPK == 1) {
        const int slot = n >> 6, c = n & 63;
        if (slot < 8) { const int m = c >> 5, cc = c & 31; return slot * 64 + m * 32 + ((cc & 1) ? (cc >> 1) + 16 : (cc >> 1)); }
        if (slot >= 12 && slot < 24) return slot * 64 + ((c & 1) ? (c >> 1) + 32 : (c >> 1));
        return n;
    }
    if (MAPK == 2) { const int pn = n >> 8, r = n & 255; return (r < 128) ? 128 * pn + r : DFF + 128 * pn + (r - 128); }
    return n;
}
template <int MAPK> __device__ __forceinline__ void transpose_item(const float* W, int K, int N, int ldw, bf16_t* WT, float* scr, int item, int lane) {
    const int nblk = N / 32, kb = item / nblk, nb = item % nblk, k0 = 64 * kb, n0 = 32 * nb;
    const int sc = colmap<MAPK>(n0 + (lane & 31));
    float tv[32];
#pragma unroll
    for (int i = 0; i < 32; ++i) tv[i] = W[(size_t)(k0 + 2 * i + (lane >> 5)) * ldw + sc];
#pragma unroll
    for (int i = 0; i < 32; ++i) scr[(2 * i + (lane >> 5)) * 33 + (lane & 31)] = tv[i];
    LDS_FENCE();
    const int c = lane & 7;
#pragma unroll
    for (int j = 0; j < 4; ++j) { const int n = (lane >> 3) + 8 * j; const float* s = scr + (8 * c) * 33 + n;
        u32x4 o; o.x = pk2(s[0 * 33], s[1 * 33]); o.y = pk2(s[2 * 33], s[3 * 33]); o.z = pk2(s[4 * 33], s[5 * 33]); o.w = pk2(s[6 * 33], s[7 * 33]);
        *(u32x4*)(WT + (size_t)(n0 + n) * K + k0 + 8 * c) = o; }
    LDS_FENCE();
}

__device__ __forceinline__ void prologue(const Args& a, unsigned char* lds, int tid, int G) {
    unsigned char* ws = a.ws;
    const int lane = tid & 63, wave = tid >> 6;
    const float* c_in = a.in[1]; const float* w_mod = a.in[2]; const float* b_mod = a.in[3];
    {
        float* sc = (float*)lds;
        float* red = (float*)(lds + 32768);
        for (int i = tid; i < NB * DM; i += 512) { const float v = c_in[i]; sc[i] = v / (1.f + __expf(-v)); }
        __syncthreads();
        float* MOD = (float*)(ws + WS_MOD);
        for (int item = blockIdx.x; item < DEPTH * (NMOD / 32); item += G) {
            const int l = item / (NMOD / 32), jb = item % (NMOD / 32), kg = tid >> 5, col = tid & 31;
            const float* wp = w_mod + ((size_t)l * DM + kg * 64) * NMOD + jb * 32 + col;
            float acc[8];
#pragma unroll
            for (int b = 0; b < 8; ++b) acc[b] = 0.f;
#pragma unroll 16
            for (int k = 0; k < 64; ++k) { const float w = wp[(size_t)k * NMOD];
#pragma unroll
                for (int b = 0; b < 8; ++b) acc[b] += sc[b * DM + kg * 64 + k] * w; }
#pragma unroll
            for (int b = 0; b < 8; ++b) red[(kg * 8 + b) * 32 + col] = acc[b];
            __syncthreads();
            if (tid < 256) { const int b = tid >> 5; float s = b_mod[(size_t)l * NMOD + jb * 32 + col];
#pragma unroll
              for (int g = 0; g < 16; ++g) s += red[(g * 8 + b) * 32 + col];
              MOD[((size_t)l * NB + b) * NMOD + jb * 32 + col] = s; }
            __syncthreads();
        }
    }
    __syncthreads();
    {
        const int gt = blockIdx.x * 512 + tid, NT_ = G * 512;
        float* RA = (float*)(ws + WS_ROPEA); float* RB = (float*)(ws + WS_ROPEB);
        for (int i = gt; i < T * 48; i += NT_) {
            const int t = i / 48, j = i % 48; const bool isA = j < 16; const int fi = isA ? j : j - 16; const float dim = isA ? 32.f : 64.f;
            const float e = (float)(2 * fi) / dim;
            const float pw = (float)exp2((double)e * 13.287712379549449);
            const float inv = 1.0f / pw;
            const float ang = (float)t * inv;
            const double x = (double)ang, k = rint(x * 0.15915494309189535);
            double r = fma(-k, 6.283185307179586, x); r = fma(-k, 2.4492935982947064e-16, r);
            const float rf = (float)r;
            const float cs = cosf(rf), sn = sinf(rf);
            float* dst = isA ? RA + ((size_t)t * 16 + fi) * 2 : RB + ((size_t)t * 32 + fi) * 2;
            dst[0] = cs; dst[1] = sn;
        }
        float* WFZ = (float*)(ws + WS_WFZ); const float* w_in = a.in[5];
        for (int i = gt; i < DEPTH * 6 * DM; i += NT_) { const int l = i / (6 * DM), r = i % (6 * DM), j = r / DM, k = r % DM; WFZ[i] = w_in[((size_t)l * DM + k) * INC + NIN + j]; }
    }
    {
        float* scr = (float*)(lds + wave * 16384);
        const int gw = blockIdx.x * 8 + wave, NGW = G * 8;
        constexpr int I_IN = (DM / 64) * (NIN / 32), I_OUT = (DM / 64) * (DM / 32), I_UP = (DM / 64) * (NUP / 32), I_DN = (DFF / 64) * (DM / 32), I_L = I_IN + I_OUT + I_UP + I_DN;
        for (int it = gw; it < DEPTH * I_L; it += NGW) {
            const int l = it / I_L; int r = it % I_L;
            bf16_t* WT = (bf16_t*)(ws + WS_WT) + (size_t)l * WL_ELEMS;
            if (r < I_IN) { transpose_item<1>(a.in[5] + (size_t)l * DM * INC, DM, NIN, INC, WT + WL_IN, scr, r, lane); continue; } r -= I_IN;
            if (r < I_OUT) { transpose_item<0>(a.in[9] + (size_t)l * DM * DM, DM, DM, DM, WT + WL_OUT, scr, r, lane); continue; } r -= I_OUT;
            if (r < I_UP) { transpose_item<2>(a.in[11] + (size_t)l * DM * NUP, DM, NUP, NUP, WT + WL_UP, scr, r, lane); continue; } r -= I_UP;
            transpose_item<0>(a.in[14] + (size_t)l * DFF * DM, DFF, DM, DM, WT + WL_DN, scr, r, lane);
        }
    }
}

template <bool FZ> __device__ __forceinline__ void norm_phase(const float* x, const bf16_t* xh, bf16_t* xcopy, bf16_t* H, const float* gw_, const float* modl, int shift_off, int scale_off,
                                                              const float* wfz, const float* fbias, float* LOGF, int tid, int G) {
    const int lane = tid & 63, wave = tid >> 6, gw = blockIdx.x * 8 + wave, NGW = G * 8;
    const int rpw = (MROWS + NGW - 1) / NGW;
    int r0 = gw * rpw, r1 = r0 + rpw; if (r1 > MROWS) r1 = MROWS;
    f32x4 A[4], B[4]; f32x4 wz[FZ ? 6 : 1][4]; float fb[6];
    if (FZ) {
#pragma unroll
        for (int j = 0; j < 6; ++j) { fb[j] = fbias[j];
#pragma unroll
            for (int q = 0; q < 4; ++q) wz[j][q] = *(const f32x4*)(wfz + j * DM + 4 * lane + 256 * q); }
    }
    int curb = -1;
    for (int r = r0; r < r1; ++r) {
        const int b = r >> 13;
        if (b != curb) { curb = b;
#pragma unroll
            for (int q = 0; q < 4; ++q) { const int c = 4 * lane + 256 * q; const f32x4 g4 = *(const f32x4*)(gw_ + c), s4 = *(const f32x4*)(modl + (size_t)b * NMOD + scale_off + c);
                A[q] = g4 * (s4 + 1.0f); B[q] = *(const f32x4*)(modl + (size_t)b * NMOD + shift_off + c); } }
        f32x4 v[4]; float s = 0.f;
        if (x) { const f32x4* xr = (const f32x4*)(x + (size_t)r * DM) + lane;
            unsigned long long* c8 = (unsigned long long*)(xcopy + (size_t)r * DM) + lane;
#pragma unroll
            for (int q = 0; q < 4; ++q) { v[q] = xr[64 * q]; c8[64 * q] = (unsigned long long)f2h2(v[q][0], v[q][1]) | ((unsigned long long)f2h2(v[q][2], v[q][3]) << 32); } }
        else { const unsigned long long* xr = (const unsigned long long*)(xh + (size_t)r * DM) + lane;
#pragma unroll
            for (int q = 0; q < 4; ++q) { const unsigned long long w = xr[64 * q]; const f32x2v a2 = h2f2((unsigned)w), b2 = h2f2((unsigned)(w >> 32));
                v[q] = (f32x4){a2[0], a2[1], b2[0], b2[1]}; } }
#pragma unroll
        for (int q = 0; q < 4; ++q) s += (v[q][0] * v[q][0] + v[q][1] * v[q][1]) + (v[q][2] * v[q][2] + v[q][3] * v[q][3]);
        const float rs = 1.0f / sqrtf(wave_sum(s) * (1.f / DM) + 1e-6f);
#pragma unroll
        for (int q = 0; q < 4; ++q) v[q] = v[q] * rs * A[q] + B[q];
        unsigned long long* o8 = (unsigned long long*)(H + (size_t)r * DM) + lane;
#pragma unroll
        for (int q = 0; q < 4; ++q) o8[64 * q] = (unsigned long long)pk2(v[q][0], v[q][1]) | ((unsigned long long)pk2(v[q][2], v[q][3]) << 32);
        if (FZ) {
            float z = 0.f;
#pragma unroll
            for (int j = 0; j < 6; ++j) { float d = 0.f;
#pragma unroll
                for (int q = 0; q < 4; ++q) d += (v[q][0] * wz[j][q][0] + v[q][1] * wz[j][q][1]) + (v[q][2] * wz[j][q][2] + v[q][3] * wz[j][q][3]);
                d = wave_sum(d) + fb[j]; if (lane == j) z = d; }
            if (lane < 6) { const float lf = fminf(z, 0.f) - log1pf(__expf(-fabsf(z))); LOGF[((size_t)b * 6 + lane) * T + (r & (T - 1))] = lf; }
        }
    }
}
__device__ __forceinline__ void final_norm(const bf16_t* xh, float* out, const float* g, int tid, int G) {
    const int lane = tid & 63, wave = tid >> 6, gw = blockIdx.x * 8 + wave, NGW = G * 8;
    f32x4 A[4];
#pragma unroll
    for (int q = 0; q < 4; ++q) A[q] = *(const f32x4*)(g + 4 * lane + 256 * q);
    for (int r = gw; r < MROWS; r += NGW) {
        const unsigned long long* xr = (const unsigned long long*)(xh + (size_t)r * DM) + lane;
        f32x4 v[4]; float s = 0.f;
#pragma unroll
        for (int q = 0; q < 4; ++q) { const unsigned long long w = xr[64 * q]; const f32x2v a2 = h2f2((unsigned)w), b2 = h2f2((unsigned)(w >> 32));
            v[q] = (f32x4){a2[0], a2[1], b2[0], b2[1]};
            s += (v[q][0] * v[q][0] + v[q][1] * v[q][1]) + (v[q][2] * v[q][2] + v[q][3] * v[q][3]); }
        const float rs = 1.0f / sqrtf(wave_sum(s) * (1.f / DM) + 1e-6f);
        f32x4* orow = (f32x4*)(out + (size_t)r * DM) + lane;
#pragma unroll
        for (int q = 0; q < 4; ++q) orow[64 * q] = v[q] * rs * A[q];
    }
}

__device__ __forceinline__ void cvec_phase(unsigned char* ws, int tid, int G) {
    const int lane = tid & 63, wave = tid >> 6, gw = blockIdx.x * 8 + wave, NGW = G * 8;
    const float* MOD = (const float*)(ws + WS_MOD); float* CUP = (float*)(ws + WS_CUP);
    for (int l = 0; l < DEPTH; ++l) {
        const bf16_t* WT = (const bf16_t*)(ws + WS_WT) + (size_t)l * WL_ELEMS + WL_UP;
        for (int n = gw; n < NUP; n += NGW) {
            const u32x4 w0 = *(const u32x4*)(WT + (size_t)n * DM + lane * 16), w1 = *(const u32x4*)(WT + (size_t)n * DM + lane * 16 + 8);
            float wv[16];
#pragma unroll
            for (int q = 0; q < 4; ++q) { wv[2 * q] = bf2f((unsigned short)(w0[q] & 0xffffu)); wv[2 * q + 1] = bf2f((unsigned short)(w0[q] >> 16)); wv[8 + 2 * q] = bf2f((unsigned short)(w1[q] & 0xffffu)); wv[8 + 2 * q + 1] = bf2f((unsigned short)(w1[q] >> 16)); }
            float mine = 0.f;
#pragma unroll
            for (int b = 0; b < NB; ++b) {
                const float* sp = MOD + ((size_t)l * NB + b) * NMOD + 3 * DM + lane * 16;
                float d = 0.f;
#pragma unroll
                for (int q = 0; q < 4; ++q) { const f32x4 s4 = *(const f32x4*)(sp + 4 * q); d += (s4[0] * wv[4 * q] + s4[1] * wv[4 * q + 1]) + (s4[2] * wv[4 * q + 2] + s4[3] * wv[4 * q + 3]); }
                d = wave_sum(d); if (lane == b) mine = d;
            }
            if (lane < NB) CUP[((size_t)l * NB + lane) * NUP + n] = mine;
        }
    }
}
__device__ __forceinline__ void scan_phase(float* LOGF, unsigned char* lds, int tid, int G) {
    float* wt = (float*)lds;
    for (int seq = blockIdx.x; seq < NB * 6; seq += G) {
        f32x4* p = (f32x4*)(LOGF + (size_t)seq * T) + tid * 4;
        f32x4 v[4]; float run = 0.f;
#pragma unroll
        for (int q = 0; q < 4; ++q) { v[q] = p[q];
#pragma unroll
            for (int i = 0; i < 4; ++i) { run += v[q][i]; v[q][i] = run; } }
        float inc = run;
        const int lane = tid & 63, wave = tid >> 6;
#pragma unroll
        for (int o = 1; o < 64; o <<= 1) { const float n = __shfl_up(inc, o); if (lane >= o) inc += n; }
        if (lane == 63) wt[wave] = inc;
        __syncthreads();
        float off = inc - run;
        for (int w = 0; w < wave; ++w) off += wt[w];
#pragma unroll
        for (int q = 0; q < 4; ++q) p[q] = (v[q] + off) * LOG2E;
        __syncthreads();
    }
}

__device__ __forceinline__ int crow(int r, int hi) { return (r & 3) + 8 * (r >> 2) + 4 * hi; }
typedef float f32x2_t __attribute__((ext_vector_type(2))); typedef __bf16 bf16x2_t __attribute__((ext_vector_type(2)));
__device__ __forceinline__ unsigned cvtpk(float lo, float hi) { f32x2_t v = {lo, hi}; bf16x2_t b = __builtin_convertvector(v, bf16x2_t); return __builtin_bit_cast(unsigned, b); }
__device__ __forceinline__ float max3f(float a, float b, float c) { float r; asm("v_max3_f32 %0, %1, %2, %3" : "=v"(r) : "v"(a), "v"(b), "v"(c)); return r; }
__device__ __forceinline__ float half_max(float m) { auto rr = __builtin_amdgcn_permlane32_swap(__float_as_uint(m), __float_as_uint(m), false, false); return fmaxf(__uint_as_float(rr[0]), __uint_as_float(rr[1])); }

template <int DK, int MODE>
__device__ __forceinline__ void attn_qk(const unsigned char* B, const unsigned char* qslot, int r32, int hi, int kfs, const bf16x8& qones, const f32x16& negm, f32x16& s0, f32x16& s1) {
    constexpr int ROWB = DK * 2, ND = DK / 16;
    bf16x8 kb0, kb1;
    if (MODE == 1) { kb0 = *(const bf16x8*)(B + AT_BIAS + r32 * 16); kb1 = *(const bf16x8*)(B + AT_BIAS + (32 + r32) * 16); }
#pragma unroll
    for (int h2 = 0; h2 < ND; h2 += 2) {
        bf16x8 kf[2][2], qf[2];
#pragma unroll
        for (int e = 0; e < 2; ++e) {
            const int d0 = h2 + e, ch = ((2 * d0 + hi) ^ kfs) << 4;
            kf[e][0] = *(const bf16x8*)(B + AT_K + r32 * ROWB + ch); kf[e][1] = *(const bf16x8*)(B + AT_K + (32 + r32) * ROWB + ch);
            qf[e] = *(const bf16x8*)(qslot + d0 * 1024);
        }
        __builtin_amdgcn_sched_barrier(0);
#pragma unroll
        for (int e = 0; e < 2; ++e) {
            if (h2 + e == 0) { s0 = __builtin_amdgcn_mfma_f32_32x32x16_bf16(kf[e][0], qf[e], negm, 0, 0, 0); s1 = __builtin_amdgcn_mfma_f32_32x32x16_bf16(kf[e][1], qf[e], negm, 0, 0, 0); }
            else { s0 = __builtin_amdgcn_mfma_f32_32x32x16_bf16(kf[e][0], qf[e], s0, 0, 0, 0); s1 = __builtin_amdgcn_mfma_f32_32x32x16_bf16(kf[e][1], qf[e], s1, 0, 0, 0); }
        }
    }
    if (MODE == 1) { s0 = __builtin_amdgcn_mfma_f32_32x32x16_bf16(kb0, qones, s0, 0, 0, 0); s1 = __builtin_amdgcn_mfma_f32_32x32x16_bf16(kb1, qones, s1, 0, 0, 0); }
}
template <int MODE>
__device__ __forceinline__ void attn_pv(bool fixn, const unsigned char* B, int key0, int qw, int qi, int r32, int hi, int vad0, int vad1, const bf16x8& ones, float* wsf,
                                        f32x16& p0, f32x16& p1, f32x16& n0, f32x16& n1, float& mref, f32x16& negm, f32x16& ol, f32x16& oa, f32x16& ob) {
    v4i16_t vl0[4], vh0[4], vl1[4], vh1[4];
#pragma unroll
    for (int j = 0; j < 2; ++j) {
        vl0[j] = __builtin_amdgcn_ds_read_tr16_b64_v4i16((LAS v4i16_t*)(B + vad0 + j * 2048)); vh0[j] = __builtin_amdgcn_ds_read_tr16_b64_v4i16((LAS v4i16_t*)(B + vad0 + j * 2048 + 1024));
        vl1[j] = __builtin_amdgcn_ds_read_tr16_b64_v4i16((LAS v4i16_t*)(B + vad1 + j * 2048)); vh1[j] = __builtin_amdgcn_ds_read_tr16_b64_v4i16((LAS v4i16_t*)(B + vad1 + j * 2048 + 1024));
    }
    if (MODE == 2) {
#pragma unroll
        for (int r = 0; r < 16; ++r) { const int dlt = qi - (key0 + crow(r, hi)); if (dlt < 0 || dlt > 128) p0[r] = -INFINITY; if (dlt - 32 < 0 || dlt - 32 > 128) p1[r] = -INFINITY; }
    } else if (key0 + 63 > qw) {
        asm volatile("" ::: "memory");
        const int lim = qi - key0 - 4 * hi;
#pragma unroll
        for (int r = 0; r < 16; ++r) { const int cr = (r & 3) + 8 * (r >> 2); if (cr > lim) p0[r] = -INFINITY; if (cr + 32 > lim) p1[r] = -INFINITY; }
    }
#define MX3(a, b, c) __builtin_fmaxf(__builtin_fmaxf((a), (b)), (c))
    float ra = MX3(p0[0], p0[1], p1[0]), rb = MX3(p0[2], p0[3], p1[1]); ra = MX3(ra, p1[2], p1[3]);
#pragma unroll
    for (int r = 4; r < 16; r += 4) { ra = MX3(ra, p0[r], p0[r + 1]); rb = MX3(rb, p0[r + 2], p0[r + 3]); ra = MX3(ra, p1[r], p1[r + 1]); rb = MX3(rb, p1[r + 2], p1[r + 3]); }
#undef MX3
    const float rm = half_max(__builtin_fmaxf(ra, rb));
    if (__any(rm > 8.f)) {
        const float dl = fmaxf(rm, 0.f); mref += dl;
#pragma unroll
        for (int r = 0; r < 16; ++r) { p0[r] -= dl; p1[r] -= dl; negm[r] = -mref; }
        if (fixn) {
#pragma unroll
            for (int r = 0; r < 16; ++r) { n0[r] -= dl; n1[r] -= dl; } }
        const float f = __builtin_amdgcn_exp2f(-dl);
        if (hi == 0) wsf[r32] = f;
        LDS_FENCE();
#pragma unroll
        for (int g = 0; g < 4; ++g) { const f32x4 fv = *(const f32x4*)(wsf + 8 * g + 4 * hi);
#pragma unroll
            for (int i = 0; i < 4; ++i) { oa[4 * g + i] *= fv[i]; ob[4 * g + i] *= fv[i]; ol[4 * g + i] *= fv[i]; } }
        LDS_FENCE();
    }
#pragma unroll
    for (int r = 0; r < 16; ++r) { p0[r] = __builtin_amdgcn_exp2f(p0[r]); p1[r] = __builtin_amdgcn_exp2f(p1[r]); }
#pragma unroll
    for (int j = 0; j < 4; ++j) {
        u32x4 pw;
        if (j < 2) { const int bs = 8 * (j & 1); pw = (u32x4){cvtpk(p0[bs], p0[bs + 1]), cvtpk(p0[bs + 2], p0[bs + 3]), cvtpk(p0[bs + 4], p0[bs + 5]), cvtpk(p0[bs + 6], p0[bs + 7])}; }
        else { const int bs = 8 * (j & 1); pw = (u32x4){cvtpk(p1[bs], p1[bs + 1]), cvtpk(p1[bs + 2], p1[bs + 3]), cvtpk(p1[bs + 4], p1[bs + 5]), cvtpk(p1[bs + 6], p1[bs + 7])}; }
        const bf16x8 pa = __builtin_bit_cast(bf16x8, pw);
        if (j < 2) {
            vl0[j + 2] = __builtin_amdgcn_ds_read_tr16_b64_v4i16((LAS v4i16_t*)(B + vad0 + (j + 2) * 2048)); vh0[j + 2] = __builtin_amdgcn_ds_read_tr16_b64_v4i16((LAS v4i16_t*)(B + vad0 + (j + 2) * 2048 + 1024));
            vl1[j + 2] = __builtin_amdgcn_ds_read_tr16_b64_v4i16((LAS v4i16_t*)(B + vad1 + (j + 2) * 2048)); vh1[j + 2] = __builtin_amdgcn_ds_read_tr16_b64_v4i16((LAS v4i16_t*)(B + vad1 + (j + 2) * 2048 + 1024));
        }
        { const bf16x8 vf = (bf16x8){vl0[j][0], vl0[j][1], vl0[j][2], vl0[j][3], vh0[j][0], vh0[j][1], vh0[j][2], vh0[j][3]};
          oa = __builtin_amdgcn_mfma_f32_32x32x16_bf16(pa, vf, oa, 0, 0, 0); }
        { const bf16x8 vf = (bf16x8){vl1[j][0], vl1[j][1], vl1[j][2], vl1[j][3], vh1[j][0], vh1[j][1], vh1[j][2], vh1[j][3]};
          ob = __builtin_amdgcn_mfma_f32_32x32x16_bf16(pa, vf, ob, 0, 0, 0); }
        ol = __builtin_amdgcn_mfma_f32_32x32x16_bf16(pa, ones, ol, 0, 0, 0);
    }
}

template <int DK, int MODE>
__device__ __forceinline__ void attn_core(unsigned char* lds, int tid_in, const bf16_t* Qg, long qrs, const bf16_t* Kg, long krs, const bf16_t* Vg, long vrs,
                                          const float* Fg, float fref, int q0, int kt_lo, int kt_hi, int korg,
                                          float& mref_out, f32x16& ol_out, f32x16& o0, f32x16& o1) {
    constexpr int ROWB = DK * 2, ND = DK / 16;
    int tid = tid_in; asm volatile("" : "+v"(tid));
    const int lane = tid & 63, wid = __builtin_amdgcn_readfirstlane(tid >> 6), r32 = lane & 31, hi = lane >> 5;
    const int qw = q0 + 32 * wid, qi = qw + r32;
    unsigned char* qslot = lds + AT_Q + wid * 4096 + lane * 16;
#pragma unroll
    for (int d0 = 0; d0 < ND; ++d0) *(bf16x8*)(qslot + d0 * 1024) = *(const bf16x8*)(Qg + (long)qi * qrs + d0 * 16 + hi * 8);
    f32x16 oa, ob, ol, negm, sa0, sa1, sb0, sb1;
#pragma unroll
    for (int r = 0; r < 16; ++r) { oa[r] = 0.f; ob[r] = 0.f; ol[r] = 0.f; negm[r] = 0.f; sa0[r] = 0.f; sa1[r] = 0.f; sb0[r] = 0.f; sb1[r] = 0.f; }
    float mref = 0.f;
    float* wsf = (float*)(lds + AT_WS + wid * 256);
    const bf16x8 ones = (bf16x8){0x3F80, 0x3F80, 0x3F80, 0x3F80, 0x3F80, 0x3F80, 0x3F80, 0x3F80};
    const bf16x8 qones = hi ? (bf16x8){0, 0, 0, 0, 0, 0, 0, 0} : (bf16x8){0x3F80, 0x3F80, 0x3F80, 0, 0, 0, 0, 0};
    const int krow = (DK == 64) ? (tid >> 3) : ((tid & 255) >> 2), kch = (DK == 64) ? (tid & 7) : (tid & 3);
    const int kswz = (DK == 64) ? ((krow >> 1) & 7) : ((krow >> 2) & 3);
    const bool kact = (DK == 64) || (tid < 256);
    const int vrow = tid >> 3, vch = tid & 7, vswz = (vrow & 2) << 1;
    const int koff = AT_K + krow * ROWB + ((kch ^ kswz) << 4), voff = AT_V + vrow * 128 + ((vch ^ vswz) << 4);
    const bf16_t* kptr = Kg + (long)(korg + 64 * kt_lo + krow) * krs + kch * 8; const bf16_t* vptr = Vg + (long)(korg + 64 * kt_lo + vrow) * vrs + vch * 8; const float* fptr = Fg + korg + 64 * kt_lo + (tid & 63);
    const int NT = kt_hi - kt_lo;
    u32x4 kreg0 = (u32x4){0u, 0u, 0u, 0u}, vreg0 = kreg0, kreg1 = kreg0, vreg1 = kreg0; float breg0 = 0.f, breg1 = 0.f;
#define AT_LOADK(S, i) do { if (kact) kreg##S = *(const u32x4*)(kptr + (long)(64 * (i)) * krs); if (MODE == 1 && tid < 64) breg##S = fref - fptr[64 * (i)]; } while (0)
#define AT_LOADV(S, i) do { vreg##S = *(const u32x4*)(vptr + (long)(64 * (i)) * vrs); } while (0)
#define AT_STOREK(S, buf) do { unsigned char* B_ = lds + (buf) * AT_BUF; if (kact) *(u32x4*)(B_ + koff) = kreg##S; \
        if (MODE == 1 && tid < 64) { const unsigned bh_ = f2bf(breg##S); const float r1_ = breg##S - __builtin_bit_cast(float, bh_ << 16); const unsigned bm_ = f2bf(r1_); \
            const float r2_ = r1_ - __builtin_bit_cast(float, bm_ << 16); const unsigned bl_ = f2bf(r2_); \
            *(u32x4*)(B_ + AT_BIAS + tid * 16) = (u32x4){bh_ | (bm_ << 16), bl_, 0u, 0u}; } } while (0)
#define AT_STOREV(S, buf) do { *(u32x4*)(lds + (buf) * AT_BUF + voff) = vreg##S; } while (0)
    const int kfs = (DK == 64) ? ((r32 >> 1) & 7) : ((r32 >> 2) & 3);
    const int q4 = (lane & 15) >> 2, p4 = lane & 3, dh = (lane >> 4) & 1;
    const int vs = (q4 & 2) >> 1;
    const int vbase = AT_V + (4 * hi + q4) * 128 + (p4 & 1) * 8;
    const int vc = 2 * dh + (p4 >> 1);
    const int vad0 = vbase + ((((0 ^ vs) << 2) | vc) << 4), vad1 = vbase + ((((1 ^ vs) << 2) | vc) << 4);
    const int kbase0 = 64 * kt_lo + korg;
#define AT_ACTIVE(i) ((MODE == 2) ? !((kbase0 + 64 * (i)) > qw + 31 || (kbase0 + 64 * (i)) + 63 < qw - 128) : !((kbase0 + 64 * (i)) > qw + 31))

    AT_LOADK(0, 0); AT_LOADV(0, 0); if (NT > 1) AT_LOADK(1, 1);
    AT_STOREK(0, 0); AT_STOREV(0, 0); if (NT > 1) AT_STOREK(1, 1);
    if (NT > 2) AT_LOADK(0, 2); if (NT > 3) AT_LOADK(1, 3); if (NT > 1) AT_LOADV(0, 1); if (NT > 2) AT_LOADV(1, 2);
    __syncthreads();
    if (AT_ACTIVE(0)) attn_qk<DK, MODE>(lds, qslot, r32, hi, kfs, qones, negm, sa0, sa1);
    __syncthreads();
#define AT_ITER(i, PAR, C0, C1, N0, N1) do { \
          \
        if ((i) + 2 < NT) AT_STOREK(PAR, PAR); \
        if ((i) + 1 < NT) AT_STOREV(PAR, 1 - (PAR)); \
        if ((i) + 4 < NT) AT_LOADK(PAR, (i) + 4); \
        if ((i) + 3 < NT) AT_LOADV(PAR, (i) + 3); \
        const bool an_ = ((i) + 1 < NT) && AT_ACTIVE((i) + 1); \
        if (an_) attn_qk<DK, MODE>(lds + (1 - (PAR)) * AT_BUF, qslot, r32, hi, kfs, qones, negm, N0, N1); \
        if (AT_ACTIVE(i)) attn_pv<MODE>(true, lds + (PAR) * AT_BUF, kbase0 + 64 * (i), qw, qi, r32, hi, vad0, vad1, ones, wsf, C0, C1, N0, N1, mref, negm, ol, oa, ob); \
        __syncthreads(); } while (0)
    for (int i = 0; i < NT; i += 2) {
        AT_ITER(i, 0, sa0, sa1, sb0, sb1);
        if (i + 1 >= NT) break;
        AT_ITER(i + 1, 1, sb0, sb1, sa0, sa1);
    }
#undef AT_ITER
#undef AT_LOADK
#undef AT_LOADV
#undef AT_STOREK
#undef AT_STOREV
#undef AT_ACTIVE
    mref_out = mref; ol_out = ol; o0 = oa; o1 = ob;
}


constexpr int ATB_WS = 6 * AT_BUF, ATB_Q = ATB_WS + 2048;
static_assert(ATB_Q + 32768 <= LDS_BYTES - 4096, "B-unit LDS map");
__device__ __forceinline__ void attn_core_band(unsigned char* lds, int tid_in, const bf16_t* Qg, const bf16_t* Kg, const bf16_t* Vg, long rs, int q0, int kt_lo, int korg,
                                               float& mref_out, f32x16& ol_out, f32x16& o0, f32x16& o1) {
    int tid = tid_in; asm volatile("" : "+v"(tid));
    const int lane = tid & 63, wid = __builtin_amdgcn_readfirstlane(tid >> 6), r32 = lane & 31, hi = lane >> 5;
    const int qw = q0 + 32 * wid, qi = qw + r32;
    unsigned char* qslot = lds + ATB_Q + wid * 4096 + lane * 16;
#pragma unroll
    for (int d0 = 0; d0 < 4; ++d0) *(bf16x8*)(qslot + d0 * 1024) = *(const bf16x8*)(Qg + (long)qi * rs + d0 * 16 + hi * 8);
    const int krow = tid >> 3, kch = tid & 7, kswz = (krow >> 1) & 7, vswz = (krow & 2) << 1;
    const int koff = AT_K + krow * 128 + ((kch ^ kswz) << 4), voff = AT_V + krow * 128 + ((kch ^ vswz) << 4);
    const int NT = 6 - kt_lo;
    const bf16_t* kptr = Kg + (long)(korg + 64 * kt_lo + krow) * rs + kch * 8; const bf16_t* vptr = Vg + (long)(korg + 64 * kt_lo + krow) * rs + kch * 8;
    u32x4 kr[6], vr[6];
#pragma unroll
    for (int i = 0; i < 6; ++i) if (i < NT) { kr[i] = *(const u32x4*)(kptr + (long)(64 * i) * rs); vr[i] = *(const u32x4*)(vptr + (long)(64 * i) * rs); }
#pragma unroll
    for (int i = 0; i < 6; ++i) if (i < NT) { *(u32x4*)(lds + i * AT_BUF + koff) = kr[i]; *(u32x4*)(lds + i * AT_BUF + voff) = vr[i]; }
    f32x16 oa, ob, ol, negm, s0, s1;
#pragma unroll
    for (int r = 0; r < 16; ++r) { oa[r] = 0.f; ob[r] = 0.f; ol[r] = 0.f; negm[r] = 0.f; s0[r] = 0.f; s1[r] = 0.f; }
    float mref = 0.f;
    float* wsf = (float*)(lds + ATB_WS + wid * 256);
    const bf16x8 ones = (bf16x8){0x3F80, 0x3F80, 0x3F80, 0x3F80, 0x3F80, 0x3F80, 0x3F80, 0x3F80};
    const bf16x8 qones = (bf16x8){0, 0, 0, 0, 0, 0, 0, 0};
    const int kfs = (r32 >> 1) & 7;
    const int q4 = (lane & 15) >> 2, p4 = lane & 3, dh = (lane >> 4) & 1, vs = (q4 & 2) >> 1;
    const int vbase = AT_V + (4 * hi + q4) * 128 + (p4 & 1) * 8, vc = 2 * dh + (p4 >> 1);
    const int vad0 = vbase + ((((0 ^ vs) << 2) | vc) << 4), vad1 = vbase + ((((1 ^ vs) << 2) | vc) << 4);
    const int kbase0 = 64 * kt_lo + korg;
    __syncthreads();
    for (int i = 0; i < NT; ++i) {
        const int key0 = kbase0 + 64 * i;
        if (!(key0 > qw + 31 || key0 + 63 < qw - 128)) {
            attn_qk<64, 2>(lds + i * AT_BUF, qslot, r32, hi, kfs, qones, negm, s0, s1);
            attn_pv<2>(false, lds + i * AT_BUF, key0, qw, qi, r32, hi, vad0, vad1, ones, wsf, s0, s1, s0, s1, mref, negm, ol, oa, ob);
        }
    }
    mref_out = mref; ol_out = ol; o0 = oa; o1 = ob;
}

__device__ __forceinline__ void row_bcast(float* wsf, float val, int r32, int hi, float (&out)[16]) {
    LDS_FENCE();
    if (hi == 0) wsf[r32] = val;
    LDS_FENCE();
#pragma unroll
    for (int g = 0; g < 4; ++g) { const f32x4 fv = *(const f32x4*)(wsf + 8 * g + 4 * hi);
#pragma unroll
        for (int i = 0; i < 4; ++i) out[4 * g + i] = fv[i]; }
    LDS_FENCE();
}

#ifndef PROBE_MASK
#define PROBE_MASK 0
#endif
#define TIC(id) unsigned long long t0_##id = 0; if ((PROBE_MASK >> (id)) & 1) t0_##id = __builtin_amdgcn_s_memrealtime()
#define TOC(id) if ((PROBE_MASK >> (id)) & 1) tacc += __builtin_amdgcn_s_memrealtime() - t0_##id
#define STG_BASE(stg) bf16_t* sp_; { int l_ = lane; asm volatile("" : "+v"(l_)); sp_ = (stg) + (l_ >> 5) * 256 + (l_ & 31); }
#define STG_PUT(r, a, b) do { const int o_ = (((r) & 3) + 8 * ((r) >> 2)) * 64; sp_[o_] = (bf16_t)f2bf(a); sp_[o_ + 32] = (bf16_t)f2bf(b); } while (0)
__device__ __forceinline__ void stage_flush(const bf16_t* stg, int lane_in, bf16_t* gbase, long grs) {
    int lane = lane_in; asm volatile("" : "+v"(lane));
    LDS_FENCE();
#pragma unroll
    for (int i = 0; i < 4; ++i) { const int row = i * 8 + (lane >> 3), ch = lane & 7; const u32x4 w = *(const u32x4*)(stg + row * 64 + ch * 8); *(u32x4*)(gbase + (long)row * grs + ch * 8) = w; }
    LDS_FENCE();
}

constexpr int N_AC = 32 * 80, N_BU = 3 * NB * 6 * 32, N_UNITS = N_AC + N_BU;

__device__ __forceinline__ void attn_phase(const Args& a, unsigned char* lds, int tid, int layer, unsigned long long& tacc) {
    unsigned char* ws = a.ws;
    const bf16_t* QKV = (const bf16_t*)(ws + WS_QKV);
    bf16_t* O = (bf16_t*)(ws + WS_O);
    bf16_t* OBP = (bf16_t*)(ws + WS_OBP);
    float* LSEB = (float*)(ws + WS_LSEB);
    const float* F2 = (const float*)(ws + WS_LOGF);
    const int lane = tid & 63, wid = __builtin_amdgcn_readfirstlane(tid >> 6), r32 = lane & 31, hi = lane >> 5;
    float* wsf = (float*)(lds + AT_WS + wid * 256);
    bf16_t* stg = (bf16_t*)(lds + AT_Q + wid * 4096);
    const float lam_init = 0.8f - 0.6f * __expf(-0.3f * (float)layer);
    float lam;
    { const float* lp = a.in[6] + (size_t)layer * 128; float s1 = 0.f, s2 = 0.f; if (lane < 32) { s1 = lp[lane] * lp[32 + lane]; s2 = lp[64 + lane] * lp[96 + lane]; }
      s1 = wave_sum(s1); s2 = wave_sum(s2); lam = expf(s1) - expf(s2) + lam_init; }
    const int G = gridDim.x, bx = blockIdx.x;
    const int vcu = (G % 8 == 0) ? (bx % 8) * (G / 8) + bx / 8 : bx;
    for (int it = vcu; it < 256 * 28; it += G) {
        const int s = it & 255, step = it >> 8, team = s >> 5, c = s & 31;
        int u;
        if (step < 6) { const int hd = team * 6 + step, qb = (step & 1) ? 31 - c : c; u = (31 - qb) * 80 + hd; }
        else if (step < 10) { const int st = step - 6, hd = team * 4 + st, qb = (st & 1) ? 31 - c : c; u = (31 - qb) * 80 + 48 + hd; }
        else { const int k = step - 10, hd = team * 6 + k / 3, p = k % 3; u = N_AC + ((p * 48 + hd) << 5) + c; }
        __syncthreads();
        float mref; f32x16 ol, o0, o1;
        if (u < N_AC) {
            const int qb = 31 - u / 80, j = u % 80, q0 = qb * 256;
            if (j < 48) {
#ifndef NO_VC
                TIC(13);
                const int b = j / 6, h = j % 6;
                const bf16_t* Qg = QKV + (size_t)(b * NSLOT + 30 + h) * T * 64; const bf16_t* Kg = QKV + (size_t)(b * NSLOT + 36 + h) * T * 64; const bf16_t* Vg = QKV + (size_t)(b * NSLOT + 42 + h) * T * 64;
                const float* Fg = F2 + (size_t)(b * 6 + h) * T;
                attn_core<64, 1>(lds, tid, Qg, 64, Kg, 64, Vg, 64, Fg, Fg[q0], q0, 0, 4 * qb + 4, 0, mref, ol, o0, o1);
                STG_BASE(stg);
#pragma unroll
                for (int r = 0; r < 16; ++r) { const float rl = __builtin_amdgcn_rcpf(ol[r]); STG_PUT(r, o0[r] * rl, o1[r] * rl); }
                stage_flush(stg, lane, O + (size_t)(b * T + q0 + 32 * wid) * DM + 640 + h * 64, DM);
                TOC(13);
#endif
            } else {
#ifndef NO_VA
                const int jj = j - 48, b = jj / 4, h = jj % 4;
                const bf16_t* Qg = QKV + (size_t)(b * NSLOT + h) * T * 64; const bf16_t* Kg = QKV + (size_t)(b * NSLOT + 4 + h) * T * 64; const bf16_t* Vg = QKV + (size_t)(b * NSLOT + 8 + h) * T * 64;
                attn_core<32, 0>(lds, tid, Qg, 32, Kg, 32, Vg, 64, nullptr, 0.f, q0, 0, 4 * qb + 4, 0, mref, ol, o0, o1);
                float* stash = (float*)(lds + AT_STASH + wid * 8192) + lane;
#pragma unroll
                for (int r = 0; r < 16; ++r) { const float rl = __builtin_amdgcn_rcpf(ol[r]); stash[r * 64] = o0[r] * rl; stash[(16 + r) * 64] = o1[r] * rl; }
                attn_core<32, 0>(lds, tid, Qg + (size_t)T * 32, 32, Kg + (size_t)T * 32, 32, Vg, 64, nullptr, 0.f, q0, 0, 4 * qb + 4, 0, mref, ol, o0, o1);
                const float* sg = a.in[7] + (size_t)layer * 64;
                const float g0 = sg[r32] * (1.0f - lam_init), g1 = sg[32 + r32] * (1.0f - lam_init);
                STG_BASE(stg);
#pragma unroll
                for (int r = 0; r < 16; ++r) {
                    const float rl = __builtin_amdgcn_rcpf(ol[r]);
                    const float a0 = stash[r * 64] - lam * (o0[r] * rl), a1 = stash[(16 + r) * 64] - lam * (o1[r] * rl);
                    float ss = a0 * a0 + a1 * a1;
                    ss += __shfl_xor(ss, 1); ss += __shfl_xor(ss, 2); ss += __shfl_xor(ss, 4); ss += __shfl_xor(ss, 8); ss += __shfl_xor(ss, 16);
                    const float rs = 1.0f / sqrtf(ss * (1.f / 64.f) + 1e-5f);
                    STG_PUT(r, a0 * rs * g0, a1 * rs * g1);
                }
                stage_flush(stg, lane, O + (size_t)(b * T + q0 + 32 * wid) * DM + h * 64, DM);
#endif
            }
        } else {
#ifndef NO_VB
            TIC(15);
            const int v = u - N_AC, k = v & 31, bhp = v >> 5, h = bhp % 6, b = (bhp / 6) % NB, p = bhp / (6 * NB);
            const int d = (p == 0) ? 1 : (p == 1) ? 4 : 16, bpc = 32 / d, cls = k / bpc, nb = k % bpc, q0 = nb * 256;
            const bf16_t* Qg = QKV + ((size_t)(b * NSLOT + 12 + h) * T + cls) * 64; const bf16_t* Kg = QKV + ((size_t)(b * NSLOT + 18 + h) * T + cls) * 64; const bf16_t* Vg = QKV + ((size_t)(b * NSLOT + 24 + h) * T + cls) * 64;
            const long rs_ = (long)d * 64;
            attn_core_band(lds, tid, Qg, Kg, Vg, rs_, q0, (nb == 0) ? 2 : 0, q0 - 128, mref, ol, o0, o1);
            float mr[16];
            row_bcast((float*)(lds + ATB_WS + wid * 256), mref, r32, hi, mr);
            const size_t pb = ((size_t)(p * NB + b) * 6 + h) * T;
            bf16_t* stgb = (bf16_t*)(lds + ATB_Q + wid * 4096);
            STG_BASE(stgb);
#pragma unroll
            for (int r = 0; r < 16; ++r) {
                const size_t tok = pb + cls + (size_t)d * (q0 + 32 * wid + crow(r, hi));
                const float rl = __builtin_amdgcn_rcpf(ol[r]);
                if (r32 == 0) LSEB[tok] = mr[r] + __log2f(ol[r]);
                STG_PUT(r, o0[r] * rl, o1[r] * rl);
            }
            stage_flush(stgb, lane, OBP + (pb + cls + (size_t)d * (q0 + 32 * wid)) * 64, rs_);
            TOC(15);
#endif
        }
    }
}

__device__ __forceinline__ void combine_phase(unsigned char* ws, int tid, int G) {
    const bf16_t* OBP = (const bf16_t*)(ws + WS_OBP); const float* LSEB = (const float*)(ws + WS_LSEB); bf16_t* O = (bf16_t*)(ws + WS_O);
    const size_t NI = (size_t)MROWS * 48, PS = (size_t)NB * 6 * T;
    for (size_t i = (size_t)blockIdx.x * 512 + tid; i < NI; i += (size_t)G * 512) {
        const int row = (int)(i / 48), rem = (int)(i % 48), h = rem >> 3, ch = rem & 7, b = row >> 13, t = row & (T - 1);
        const size_t e = ((size_t)b * 6 + h) * T + t;
        const float l0 = LSEB[e], l1 = LSEB[PS + e], l2 = LSEB[2 * PS + e];
        const float mx = fmaxf(l0, fmaxf(l1, l2));
        float w0 = __builtin_amdgcn_exp2f(l0 - mx), w1 = __builtin_amdgcn_exp2f(l1 - mx), w2 = __builtin_amdgcn_exp2f(l2 - mx);
        const float inv = 1.0f / (w0 + w1 + w2); w0 *= inv; w1 *= inv; w2 *= inv;
        const u32x4 a0 = *(const u32x4*)(OBP + e * 64 + ch * 8), a1 = *(const u32x4*)(OBP + (PS + e) * 64 + ch * 8), a2 = *(const u32x4*)(OBP + (2 * PS + e) * 64 + ch * 8);
        u32x4 o;
#pragma unroll
        for (int q = 0; q < 4; ++q) {
            const float x0 = w0 * bf2f((unsigned short)(a0[q] & 0xffffu)) + w1 * bf2f((unsigned short)(a1[q] & 0xffffu)) + w2 * bf2f((unsigned short)(a2[q] & 0xffffu));
            const float x1 = w0 * bf2f((unsigned short)(a0[q] >> 16)) + w1 * bf2f((unsigned short)(a1[q] >> 16)) + w2 * bf2f((unsigned short)(a2[q] >> 16));
            o[q] = pk2(x0, x1);
        }
        *(u32x4*)(O + (size_t)row * DM + 256 + h * 64 + ch * 8) = o;
    }
}
__device__ __forceinline__ void fix_phase(unsigned char* ws, const float* cw, const float* cb, int tid, int G) {
    const unsigned char* FIXP = (const unsigned char*)(ws + WS_FIX); const unsigned char* FIXT2 = FIXP + FIX_ELEMS * 4; bf16_t* ACT = (bf16_t*)(ws + WS_ACT);
    constexpr int F4 = DFF / 4; const int NI = 1024 * 2 * F4;
    for (int i = blockIdx.x * 512 + tid; i < NI; i += G * 512) {
        const int grp = i / (2 * F4), rem = i % (2 * F4), rr = rem / F4, f = (rem % F4) * 4;
        const int row = grp * 64 + rr, t = row & (T - 1);
#define FX_U2F(w, hi_) ((hi_) ? __builtin_bit_cast(float, (w) & 0xffff0000u) : __builtin_bit_cast(float, (w) << 16))
        const u32x4 own = *(const u32x4*)(FIXP + (((size_t)grp * 2 + rr) * DFF + f) * 4);
        const f32x4 uu = (f32x4){FX_U2F(own.x, 0), FX_U2F(own.x, 1), FX_U2F(own.y, 0), FX_U2F(own.y, 1)}, g0 = (f32x4){FX_U2F(own.z, 0), FX_U2F(own.z, 1), FX_U2F(own.w, 0), FX_U2F(own.w, 1)};
        f32x4 gm1 = (f32x4){0.f, 0.f, 0.f, 0.f}, gm2 = gm1;
        typedef unsigned u32x2t __attribute__((ext_vector_type(2)));
        const u32x2t t1 = (t >= 2 - rr && grp > 0) ? *(const u32x2t*)(FIXT2 + (((size_t)(grp - 1) * 2 + 1) * DFF + f) * 4) : (u32x2t){0u, 0u};
        const f32x4 tail1 = (f32x4){FX_U2F(t1.x, 0), FX_U2F(t1.x, 1), FX_U2F(t1.y, 0), FX_U2F(t1.y, 1)};
        if (rr == 0) {
            if (t >= 1) gm1 = tail1;
            if (t >= 2) { const u32x2t t0 = *(const u32x2t*)(FIXT2 + (((size_t)(grp - 1) * 2 + 0) * DFF + f) * 4); gm2 = (f32x4){FX_U2F(t0.x, 0), FX_U2F(t0.x, 1), FX_U2F(t0.y, 0), FX_U2F(t0.y, 1)}; }
        } else {
            const u32x4 p0 = *(const u32x4*)(FIXP + (((size_t)grp * 2 + 0) * DFF + f) * 4);
            gm1 = (f32x4){FX_U2F(p0.z, 0), FX_U2F(p0.z, 1), FX_U2F(p0.w, 0), FX_U2F(p0.w, 1)};
            if (t >= 2) gm2 = tail1;
        }
#undef FX_U2F
        const f32x4 w0 = *(const f32x4*)(cw + f), w1 = *(const f32x4*)(cw + DFF + f), w2 = *(const f32x4*)(cw + 2 * DFF + f), bb = *(const f32x4*)(cb + f);
        float av[4];
#pragma unroll
        for (int q = 0; q < 4; ++q) { const float y = bb[q] + w0[q] * gm2[q] + w1[q] * gm1[q] + w2[q] * g0[q]; av[q] = y * __builtin_amdgcn_rcpf(1.f + __expf(-y)) * uu[q]; }
        *(unsigned long long*)(ACT + (size_t)row * DFF + f) = (unsigned long long)pk2(av[0], av[1]) | ((unsigned long long)pk2(av[2], av[3]) << 32);
    }
}

#define XB_TMO      128
#define XB_XCNT(j)  (256  + 64 * (j))
#define XB_XSUB(j)  (1280 + 64 * (j))
#define XB_XGEN(j)  (2304 + 64 * (j))
#define XB_TOP      3328
#define XB_TOPGEN   3392
#define XCD_BAR_WORDS 3456
#define XB_SPIN_CAP (1u << 18)

__device__ __forceinline__ unsigned xb_ld(unsigned* p)              { return __hip_atomic_load(p, __ATOMIC_RELAXED, __HIP_MEMORY_SCOPE_AGENT); }
__device__ __forceinline__ unsigned xb_add(unsigned* p, unsigned v) { return __hip_atomic_fetch_add(p, v, __ATOMIC_RELAXED, __HIP_MEMORY_SCOPE_AGENT); }
__device__ __forceinline__ unsigned xb_xcc_id() { return (unsigned)__builtin_amdgcn_s_getreg((3 << 11) | 20) & 0xFu; }
#define XB_SPIN(cond, bar) do { unsigned _sp = 0; while (cond) { __builtin_amdgcn_s_sleep(1); \
    if ((++_sp & 255u) == 0u) { if (xb_ld(&(bar)[XB_TMO])) break; if (_sp > XB_SPIN_CAP) { atomicAdd(&(bar)[XB_TMO], 1u); break; } } } } while (0)

struct XcdBarrier {
    unsigned* bar; unsigned x;
    volatile LAS unsigned* st;
};

__device__ __forceinline__ XcdBarrier xcd_barrier_post(unsigned* bar, volatile LAS unsigned* st) {
    XcdBarrier b; b.bar = bar; b.x = xb_xcc_id(); b.st = st;
    if (threadIdx.x == 0) (void)xb_add(&bar[XB_XCNT(b.x)], 1u);
    return b;
}
__device__ __forceinline__ void xcd_barrier_complete(unsigned* bar, unsigned x, unsigned& nloc, unsigned& nx) {
    const unsigned G = gridDim.x * gridDim.y * gridDim.z;
    unsigned sum, cnt, mine, sp = 0u;
    for (;;) {
        sum = 0u; cnt = 0u; mine = 0u;
#pragma unroll
        for (unsigned j = 0; j < 16; ++j) { const unsigned c = xb_ld(&bar[XB_XCNT(j)]); sum += c; cnt += (c > 0u) ? 1u : 0u; mine = (j == x) ? c : mine; }
        if (sum == G) break;
        __builtin_amdgcn_s_sleep(1);
        if ((++sp & 255u) == 0u) { if (xb_ld(&bar[XB_TMO])) break; if (sp > XB_SPIN_CAP) { atomicAdd(&bar[XB_TMO], 1u); break; } }
    }
    nloc = mine > 0u ? mine : 1u; nx = cnt > 0u ? cnt : 1u;
}

__device__ __forceinline__ void xcd_barrier(const XcdBarrier& b) {
    asm volatile("s_waitcnt vmcnt(0)" ::: "memory");
    __syncthreads();
    if (threadIdx.x == 0) {
        unsigned* bar = b.bar;
        __builtin_amdgcn_s_waitcnt(0);
        unsigned nloc = b.st[0], nx = b.st[1];
        if (nloc == 0u) { xcd_barrier_complete(bar, b.x, nloc, nx); b.st[0] = nloc; b.st[1] = nx; }
        const unsigned old = xb_add(&bar[XB_XSUB(b.x)], 1u);
        const unsigned gen = old / nloc;
        if (old + 1u == (gen + 1u) * nloc) {
            __builtin_amdgcn_fence(__ATOMIC_RELEASE, "agent");
            asm volatile("s_waitcnt vmcnt(0)" ::: "memory");
            const unsigned og = xb_add(&bar[XB_TOP], 1u);
            const unsigned tg = og / nx;
            if (og + 1u == (tg + 1u) * nx) xb_add(&bar[XB_TOPGEN], 1u);
            else XB_SPIN(xb_ld(&bar[XB_TOPGEN]) == tg, bar);
            __builtin_amdgcn_fence(__ATOMIC_ACQUIRE, "agent");
            xb_add(&bar[XB_XGEN(b.x)], 1u);
            asm volatile("s_waitcnt vmcnt(0)" ::: "memory");
        } else {
            XB_SPIN(xb_ld(&bar[XB_XGEN(b.x)]) == gen, bar);
            __builtin_amdgcn_fence(__ATOMIC_ACQUIRE, "agent");
            asm volatile("s_waitcnt vmcnt(0)" ::: "memory");
        }
    }
    __syncthreads();
}

#define GSYNC() do { TIC(12); xcd_barrier(xbar); TOC(12); } while (0)
__global__ void __launch_bounds__(512, 2) fwd_mega(Args a) {
    extern __shared__ __attribute__((aligned(16))) unsigned char lds[];
    cg::grid_group grid = cg::this_grid();
    const int tid0 = threadIdx.x, G = gridDim.x;
#define LAUNDER_TID() int tid = tid0; asm volatile("" : "+v"(tid))
    unsigned char* ws = a.ws;
    PG8_LAS unsigned char* ldsl = (PG8_LAS unsigned char*)lds;
    bf16_t* H = (bf16_t*)(ws + WS_H);
    float* MOD = (float*)(ws + WS_MOD);
    unsigned* ctl = (unsigned*)(ws + WS_CTL);
    unsigned long long tacc = 0;
    if (tid0 < 64) ((volatile LAS unsigned*)(lds + LDS_BYTES - 4096))[tid0] = 0u;
    __syncthreads();
    XcdBarrier xbar = xcd_barrier_post(ctl + 4096, (volatile LAS unsigned*)(lds + LDS_BYTES - 4096) + 8);

#ifndef SK_PRO
    { TIC(1); LAUNDER_TID(); prologue(a, lds, tid, G); TOC(1); }
#endif
    grid.sync();
#pragma unroll 1
    for (int layer = 0; layer < DEPTH; ++layer) {
        const float* xin = (layer == 0) ? a.in[0] : nullptr;
        bf16_t* XB = (bf16_t*)(ws + WS_XB); bf16_t* XA = (bf16_t*)(ws + WS_XA);
        const float* modl = MOD + (size_t)layer * NB * NMOD;
        const bf16_t* WT = (const bf16_t*)(ws + WS_WT) + (size_t)layer * WL_ELEMS;
#ifndef SK_N1
        if (layer == 0) { LAUNDER_TID(); cvec_phase(ws, tid, G); }
        { TIC(2); LAUNDER_TID(); norm_phase<true>(xin, XB, XB, H, a.in[4] + (size_t)layer * DM, modl, 0, DM, (const float*)(ws + WS_WFZ) + (size_t)layer * 6 * DM, a.in[8] + (size_t)layer * 6, (float*)(ws + WS_LOGF), tid, G); TOC(2); }
#endif
        GSYNC();
#ifndef SK_SCAN
        { LAUNDER_TID(); scan_phase((float*)(ws + WS_LOGF), lds, tid, G); }
#endif
        __syncthreads();
#ifndef SK_GIN
        { TIC(3); pg8::Gemm g{H, WT + WL_IN, MROWS, NIN, DM}; pg8::StaticOrder S; S.init(MROWS, NIN, G, (int)blockIdx.x);
          pg8::EpiIn E{(bf16_t*)(ws + WS_QKV), (const float*)(ws + WS_ROPEA), (const float*)(ws + WS_ROPEB)};
          pg8::gemm_phase<pg8::EpiIn, pg8::StaticOrder, true, true>(ldsl, g, S, E); TOC(3); }
#endif
        GSYNC();
#ifndef SK_ATT
        { TIC(4); LAUNDER_TID(); attn_phase(a, lds, tid, layer, tacc); TOC(4); }
#endif
        GSYNC();
#ifndef SK_CMB
        { TIC(5); LAUNDER_TID(); combine_phase(ws, tid, G); TOC(5); }
#endif
        GSYNC();
#ifndef SK_GOUT
        { TIC(6); pg8::Gemm g{(const bf16_t*)(ws + WS_O), WT + WL_OUT, MROWS, DM, DM}; pg8::StaticOrder S; S.init(MROWS, DM, G, (int)blockIdx.x);
          pg8::EpiRes<true> E{XB, XB, modl + 2 * DM, XA, (unsigned long long*)(ws + WS_SSQ) + (size_t)layer * MROWS, a.in[10] + (size_t)layer * DM, modl + 4 * DM};
          pg8::gemm_phase<pg8::EpiRes<true>, pg8::StaticOrder, true, true>(ldsl, g, S, E); TOC(6); }
#endif
        GSYNC();
#ifndef SK_GUP
        { TIC(8); pg8::Gemm g{XA, WT + WL_UP, MROWS, NUP, DM}; pg8::StaticOrder S; S.init(MROWS, NUP, G, (int)blockIdx.x);
          float* FX = (float*)(ws + WS_FIX);
          pg8::EpiUp E{(bf16_t*)(ws + WS_ACT), (unsigned char*)FX, (unsigned char*)FX + FIX_ELEMS * 4, a.in[12] + (size_t)layer * 3 * DFF, a.in[13] + (size_t)layer * DFF,
                       (const unsigned long long*)(ws + WS_SSQ) + (size_t)layer * MROWS, (const float*)(ws + WS_CUP) + (size_t)layer * NB * NUP};
          pg8::gemm_phase<pg8::EpiUp, pg8::StaticOrder, true, true>(ldsl, g, S, E); TOC(8); }
#endif
        GSYNC();
#ifndef SK_FIX
        { TIC(9); LAUNDER_TID(); fix_phase(ws, a.in[12] + (size_t)layer * 3 * DFF, a.in[13] + (size_t)layer * DFF, tid, G); TOC(9); }
#endif
        GSYNC();
#ifndef SK_GDN
        { TIC(10); pg8::Gemm g{(const bf16_t*)(ws + WS_ACT), WT + WL_DN, MROWS, DM, DFF}; pg8::StaticOrder S; S.init(MROWS, DM, G, (int)blockIdx.x);
          pg8::EpiRes<false> E{XB, XB, modl + 5 * DM, nullptr, nullptr, nullptr, nullptr};
          pg8::gemm_phase<pg8::EpiRes<false>, pg8::StaticOrder, true, true>(ldsl, g, S, E); TOC(10); }
#endif
        GSYNC();
    }
    { TIC(11); LAUNDER_TID(); final_norm((const bf16_t*)(ws + WS_XB), a.out, a.in[15], tid, G); TOC(11); }
    if (PROBE_MASK != 0 && blockIdx.x == 0) { const unsigned long long ts = __builtin_amdgcn_s_memrealtime(); while (__builtin_amdgcn_s_memrealtime() - ts < tacc) __builtin_amdgcn_s_sleep(8); }
}

extern "C" void kernel_launch(void* const* d_in, const int* in_sizes, int n_in, void* d_out, int out_size, void* d_ws, size_t ws_size, hipStream_t stream) {
    static int grid = 0;
    if (grid == 0) {
        if (n_in != 16 || ws_size < WS_END) { fprintf(stderr, "kernel_launch: unexpected inputs (n_in %d, ws %zu)\n", n_in, ws_size); grid = -1; return; }
        int dev = 0, cus = 0, per_cu = 0;
        hipGetDevice(&dev);
        hipDeviceGetAttribute(&cus, hipDeviceAttributeMultiprocessorCount, dev);
        hipFuncSetAttribute((const void*)fwd_mega, hipFuncAttributeMaxDynamicSharedMemorySize, LDS_BYTES);
        hipOccupancyMaxActiveBlocksPerMultiprocessor(&per_cu, (const void*)fwd_mega, 512, LDS_BYTES);
        if (per_cu < 1) per_cu = 1;
        (void)hipGetLastError();
        grid = cus * per_cu;
    }
    if (grid < 0) return;
    hipMemsetAsync((char*)d_ws + WS_CTL, 0, CTL_BYTES, stream);
    hipMemsetAsync((char*)d_ws + WS_SSQ, 0, (size_t)DEPTH * MROWS * 8, stream);
    Args a{};
    for (int i = 0; i < 16; ++i) a.in[i] = (const float*)d_in[i];
    a.out = (float*)d_out; a.ws = (unsigned char*)d_ws;
    void* args[] = {&a};
    hipError_t e = hipLaunchCooperativeKernel((const void*)fwd_mega, dim3(grid), dim3(512), args, LDS_BYTES, stream);
    if (e != hipSuccess) fprintf(stderr, "cooperative launch failed: %s (grid %d)\n", hipGetErrorString(e), grid);
}
```

```cpp
#include <hip/hip_runtime.h>
#include <hip/hip_cooperative_groups.h>
#include <cstdio>
#include <cstdint>
namespace cg = cooperative_groups;
namespace pg8 {
#define PG8_LAS __attribute__((address_space(3)))
typedef unsigned short bf16_t;
typedef short bf16x8 __attribute__((ext_vector_type(8)));
typedef float f32x4 __attribute__((ext_vector_type(4)));
typedef unsigned u32x4 __attribute__((ext_vector_type(4)));
constexpr int BM = 256, BK = 64, HALF = 128, HTB = HALF * BK * 2  , STAGE_BYTES = 8 * HTB, NXCD = 8, WGM = 8;

__host__ __device__ __forceinline__ int lds_byte(int r, int c) { const int st = (r >> 4) * 2 + (c >> 5), rr = r & 15, cc = c & 31, ob = rr * 64 + cc * 2; return st * 1024 + (ob ^ (((ob >> 9) & 1) << 5)); }
__host__ __device__ __forceinline__ void stage_rc(int b, int& R, int& C) { const int st = b / 1024, sb = b % 1024, swz = sb ^ (((sb >> 9) & 1) << 5); R = (st >> 1) * 16 + swz / 64; C = (st & 1) * 32 + (swz % 64) / 2; }
__host__ __device__ __forceinline__ int perm32(int rho) { const int n = rho >> 4, i = rho & 15; return 8 * (i >> 2) + 4 * n + (i & 3); }

struct Unit { int pm, pn; };
struct Gemm { const bf16_t* A; const bf16_t* Bt; int M, N, K; };

struct StaticOrder {
    int nM, nN, nwg, G, c;
    __host__ __device__ void init(int M, int N, int G_, int c_) { nM = M / BM; nN = N / BM; nwg = nM * nN; G = G_; c = c_; }
    __host__ __device__ bool next(int i, Unit& u) const {
        const long L = (long)i * G + c; if (L >= nwg) return false;
        int wgid = (int)L; { const int q = nwg / NXCD, r = nwg % NXCD, xcd = wgid % NXCD, off = wgid / NXCD; wgid = (xcd < r ? xcd * (q + 1) : r * (q + 1) + (xcd - r) * q) + off; }
        const int nig = WGM * nN, gid = wgid / nig, fm = gid * WGM, gsz = (nM - fm) < WGM ? (nM - fm) : WGM;
        u.pm = fm + ((wgid % nig) % gsz); u.pn = (wgid % nig) / gsz; return true;
    }
    __device__ __forceinline__ void a_ready(const Unit&) const {}
    __device__ __forceinline__ void done(const Unit&) const {}
};

__device__ __forceinline__ unsigned cvt_pk_bf16(float lo, float hi) { unsigned r; asm volatile("v_cvt_pk_bf16_f32 %0, %1, %2" : "=v"(r) : "v"(lo), "v"(hi)); return r; }
template <class Epi, class Sched, bool ALIGN_EPI = false, bool SP2 = false>
__device__ __forceinline__ void gemm_phase(PG8_LAS unsigned char* lds, const Gemm g, const Sched& S, const Epi& E) {
    int tid_l = threadIdx.x; asm volatile("" : "+v"(tid_l));
    const int tid = tid_l, wid = __builtin_amdgcn_readfirstlane(tid >> 6), lane = tid & 63, wr = wid >> 2, wc = wid & 3, fr = lane & 15, fq = lane >> 4;
    const int K = g.K, nt = K / BK;
    unsigned voffA[2], voffB[2];
#pragma unroll
    for (int i = 0; i < 2; ++i) { int R, C; stage_rc(tid * 16 + i * 8192, R, C); const int Rb = Epi::PERM ? ((R & ~31) + perm32(R & 31)) : R;
        voffA[i] = (unsigned)(R * K + C) * 2u; voffB[i] = (unsigned)(Rb * K + C) * 2u; }
    const size_t kstep = (size_t)(BK * 2);
    const size_t hstep = (size_t)HALF * K * 2;
    const size_t tstep = 2 * hstep;
    const unsigned ldsw = (unsigned)wid * 1024u;
    const int aoff = lds_byte(wr * 64 + fr, fq * 8), boff = lds_byte(wc * 32 + fr, fq * 8);
#define PG8_SA(b, h) (((b) * 2 + (h)) * HTB)
#define PG8_SB(b, h) ((4 + (b) * 2 + (h)) * HTB)
#define PG8_STAGE(bufoff, gbase, voff) do { _Pragma("unroll") for (int _i = 0; _i < 2; ++_i) \
        __builtin_amdgcn_global_load_lds((const unsigned*)((const char*)(gbase) + (voff)[_i]), (PG8_LAS unsigned*)(lds + (bufoff) + ldsw + _i * 8192), 16, 0, 0); } while (0)
#define PG8_LDA(dst, b, h) do { _Pragma("unroll") for (int m = 0; m < 4; ++m) _Pragma("unroll") for (int k = 0; k < 2; ++k) dst[m][k] = *(const PG8_LAS bf16x8*)(lds + PG8_SA(b, h) + aoff + m * 2048 + k * 1024); } while (0)
#define PG8_LDB(dst, b, h) do { _Pragma("unroll") for (int n = 0; n < 2; ++n) _Pragma("unroll") for (int k = 0; k < 2; ++k) dst[n][k] = *(const PG8_LAS bf16x8*)(lds + PG8_SB(b, h) + boff + n * 2048 + k * 1024); } while (0)
#define PG8_MMA(ai, bj, At, Bt) do { __builtin_amdgcn_s_setprio(1); _Pragma("unroll") for (int m = 0; m < 4; ++m) _Pragma("unroll") for (int n = 0; n < 2; ++n) _Pragma("unroll") for (int k = 0; k < 2; ++k) \
        acc[ai][bj][m][n] = __builtin_amdgcn_mfma_f32_16x16x32_bf16(Bt[n][k], At[m][k], acc[ai][bj][m][n], 0, 0, 0); __builtin_amdgcn_s_setprio(0); } while (0)
#define PG8_WAIT_V(n) asm volatile("s_waitcnt vmcnt(" #n ")" ::: "memory")
#define PG8_WAIT_L(n) asm volatile("s_waitcnt lgkmcnt(" #n ")" ::: "memory")
#define PG8_BAR __builtin_amdgcn_s_barrier()
#define PG8_SCHED __builtin_amdgcn_sched_barrier(0)
    Unit cur, nxt; int ui = 0;
    if (!S.next(0, cur)) return;
    f32x4 acc[2][2][4][2];
#pragma unroll
    for (int a = 0; a < 2; ++a)
#pragma unroll
        for (int b = 0; b < 2; ++b)
#pragma unroll
            for (int m = 0; m < 4; ++m)
#pragma unroll
                for (int n = 0; n < 2; ++n) acc[a][b][m][n] = (f32x4){0.f, 0.f, 0.f, 0.f};
    bf16x8 At[4][2], B0[2][2], B1[2][2];
    const char* cA = (const char*)g.A + (size_t)cur.pm * tstep; const char* cB = (const char*)g.Bt + (size_t)cur.pn * tstep;
    S.a_ready(cur);
    if constexpr (SP2) {
        PG8_STAGE(PG8_SB(0, 0), cB, voffB); PG8_STAGE(PG8_SB(0, 1), cB + hstep, voffB); PG8_STAGE(PG8_SA(0, 0), cA, voffA); PG8_STAGE(PG8_SA(0, 1), cA + hstep, voffA);
        if (wr == 1) PG8_BAR;
        PG8_WAIT_V(2); PG8_BAR;
        PG8_STAGE(PG8_SB(1, 0), cB + kstep, voffB); PG8_STAGE(PG8_SA(1, 0), cA + kstep, voffA); PG8_STAGE(PG8_SB(1, 1), cB + hstep + kstep, voffB);
        PG8_WAIT_V(6); PG8_BAR;
    } else {
        PG8_STAGE(PG8_SB(0, 0), cB, voffB); PG8_STAGE(PG8_SA(0, 0), cA, voffA); PG8_STAGE(PG8_SB(0, 1), cB + hstep, voffB); PG8_STAGE(PG8_SA(0, 1), cA + hstep, voffA);
        if (wr == 1) PG8_BAR;
        PG8_WAIT_V(4); PG8_BAR;
        PG8_STAGE(PG8_SB(1, 0), cB + kstep, voffB); PG8_STAGE(PG8_SA(1, 0), cA + kstep, voffA); PG8_STAGE(PG8_SB(1, 1), cB + hstep + kstep, voffB);
        PG8_WAIT_V(6); PG8_BAR;
    }
    for (;;) {
        const bool has_next = S.next(ui + 1, nxt);
        const char* nA = has_next ? (const char*)g.A + (size_t)nxt.pm * tstep : cA; const char* nB = has_next ? (const char*)g.Bt + (size_t)nxt.pn * tstep : cB;
        for (int t = 0; t < nt; t += 2) {
            const bool last = (t == nt - 2);
            const char* a1 = cA + (size_t)(t + 1) * kstep;
            const char* a2 = last ? nA : cA + (size_t)(t + 2) * kstep; const char* b2 = last ? nB : cB + (size_t)(t + 2) * kstep;
            const char* a3 = a2 + kstep; const char* b3 = b2 + kstep;
            if (last && has_next) S.a_ready(nxt);
            if constexpr (SP2) {
            PG8_LDB(B0, 0, 0); PG8_LDB(B1, 0, 1); PG8_SCHED; PG8_LDA(At, 0, 0); PG8_STAGE(PG8_SA(1, 1), a1 + hstep, voffA);
            PG8_WAIT_V(8); PG8_WAIT_L(0); PG8_BAR; PG8_MMA(0, 0, At, B0); PG8_MMA(0, 1, At, B1); PG8_BAR; PG8_SCHED;
            PG8_LDA(At, 0, 1); PG8_STAGE(PG8_SB(0, 0), b2, voffB); PG8_STAGE(PG8_SB(0, 1), b2 + hstep, voffB); PG8_STAGE(PG8_SA(0, 0), a2, voffA);
            PG8_WAIT_V(8); PG8_WAIT_L(0); PG8_BAR; PG8_MMA(1, 0, At, B0); PG8_MMA(1, 1, At, B1); PG8_BAR; PG8_SCHED;
            PG8_LDB(B0, 1, 0); PG8_LDB(B1, 1, 1); PG8_SCHED; PG8_LDA(At, 1, 0); PG8_STAGE(PG8_SA(0, 1), a2 + hstep, voffA);
            PG8_WAIT_V(8); PG8_WAIT_L(0); PG8_BAR; PG8_MMA(0, 0, At, B0); PG8_MMA(0, 1, At, B1); PG8_BAR; PG8_SCHED;
            PG8_LDA(At, 1, 1); PG8_STAGE(PG8_SB(1, 0), b3, voffB); PG8_STAGE(PG8_SB(1, 1), b3 + hstep, voffB); PG8_STAGE(PG8_SA(1, 0), a3, voffA);
            PG8_WAIT_V(8); PG8_WAIT_L(0); PG8_BAR; PG8_MMA(1, 0, At, B0); PG8_MMA(1, 1, At, B1); PG8_BAR; PG8_SCHED;
            } else {
            PG8_LDB(B0, 0, 0); PG8_SCHED; PG8_LDA(At, 0, 0); PG8_STAGE(PG8_SA(1, 1), a1 + hstep, voffA);
            PG8_WAIT_L(8); PG8_BAR; PG8_WAIT_L(0); PG8_MMA(0, 0, At, B0); PG8_BAR; PG8_SCHED;
            PG8_LDB(B1, 0, 1); PG8_STAGE(PG8_SB(0, 0), b2, voffB);
            PG8_BAR; PG8_WAIT_L(0); PG8_MMA(0, 1, At, B1); PG8_BAR;
            PG8_LDA(At, 0, 1); PG8_STAGE(PG8_SA(0, 0), a2, voffA);
            PG8_BAR; PG8_WAIT_L(0); PG8_MMA(1, 0, At, B0); PG8_BAR; PG8_SCHED;
            PG8_STAGE(PG8_SB(0, 1), b2 + hstep, voffB);
            PG8_WAIT_V(6); PG8_BAR; PG8_MMA(1, 1, At, B1); PG8_BAR;
            PG8_LDB(B0, 1, 0); PG8_SCHED; PG8_LDA(At, 1, 0); PG8_STAGE(PG8_SA(0, 1), a2 + hstep, voffA);
            PG8_WAIT_L(8); PG8_BAR; PG8_WAIT_L(0); PG8_MMA(0, 0, At, B0); PG8_BAR; PG8_SCHED;
            PG8_LDB(B1, 1, 1); PG8_STAGE(PG8_SB(1, 0), b3, voffB);
            PG8_BAR; PG8_WAIT_L(0); PG8_MMA(0, 1, At, B1); PG8_BAR;
            PG8_LDA(At, 1, 1); PG8_STAGE(PG8_SA(1, 0), a3, voffA);
            PG8_BAR; PG8_WAIT_L(0); PG8_MMA(1, 0, At, B0); PG8_BAR; PG8_SCHED;
            PG8_STAGE(PG8_SB(1, 1), b3 + hstep, voffB);
            PG8_WAIT_V(6); PG8_BAR; PG8_MMA(1, 1, At, B1); PG8_BAR;
            }
        }
        if constexpr (ALIGN_EPI) { if (wr == 0) PG8_BAR; }
        if constexpr (!Epi::AFTER_DRAIN) { E(acc, cur, wr, wc, fr, fq); S.done(cur); }
        if (!has_next) break;
#pragma unroll
        for (int a = 0; a < 2; ++a)
#pragma unroll
            for (int b = 0; b < 2; ++b)
#pragma unroll
                for (int m = 0; m < 4; ++m)
#pragma unroll
                    for (int n = 0; n < 2; ++n) acc[a][b][m][n] = (f32x4){0.f, 0.f, 0.f, 0.f};
        cur = nxt; cA = nA; cB = nB; ++ui;
        if constexpr (ALIGN_EPI) { if (wr == 1) PG8_BAR; }
    }
    PG8_WAIT_V(0);
    if constexpr (!ALIGN_EPI) { if (wr == 0) PG8_BAR; }
    PG8_BAR;
    if constexpr (Epi::AFTER_DRAIN) { E.fused(acc, cur, wr, wc, fr, fq, lds, wid, lane); S.done(cur); }
#undef PG8_SA
#undef PG8_SB
#undef PG8_STAGE
#undef PG8_LDA
#undef PG8_LDB
#undef PG8_MMA
#undef PG8_WAIT_V
#undef PG8_WAIT_L
#undef PG8_BAR
#undef PG8_SCHED
}
}

using pg8::bf16_t; using pg8::f32x4; using pg8::u32x4; using pg8::bf16x8;
typedef float f32x16 __attribute__((ext_vector_type(16)));
typedef short v4i16_t __attribute__((ext_vector_type(4)));
#define LAS __attribute__((address_space(3)))

constexpr int NB = 8, T = 8192, DM = 1024, DEPTH = 4, MROWS = NB * T;
constexpr int INC = 3078, NIN = 3072, DFF = 2816, NUP = 5632, NSLOT = 48, NMOD = 6 * DM;
constexpr float LOG2E = 1.4426950408889634f;
constexpr float QSC_A = 0.17677669529663687f * LOG2E;
constexpr float QSC_B = 0.125f * LOG2E;

constexpr size_t MiB = 1u << 20;
constexpr size_t WS_CTL = 0, CTL_BYTES = 1 * MiB;
constexpr size_t WS_WT = 2 * MiB;
constexpr size_t WL_IN = 0, WL_OUT = (size_t)NIN * DM, WL_UP = WL_OUT + (size_t)DM * DM, WL_DN = WL_UP + (size_t)NUP * DM, WL_ELEMS = WL_DN + (size_t)DM * DFF;
constexpr size_t WS_MOD = 102 * MiB;
constexpr size_t WS_ROPEA = 103 * MiB;
constexpr size_t WS_ROPEB = 104 * MiB;
constexpr size_t WS_WFZ = 106 * MiB;
constexpr size_t WS_LOGF = 107 * MiB;
constexpr size_t WS_LSEB = 109 * MiB;
constexpr size_t WS_XB = 116 * MiB;
constexpr size_t WS_H = 628 * MiB;
constexpr size_t WS_QKV = 244 * MiB;
constexpr size_t WS_ACT = WS_QKV;
constexpr size_t WS_O = 628 * MiB;
constexpr size_t WS_OBP = 756 * MiB;
constexpr size_t WS_FIX = WS_OBP;
constexpr size_t FIX_ELEMS = (size_t)1024 * 2 * DFF;
constexpr size_t WS_SSQ = 114 * MiB;
constexpr size_t WS_XA = 822 * MiB;
constexpr size_t WS_CUP = 950 * MiB;
constexpr size_t WS_END = 952 * MiB;
static_assert(WS_WT + WL_ELEMS * 2 * DEPTH <= WS_MOD, "weights fit");
static_assert(WS_FIX + 3 * FIX_ELEMS * 4 <= WS_XA && WS_XA + (size_t)65536 * 1024 * 2 <= WS_CUP, "fix / xa fit");

constexpr int LDS_BYTES = 147456;
constexpr int MISC_OFF = 131072;
constexpr int AT_K = 0, AT_V = 8192, AT_BIAS = 16384, AT_BUF = 17408, AT_WS = 2 * AT_BUF, AT_Q = AT_WS + 2048, AT_STASH = AT_Q + 32768;

struct Args { const float* in[16]; float* out; unsigned char* ws; };

__device__ __forceinline__ unsigned f2bf(float f) { unsigned u = __builtin_bit_cast(unsigned, f); return (u + 0x7fffu + ((u >> 16) & 1u)) >> 16; }
__device__ __forceinline__ unsigned pk2(float lo, float hi) { return f2bf(lo) | (f2bf(hi) << 16); }
__device__ __forceinline__ float bf2f(unsigned short h) { return __builtin_bit_cast(float, (unsigned)h << 16); }
typedef _Float16 h16x2 __attribute__((ext_vector_type(2))); typedef float f32x2v __attribute__((ext_vector_type(2)));
__device__ __forceinline__ unsigned f2h2(float lo, float hi) { const f32x2v v = {lo, hi}; const h16x2 h = __builtin_convertvector(v, h16x2); return __builtin_bit_cast(unsigned, h); }
__device__ __forceinline__ f32x2v h2f2(unsigned w) { const h16x2 h = __builtin_bit_cast(h16x2, w); return __builtin_convertvector(h, f32x2v); }
__device__ __forceinline__ float wave_sum(float v) {
#pragma unroll
    for (int o = 1; o < 64; o <<= 1) v += __shfl_xor(v, o);
    return v;
}
#define LDS_FENCE() asm volatile("s_waitcnt lgkmcnt(0)" ::: "memory")

namespace pg8 {
struct EpiIn {
    static constexpr bool PERM = true, AFTER_DRAIN = false;
    bf16_t* QKV; const float* ropeA; const float* ropeB;
    __device__ __forceinline__ void operator()(const f32x4 (&acc)[2][2][4][2], const Unit& u, int wr, int wc, int fr, int fq) const {
        const int c0 = 32 * (wc & 1) + 8 * fq;
        int kind[2]; float sc[2]; int slot[2];
#pragma unroll
        for (int bj = 0; bj < 2; ++bj) {
            const int s = 4 * u.pn + 2 * bj + (wc >> 1); slot[bj] = s; kind[bj] = 0; sc[bj] = 1.f;
            if (s < 8) { kind[bj] = 1; if (s < 4) sc[bj] = QSC_A; }
            else if (s >= 12 && s < 24) { kind[bj] = 2; if (s < 18) sc[bj] = QSC_B; }
            else if (s >= 30 && s < 36) sc[bj] = QSC_B;
        }
        const int kk = kind[0] ? kind[0] : kind[1];
#pragma unroll
        for (int ai = 0; ai < 2; ++ai)
#pragma unroll
            for (int m = 0; m < 4; ++m) {
                const int row = u.pm * BM + ai * HALF + wr * 64 + m * 16 + fr, b = row >> 13, t = row & (T - 1);
                f32x4 c01 = (f32x4){1.f, 0.f, 1.f, 0.f}, c23 = c01;
                if (kk) { const float* tb = (kk == 1) ? ropeA + ((size_t)t * 16 + 4 * fq) * 2 : ropeB + ((size_t)t * 32 + 16 * (wc & 1) + 4 * fq) * 2;
                          c01 = *(const f32x4*)tb; c23 = *(const f32x4*)(tb + 4); }
#pragma unroll
                for (int bj = 0; bj < 2; ++bj) {
                    f32x4 v0 = acc[ai][bj][m][0], v1 = acc[ai][bj][m][1];
                    if (kind[bj]) {
                        f32x4 w0, w1;
                        w0[0] = v0[0] * c01[0] - v0[1] * c01[1]; w0[1] = v0[1] * c01[0] + v0[0] * c01[1];
                        w0[2] = v0[2] * c01[2] - v0[3] * c01[3]; w0[3] = v0[3] * c01[2] + v0[2] * c01[3];
                        w1[0] = v1[0] * c23[0] - v1[1] * c23[1]; w1[1] = v1[1] * c23[0] + v1[0] * c23[1];
                        w1[2] = v1[2] * c23[2] - v1[3] * c23[3]; w1[3] = v1[3] * c23[2] + v1[2] * c23[3];
                        v0 = w0; v1 = w1;
                    }
                    v0 = v0 * sc[bj]; v1 = v1 * sc[bj];
                    u32x4 w; w.x = cvt_pk_bf16(v0[0], v0[1]); w.y = cvt_pk_bf16(v0[2], v0[3]); w.z = cvt_pk_bf16(v1[0], v1[1]); w.w = cvt_pk_bf16(v1[2], v1[3]);
                    const size_t sb = (size_t)(b * NSLOT + slot[bj]) * T * 64;
                    const size_t off = (kind[bj] == 1) ? sb + (size_t)(wc & 1) * T * 32 + (size_t)t * 32 + 8 * fq : sb + (size_t)t * 64 + c0;
                    __builtin_nontemporal_store(w, (u32x4*)(QKV + off));
                }
            }
    }
};
template <bool NORM> struct EpiRes {
    static constexpr bool PERM = true, AFTER_DRAIN = false;
    const bf16_t* bh; bf16_t* xo; const float* gate;
    bf16_t* XA; unsigned long long* ssq; const float* gnorm; const float* scale;
    __device__ __forceinline__ void operator()(const f32x4 (&acc)[2][2][4][2], const Unit& u, int wr, int wc, int fr, int fq) const {
        const int b = (u.pm * BM) >> 13;
        float sq[2][4];
#pragma unroll
        for (int ai = 0; ai < 2; ++ai)
#pragma unroll
            for (int m = 0; m < 4; ++m) sq[ai][m] = 0.f;
#pragma unroll
        for (int bj = 0; bj < 2; ++bj) {
            const int col = u.pn * BM + bj * HALF + wc * 32 + 8 * fq;
            const f32x4 g0 = *(const f32x4*)(gate + (size_t)b * NMOD + col), g1 = *(const f32x4*)(gate + (size_t)b * NMOD + col + 4);
            f32x4 a0 = (f32x4){0.f, 0.f, 0.f, 0.f}, a1 = a0;
            if (NORM) { a0 = *(const f32x4*)(gnorm + col) * (*(const f32x4*)(scale + (size_t)b * NMOD + col) + 1.0f); a1 = *(const f32x4*)(gnorm + col + 4) * (*(const f32x4*)(scale + (size_t)b * NMOD + col + 4) + 1.0f); }
#pragma unroll
            for (int ai = 0; ai < 2; ++ai)
#pragma unroll
                for (int m = 0; m < 4; ++m) {
                    const size_t off = (size_t)(u.pm * BM + ai * HALF + wr * 64 + m * 16 + fr) * DM + col;
                    const u32x4 r = *(const u32x4*)(bh + off);
                    const f32x2v q0 = h2f2(r.x), q1 = h2f2(r.y), q2 = h2f2(r.z), q3 = h2f2(r.w);
                    const f32x4 x0 = (f32x4){q0[0], q0[1], q1[0], q1[1]}, x1 = (f32x4){q2[0], q2[1], q3[0], q3[1]};
                    const f32x4 y0 = x0 + g0 * acc[ai][bj][m][0], y1 = x1 + g1 * acc[ai][bj][m][1];
                    { u32x4 w; w.x = f2h2(y0[0], y0[1]); w.y = f2h2(y0[2], y0[3]); w.z = f2h2(y1[0], y1[1]); w.w = f2h2(y1[2], y1[3]); *(u32x4*)(xo + off) = w; }
                    if (NORM) {
                        sq[ai][m] += ((y0[0] * y0[0] + y0[1] * y0[1]) + (y0[2] * y0[2] + y0[3] * y0[3])) + ((y1[0] * y1[0] + y1[1] * y1[1]) + (y1[2] * y1[2] + y1[3] * y1[3]));
                        const f32x4 z0 = y0 * a0, z1 = y1 * a1;
                        u32x4 w; w.x = cvt_pk_bf16(z0[0], z0[1]); w.y = cvt_pk_bf16(z0[2], z0[3]); w.z = cvt_pk_bf16(z1[0], z1[1]); w.w = cvt_pk_bf16(z1[2], z1[3]);
                        { const int row = u.pm * BM + ai * HALF + wr * 64 + m * 16 + fr;
                          const int prow = (row & ~63) | (16 * (row & 3) + ((row >> 2) & 15));
                          *(u32x4*)(XA + (size_t)prow * DM + col) = w; }
                    }
                }
        }
        if (NORM) {
#pragma unroll
            for (int ai = 0; ai < 2; ++ai)
#pragma unroll
                for (int m = 0; m < 4; ++m) {
                    float s = sq[ai][m]; s += __shfl_xor(s, 16); s += __shfl_xor(s, 32);
                    if (fq == 0) atomicAdd(ssq + (u.pm * BM + ai * HALF + wr * 64 + m * 16 + fr), (unsigned long long)(s * 16777216.f));
                }
        }
    }
};
struct EpiUp {
    static constexpr bool PERM = true, AFTER_DRAIN = false;
    bf16_t* ACT; unsigned char* FIXP; unsigned char* FIXT2; const float* cw; const float* cb; const unsigned long long* ssq; const float* cup;
    __device__ __forceinline__ void operator()(const f32x4 (&acc)[2][2][4][2], const Unit& u, int wr, int wc, int fr, int fq) const {
        const int lane = fq * 16 + fr;
        const int srcp = (lane & 48) | ((fr - 1) & 15);
        const float* cp = cup + (size_t)((u.pm * BM) >> 13) * NUP + u.pn * BM + wc * 32 + 8 * fq;
        f32x4 rsv[2];
#pragma unroll
        for (int ai = 0; ai < 2; ++ai) { const u32x4* sp = (const u32x4*)(ssq + u.pm * BM + ai * HALF + wr * 64 + 4 * fr);
            const u32x4 q0 = sp[0], q1 = sp[1];
            const float s0 = (float)q0.y * 4294967296.f + (float)q0.x, s1 = (float)q0.w * 4294967296.f + (float)q0.z, s2 = (float)q1.y * 4294967296.f + (float)q1.x, s3 = (float)q1.w * 4294967296.f + (float)q1.z;
            rsv[ai][0] = __builtin_amdgcn_rsqf(s0 * (1.f / (16777216.f * DM)) + 1e-6f); rsv[ai][1] = __builtin_amdgcn_rsqf(s1 * (1.f / (16777216.f * DM)) + 1e-6f);
            rsv[ai][2] = __builtin_amdgcn_rsqf(s2 * (1.f / (16777216.f * DM)) + 1e-6f); rsv[ai][3] = __builtin_amdgcn_rsqf(s3 * (1.f / (16777216.f * DM)) + 1e-6f); }
        unsigned long long keep[2][4];
#pragma unroll
        for (int hh = 0; hh < 2; ++hh) {
            const int f0 = u.pn * HALF + wc * 32 + 8 * fq + 4 * hh;
            const f32x4 w0 = *(const f32x4*)(cw + f0), w1 = *(const f32x4*)(cw + DFF + f0), w2 = *(const f32x4*)(cw + 2 * DFF + f0), bb = *(const f32x4*)(cb + f0);
            const f32x4 cu = *(const f32x4*)(cp + 4 * hh), cg = *(const f32x4*)(cp + HALF + 4 * hh);
#pragma unroll
            for (int ai = 0; ai < 2; ++ai) {
                const int tok0 = u.pm * BM + ai * HALF + wr * 64, grp = tok0 >> 6;
                f32x4 g[4], uu[4], pv3, pv2;
#pragma unroll
                for (int m = 0; m < 4; ++m) { g[m] = acc[ai][1][m][hh] * rsv[ai][m] + cg; uu[m] = acc[ai][0][m][hh] * rsv[ai][m] + cu; }
#pragma unroll
                for (int e = 0; e < 4; ++e) { pv3[e] = __shfl(g[3][e], srcp); pv2[e] = __shfl(g[2][e], srcp); }
#pragma unroll
                for (int j = 0; j < 2; ++j) {
                    const bool isT = (fr == 15);
                    const f32x4 sa = isT ? g[j + 2] : uu[j], sb = g[j];
                    u32x4 w; w.x = cvt_pk_bf16(sa[0], sa[1]); w.y = cvt_pk_bf16(sa[2], sa[3]); w.z = cvt_pk_bf16(sb[0], sb[1]); w.w = cvt_pk_bf16(sb[2], sb[3]);
                    unsigned char* dst = (isT ? FIXT2 : FIXP) + (((size_t)grp * 2 + j) * DFF + f0) * 4;
                    if (fr == 0 || fr == 15) *(u32x4*)dst = w;
                }
#pragma unroll
                for (int m = 0; m < 4; ++m) {
                    const f32x4 gm1 = (m == 0) ? pv3 : g[(m + 3) & 3], gm2 = (m == 0) ? pv2 : (m == 1) ? pv3 : g[(m + 2) & 3];
                    f32x4 av;
#pragma unroll
                    for (int e = 0; e < 4; ++e) {
                        const float y = bb[e] + w0[e] * gm2[e] + w1[e] * gm1[e] + w2[e] * g[m][e];
                        av[e] = y * __builtin_amdgcn_rcpf(1.f + __expf(-y)) * uu[m][e];
                    }
                    const int row = tok0 + 4 * fr + m;
                    const bool fixrow = (fr == 0) && (m < 2);
                    const unsigned long long pk = (unsigned long long)cvt_pk_bf16(av[0], av[1]) | ((unsigned long long)cvt_pk_bf16(av[2], av[3]) << 32);
                    if (hh == 0) keep[ai][m] = pk;
                    else if (!fixrow) { u32x4 w; w.x = (unsigned)keep[ai][m]; w.y = (unsigned)(keep[ai][m] >> 32); w.z = (unsigned)pk; w.w = (unsigned)(pk >> 32); __builtin_nontemporal_store(w, (u32x4*)(ACT + (size_t)row * DFF + f0 - 4)); }
                }
            }
        }
    }
};
}

template <int MAPK> __device__ __forceinline__ int colmap(int n) {
    if (MAPK == 1) {
        const int slot = n >> 6, c = n & 63;
        if (slot < 8) { const int m = c >> 5, cc = c & 31; return slot * 64 + m * 32 + ((cc & 1) ? (cc >> 1) + 16 : (cc >> 1)); }
        if (slot >= 12 && slot < 24) return slot * 64 + ((c & 1) ? (c >> 1) + 32 : (c >> 1));
        return n;
    }
    if (MAPK == 2) { const int pn = n >> 8, r = n & 255; return (r < 128) ? 128 * pn + r : DFF + 128 * pn + (r - 128); }
    return n;
}
template <int MAPK> __device__ __forceinline__ void transpose_item(const float* W, int K, int N, int ldw, bf16_t* WT, float* scr, int item, int lane) {
    const int nblk = N / 32, kb = item / nblk, nb = item % nblk, k0 = 64 * kb, n0 = 32 * nb;
    const int sc = colmap<MAPK>(n0 + (lane & 31));
    float tv[32];
#pragma unroll
    for (int i = 0; i < 32; ++i) tv[i] = W[(size_t)(k0 + 2 * i + (lane >> 5)) * ldw + sc];
#pragma unroll
    for (int i = 0; i < 32; ++i) scr[(2 * i + (lane >> 5)) * 33 + (lane & 31)] = tv[i];
    LDS_FENCE();
    const int c = lane & 7;
#pragma unroll
    for (int j = 0; j < 4; ++j) { const int n = (lane >> 3) + 8 * j; const float* s = scr + (8 * c) * 33 + n;
        u32x4 o; o.x = pk2(s[0 * 33], s[1 * 33]); o.y = pk2(s[2 * 33], s[3 * 33]); o.z = pk2(s[4 * 33], s[5 * 33]); o.w = pk2(s[6 * 33], s[7 * 33]);
        *(u32x4*)(WT + (size_t)(n0 + n) * K + k0 + 8 * c) = o; }
    LDS_FENCE();
}

__device__ __forceinline__ void prologue(const Args& a, unsigned char* lds, int tid, int G) {
    unsigned char* ws = a.ws;
    const int lane = tid & 63, wave = tid >> 6;
    const float* c_in = a.in[1]; const float* w_mod = a.in[2]; const float* b_mod = a.in[3];
    {
        float* sc = (float*)lds;
        float* red = (float*)(lds + 32768);
        for (int i = tid; i < NB * DM; i += 512) { const float v = c_in[i]; sc[i] = v / (1.f + __expf(-v)); }
        __syncthreads();
        float* MOD = (float*)(ws + WS_MOD);
        for (int item = blockIdx.x; item < DEPTH * (NMOD / 32); item += G) {
            const int l = item / (NMOD / 32), jb = item % (NMOD / 32), kg = tid >> 5, col = tid & 31;
            const float* wp = w_mod + ((size_t)l * DM + kg * 64) * NMOD + jb * 32 + col;
            float acc[8];
#pragma unroll
            for (int b = 0; b < 8; ++b) acc[b] = 0.f;
#pragma unroll 16
            for (int k = 0; k < 64; ++k) { const float w = wp[(size_t)k * NMOD];
#pragma unroll
                for (int b = 0; b < 8; ++b) acc[b] += sc[b * DM + kg * 64 + k] * w; }
#pragma unroll
            for (int b = 0; b < 8; ++b) red[(kg * 8 + b) * 32 + col] = acc[b];
            __syncthreads();
            if (tid < 256) { const int b = tid >> 5; float s = b_mod[(size_t)l * NMOD + jb * 32 + col];
#pragma unroll
              for (int g = 0; g < 16; ++g) s += red[(g * 8 + b) * 32 + col];
              MOD[((size_t)l * NB + b) * NMOD + jb * 32 + col] = s; }
            __syncthreads();
        }
    }
    __syncthreads();
    {
        const int gt = blockIdx.x * 512 + tid, NT_ = G * 512;
        float* RA = (float*)(ws + WS_ROPEA); float* RB = (float*)(ws + WS_ROPEB);
        for (int i = gt; i < T * 48; i += NT_) {
            const int t = i / 48, j = i % 48; const bool isA = j < 16; const int fi = isA ? j : j - 16; const float dim = isA ? 32.f : 64.f;
            const float e = (float)(2 * fi) / dim;
            const float pw = (float)exp2((double)e * 13.287712379549449);
            const float inv = 1.0f / pw;
            const float ang = (float)t * inv;
            const double x = (double)ang, k = rint(x * 0.15915494309189535);
            double r = fma(-k, 6.283185307179586, x); r = fma(-k, 2.4492935982947064e-16, r);
            const float rf = (float)r;
            const float cs = cosf(rf), sn = sinf(rf);
            float* dst = isA ? RA + ((size_t)t * 16 + fi) * 2 : RB + ((size_t)t * 32 + fi) * 2;
            dst[0] = cs; dst[1] = sn;
        }
        float* WFZ = (float*)(ws + WS_WFZ); const float* w_in = a.in[5];
        for (int i = gt; i < DEPTH * 6 * DM; i += NT_) { const int l = i / (6 * DM), r = i % (6 * DM), j = r / DM, k = r % DM; WFZ[i] = w_in[((size_t)l * DM + k) * INC + NIN + j]; }
    }
    {
        float* scr = (float*)(lds + wave * 16384);
        const int gw = blockIdx.x * 8 + wave, NGW = G * 8;
        constexpr int I_IN = (DM / 64) * (NIN / 32), I_OUT = (DM / 64) * (DM / 32), I_UP = (DM / 64) * (NUP / 32), I_DN = (DFF / 64) * (DM / 32), I_L = I_IN + I_OUT + I_UP + I_DN;
        for (int it = gw; it < DEPTH * I_L; it += NGW) {
            const int l = it / I_L; int r = it % I_L;
            bf16_t* WT = (bf16_t*)(ws + WS_WT) + (size_t)l * WL_ELEMS;
            if (r < I_IN) { transpose_item<1>(a.in[5] + (size_t)l * DM * INC, DM, NIN, INC, WT + WL_IN, scr, r, lane); continue; } r -= I_IN;
            if (r < I_OUT) { transpose_item<0>(a.in[9] + (size_t)l * DM * DM, DM, DM, DM, WT + WL_OUT, scr, r, lane); continue; } r -= I_OUT;
            if (r < I_UP) { transpose_item<2>(a.in[11] + (size_t)l * DM * NUP, DM, NUP, NUP, WT + WL_UP, scr, r, lane); continue; } r -= I_UP;
            transpose_item<0>(a.in[14] + (size_t)l * DFF * DM, DFF, DM, DM, WT + WL_DN, scr, r, lane);
        }
    }
}

template <bool FZ> __device__ __forceinline__ void norm_phase(const float* x, const bf16_t* xh, bf16_t* xcopy, bf16_t* H, const float* gw_, const float* modl, int shift_off, int scale_off,
                                                              const float* wfz, const float* fbias, float* LOGF, int tid, int G) {
    const int lane = tid & 63, wave = tid >> 6, gw = blockIdx.x * 8 + wave, NGW = G * 8;
    const int rpw = (MROWS + NGW - 1) / NGW;
    int r0 = gw * rpw, r1 = r0 + rpw; if (r1 > MROWS) r1 = MROWS;
    f32x4 A[4], B[4]; f32x4 wz[FZ ? 6 : 1][4]; float fb[6];
    if (FZ) {
#pragma unroll
        for (int j = 0; j < 6; ++j) { fb[j] = fbias[j];
#pragma unroll
            for (int q = 0; q < 4; ++q) wz[j][q] = *(const f32x4*)(wfz + j * DM + 4 * lane + 256 * q); }
    }
    int curb = -1;
    for (int r = r0; r < r1; ++r) {
        const int b = r >> 13;
        if (b != curb) { curb = b;
#pragma unroll
            for (int q = 0; q < 4; ++q) { const int c = 4 * lane + 256 * q; const f32x4 g4 = *(const f32x4*)(gw_ + c), s4 = *(const f32x4*)(modl + (size_t)b * NMOD + scale_off + c);
                A[q] = g4 * (s4 + 1.0f); B[q] = *(const f32x4*)(modl + (size_t)b * NMOD + shift_off + c); } }
        f32x4 v[4]; float s = 0.f;
        if (x) { const f32x4* xr = (const f32x4*)(x + (size_t)r * DM) + lane;
            unsigned long long* c8 = (unsigned long long*)(xcopy + (size_t)r * DM) + lane;
#pragma unroll
            for (int q = 0; q < 4; ++q) { v[q] = xr[64 * q]; c8[64 * q] = (unsigned long long)f2h2(v[q][0], v[q][1]) | ((unsigned long long)f2h2(v[q][2], v[q][3]) << 32); } }
        else { const unsigned long long* xr = (const unsigned long long*)(xh + (size_t)r * DM) + lane;
#pragma unroll
            for (int q = 0; q < 4; ++q) { const unsigned long long w = xr[64 * q]; const f32x2v a2 = h2f2((unsigned)w), b2 = h2f2((unsigned)(w >> 32));
                v[q] = (f32x4){a2[0], a2[1], b2[0], b2[1]}; } }
#pragma unroll
        for (int q = 0; q < 4; ++q) s += (v[q][0] * v[q][0] + v[q][1] * v[q][1]) + (v[q][2] * v[q][2] + v[q][3] * v[q][3]);
        const float rs = 1.0f / sqrtf(wave_sum(s) * (1.f / DM) + 1e-6f);
#pragma unroll
        for (int q = 0; q < 4; ++q) v[q] = v[q] * rs * A[q] + B[q];
        unsigned long long* o8 = (unsigned long long*)(H + (size_t)r * DM) + lane;
#pragma unroll
        for (int q = 0; q < 4; ++q) o8[64 * q] = (unsigned long long)pk2(v[q][0], v[q][1]) | ((unsigned long long)pk2(v[q][2], v[q][3]) << 32);
        if (FZ) {
            float z = 0.f;
#pragma unroll
            for (int j = 0; j < 6; ++j) { float d = 0.f;
#pragma unroll
                for (int q = 0; q < 4; ++q) d += (v[q][0] * wz[j][q][0] + v[q][1] * wz[j][q][1]) + (v[q][2] * wz[j][q][2] + v[q][3] * wz[j][q][3]);
                d = wave_sum(d) + fb[j]; if (lane == j) z = d; }
            if (lane < 6) { const float lf = fminf(z, 0.f) - log1pf(__expf(-fabsf(z))); LOGF[((size_t)b * 6 + lane) * T + (r & (T - 1))] = lf; }
        }
    }
}
__device__ __forceinline__ void final_norm(const bf16_t* xh, float* out, const float* g, int tid, int G) {
    const int lane = tid & 63, wave = tid >> 6, gw = blockIdx.x * 8 + wave, NGW = G * 8;
    f32x4 A[4];
#pragma unroll
    for (int q = 0; q < 4; ++q) A[q] = *(const f32x4*)(g + 4 * lane + 256 * q);
    for (int r = gw; r < MROWS; r += NGW) {
        const unsigned long long* xr = (const unsigned long long*)(xh + (size_t)r * DM) + lane;
        f32x4 v[4]; float s = 0.f;
#pragma unroll
        for (int q = 0; q < 4; ++q) { const unsigned long long w = xr[64 * q]; const f32x2v a2 = h2f2((unsigned)w), b2 = h2f2((unsigned)(w >> 32));
            v[q] = (f32x4){a2[0], a2[1], b2[0], b2[1]};
            s += (v[q][0] * v[q][0] + v[q][1] * v[q][1]) + (v[q][2] * v[q][2] + v[q][3] * v[q][3]); }
        const float rs = 1.0f / sqrtf(wave_sum(s) * (1.f / DM) + 1e-6f);
        f32x4* orow = (f32x4*)(out + (size_t)r * DM) + lane;
#pragma unroll
        for (int q = 0; q < 4; ++q) orow[64 * q] = v[q] * rs * A[q];
    }
}

__device__ __forceinline__ void cvec_phase(unsigned char* ws, int tid, int G) {
    const int lane = tid & 63, wave = tid >> 6, gw = blockIdx.x * 8 + wave, NGW = G * 8;
    const float* MOD = (const float*)(ws + WS_MOD); float* CUP = (float*)(ws + WS_CUP);
    for (int l = 0; l < DEPTH; ++l) {
        const bf16_t* WT = (const bf16_t*)(ws + WS_WT) + (size_t)l * WL_ELEMS + WL_UP;
        for (int n = gw; n < NUP; n += NGW) {
            const u32x4 w0 = *(const u32x4*)(WT + (size_t)n * DM + lane * 16), w1 = *(const u32x4*)(WT + (size_t)n * DM + lane * 16 + 8);
            float wv[16];
#pragma unroll
            for (int q = 0; q < 4; ++q) { wv[2 * q] = bf2f((unsigned short)(w0[q] & 0xffffu)); wv[2 * q + 1] = bf2f((unsigned short)(w0[q] >> 16)); wv[8 + 2 * q] = bf2f((unsigned short)(w1[q] & 0xffffu)); wv[8 + 2 * q + 1] = bf2f((unsigned short)(w1[q] >> 16)); }
            float mine = 0.f;
#pragma unroll
            for (int b = 0; b < NB; ++b) {
                const float* sp = MOD + ((size_t)l * NB + b) * NMOD + 3 * DM + lane * 16;
                float d = 0.f;
#pragma unroll
                for (int q = 0; q < 4; ++q) { const f32x4 s4 = *(const f32x4*)(sp + 4 * q); d += (s4[0] * wv[4 * q] + s4[1] * wv[4 * q + 1]) + (s4[2] * wv[4 * q + 2] + s4[3] * wv[4 * q + 3]); }
                d = wave_sum(d); if (lane == b) mine = d;
            }
            if (lane < NB) CUP[((size_t)l * NB + lane) * NUP + n] = mine;
        }
    }
}
__device__ __forceinline__ void scan_phase(float* LOGF, unsigned char* lds, int tid, int G) {
    float* wt = (float*)lds;
    for (int seq = blockIdx.x; seq < NB * 6; seq += G) {
        f32x4* p = (f32x4*)(LOGF + (size_t)seq * T) + tid * 4;
        f32x4 v[4]; float run = 0.f;
#pragma unroll
        for (int q = 0; q < 4; ++q) { v[q] = p[q];
#pragma unroll
            for (int i = 0; i < 4; ++i) { run += v[q][i]; v[q][i] = run; } }
        float inc = run;
        const int lane = tid & 63, wave = tid >> 6;
#pragma unroll
        for (int o = 1; o < 64; o <<= 1) { const float n = __shfl_up(inc, o); if (lane >= o) inc += n; }
        if (lane == 63) wt[wave] = inc;
        __syncthreads();
        float off = inc - run;
        for (int w = 0; w < wave; ++w) off += wt[w];
#pragma unroll
        for (int q = 0; q < 4; ++q) p[q] = (v[q] + off) * LOG2E;
        __syncthreads();
    }
}

__device__ __forceinline__ int crow(int r, int hi) { return (r & 3) + 8 * (r >> 2) + 4 * hi; }
typedef float f32x2_t __attribute__((ext_vector_type(2))); typedef __bf16 bf16x2_t __attribute__((ext_vector_type(2)));
__device__ __forceinline__ unsigned cvtpk(float lo, float hi) { f32x2_t v = {lo, hi}; bf16x2_t b = __builtin_convertvector(v, bf16x2_t); return __builtin_bit_cast(unsigned, b); }
__device__ __forceinline__ float max3f(float a, float b, float c) { float r; asm("v_max3_f32 %0, %1, %2, %3" : "=v"(r) : "v"(a), "v"(b), "v"(c)); return r; }
__device__ __forceinline__ float half_max(float m) { auto rr = __builtin_amdgcn_permlane32_swap(__float_as_uint(m), __float_as_uint(m), false, false); return fmaxf(__uint_as_float(rr[0]), __uint_as_float(rr[1])); }

template <int DK, int MODE>
__device__ __forceinline__ void attn_qk(const unsigned char* B, const unsigned char* qslot, int r32, int hi, int kfs, const bf16x8& qones, const f32x16& negm, f32x16& s0, f32x16& s1) {
    constexpr int ROWB = DK * 2, ND = DK / 16;
    bf16x8 kb0, kb1;
    if (MODE == 1) { kb0 = *(const bf16x8*)(B + AT_BIAS + r32 * 16); kb1 = *(const bf16x8*)(B + AT_BIAS + (32 + r32) * 16); }
#pragma unroll
    for (int h2 = 0; h2 < ND; h2 += 2) {
        bf16x8 kf[2][2], qf[2];
#pragma unroll
        for (int e = 0; e < 2; ++e) {
            const int d0 = h2 + e, ch = ((2 * d0 + hi) ^ kfs) << 4;
            kf[e][0] = *(const bf16x8*)(B + AT_K + r32 * ROWB + ch); kf[e][1] = *(const bf16x8*)(B + AT_K + (32 + r32) * ROWB + ch);
            qf[e] = *(const bf16x8*)(qslot + d0 * 1024);
        }
        __builtin_amdgcn_sched_barrier(0);
#pragma unroll
        for (int e = 0; e < 2; ++e) {
            if (h2 + e == 0) { s0 = __builtin_amdgcn_mfma_f32_32x32x16_bf16(kf[e][0], qf[e], negm, 0, 0, 0); s1 = __builtin_amdgcn_mfma_f32_32x32x16_bf16(kf[e][1], qf[e], negm, 0, 0, 0); }
            else { s0 = __builtin_amdgcn_mfma_f32_32x32x16_bf16(kf[e][0], qf[e], s0, 0, 0, 0); s1 = __builtin_amdgcn_mfma_f32_32x32x16_bf16(kf[e][1], qf[e], s1, 0, 0, 0); }
        }
    }
    if (MODE == 1) { s0 = __builtin_amdgcn_mfma_f32_32x32x16_bf16(kb0, qones, s0, 0, 0, 0); s1 = __builtin_amdgcn_mfma_f32_32x32x16_bf16(kb1, qones, s1, 0, 0, 0); }
}
template <int MODE>
__device__ __forceinline__ void attn_pv(bool fixn, const unsigned char* B, int key0, int qw, int qi, int r32, int hi, int vad0, int vad1, const bf16x8& ones, float* wsf,
                                        f32x16& p0, f32x16& p1, f32x16& n0, f32x16& n1, float& mref, f32x16& negm, f32x16& ol, f32x16& oa, f32x16& ob) {
    v4i16_t vl0[4], vh0[4], vl1[4], vh1[4];
#pragma unroll
    for (int j = 0; j < 2; ++j) {
        vl0[j] = __builtin_amdgcn_ds_read_tr16_b64_v4i16((LAS v4i16_t*)(B + vad0 + j * 2048)); vh0[j] = __builtin_amdgcn_ds_read_tr16_b64_v4i16((LAS v4i16_t*)(B + vad0 + j * 2048 + 1024));
        vl1[j] = __builtin_amdgcn_ds_read_tr16_b64_v4i16((LAS v4i16_t*)(B + vad1 + j * 2048)); vh1[j] = __builtin_amdgcn_ds_read_tr16_b64_v4i16((LAS v4i16_t*)(B + vad1 + j * 2048 + 1024));
    }
    if (MODE == 2) {
#pragma unroll
        for (int r = 0; r < 16; ++r) { const int dlt = qi - (key0 + crow(r, hi)); if (dlt < 0 || dlt > 128) p0[r] = -INFINITY; if (dlt - 32 < 0 || dlt - 32 > 128) p1[r] = -INFINITY; }
    } else if (key0 + 63 > qw) {
        asm volatile("" ::: "memory");
        const int lim = qi - key0 - 4 * hi;
#pragma unroll
        for (int r = 0; r < 16; ++r) { const int cr = (r & 3) + 8 * (r >> 2); if (cr > lim) p0[r] = -INFINITY; if (cr + 32 > lim) p1[r] = -INFINITY; }
    }
#define MX3(a, b, c) __builtin_fmaxf(__builtin_fmaxf((a), (b)), (c))
    float ra = MX3(p0[0], p0[1], p1[0]), rb = MX3(p0[2], p0[3], p1[1]); ra = MX3(ra, p1[2], p1[3]);
#pragma unroll
    for (int r = 4; r < 16; r += 4) { ra = MX3(ra, p0[r], p0[r + 1]); rb = MX3(rb, p0[r + 2], p0[r + 3]); ra = MX3(ra, p1[r], p1[r + 1]); rb = MX3(rb, p1[r + 2], p1[r + 3]); }
#undef MX3
    const float rm = half_max(__builtin_fmaxf(ra, rb));
    if (__any(rm > 8.f)) {
        const float dl = fmaxf(rm, 0.f); mref += dl;
#pragma unroll
        for (int r = 0; r < 16; ++r) { p0[r] -= dl; p1[r] -= dl; negm[r] = -mref; }
        if (fixn) {
#pragma unroll
            for (int r = 0; r < 16; ++r) { n0[r] -= dl; n1[r] -= dl; } }
        const float f = __builtin_amdgcn_exp2f(-dl);
        if (hi == 0) wsf[r32] = f;
        LDS_FENCE();
#pragma unroll
        for (int g = 0; g < 4; ++g) { const f32x4 fv = *(const f32x4*)(wsf + 8 * g + 4 * hi);
#pragma unroll
            for (int i = 0; i < 4; ++i) { oa[4 * g + i] *= fv[i]; ob[4 * g + i] *= fv[i]; ol[4 * g + i] *= fv[i]; } }
        LDS_FENCE();
    }
#pragma unroll
    for (int r = 0; r < 16; ++r) { p0[r] = __builtin_amdgcn_exp2f(p0[r]); p1[r] = __builtin_amdgcn_exp2f(p1[r]); }
#pragma unroll
    for (int j = 0; j < 4; ++j) {
        u32x4 pw;
        if (j < 2) { const int bs = 8 * (j & 1); pw = (u32x4){cvtpk(p0[bs], p0[bs + 1]), cvtpk(p0[bs + 2], p0[bs + 3]), cvtpk(p0[bs + 4], p0[bs + 5]), cvtpk(p0[bs + 6], p0[bs + 7])}; }
        else { const int bs = 8 * (j & 1); pw = (u32x4){cvtpk(p1[bs], p1[bs + 1]), cvtpk(p1[bs + 2], p1[bs + 3]), cvtpk(p1[bs + 4], p1[bs + 5]), cvtpk(p1[bs + 6], p1[bs + 7])}; }
        const bf16x8 pa = __builtin_bit_cast(bf16x8, pw);
        if (j < 2) {
            vl0[j + 2] = __builtin_amdgcn_ds_read_tr16_b64_v4i16((LAS v4i16_t*)(B + vad0 + (j + 2) * 2048)); vh0[j + 2] = __builtin_amdgcn_ds_read_tr16_b64_v4i16((LAS v4i16_t*)(B + vad0 + (j + 2) * 2048 + 1024));
            vl1[j + 2] = __builtin_amdgcn_ds_read_tr16_b64_v4i16((LAS v4i16_t*)(B + vad1 + (j + 2) * 2048)); vh1[j + 2] = __builtin_amdgcn_ds_read_tr16_b64_v4i16((LAS v4i16_t*)(B + vad1 + (j + 2) * 2048 + 1024));
        }
        { const bf16x8 vf = (bf16x8){vl0[j][0], vl0[j][1], vl0[j][2], vl0[j][3], vh0[j][0], vh0[j][1], vh0[j][2], vh0[j][3]};
          oa = __builtin_amdgcn_mfma_f32_32x32x16_bf16(pa, vf, oa, 0, 0, 0); }
        { const bf16x8 vf = (bf16x8){vl1[j][0], vl1[j][1], vl1[j][2], vl1[j][3], vh1[j][0], vh1[j][1], vh1[j][2], vh1[j][3]};
          ob = __builtin_amdgcn_mfma_f32_32x32x16_bf16(pa, vf, ob, 0, 0, 0); }
        ol = __builtin_amdgcn_mfma_f32_32x32x16_bf16(pa, ones, ol, 0, 0, 0);
    }
}

template <int DK, int MODE>
__device__ __forceinline__ void attn_core(unsigned char* lds, int tid_in, const bf16_t* Qg, long qrs, const bf16_t* Kg, long krs, const bf16_t* Vg, long vrs,
                                          const float* Fg, float fref, int q0, int kt_lo, int kt_hi, int korg,
                                          float& mref_out, f32x16& ol_out, f32x16& o0, f32x16& o1) {
    constexpr int ROWB = DK * 2, ND = DK / 16;
    int tid = tid_in; asm volatile("" : "+v"(tid));
    const int lane = tid & 63, wid = __builtin_amdgcn_readfirstlane(tid >> 6), r32 = lane & 31, hi = lane >> 5;
    const int qw = q0 + 32 * wid, qi = qw + r32;
    unsigned char* qslot = lds + AT_Q + wid * 4096 + lane * 16;
#pragma unroll
    for (int d0 = 0; d0 < ND; ++d0) *(bf16x8*)(qslot + d0 * 1024) = *(const bf16x8*)(Qg + (long)qi * qrs + d0 * 16 + hi * 8);
    f32x16 oa, ob, ol, negm, sa0, sa1, sb0, sb1;
#pragma unroll
    for (int r = 0; r < 16; ++r) { oa[r] = 0.f; ob[r] = 0.f; ol[r] = 0.f; negm[r] = 0.f; sa0[r] = 0.f; sa1[r] = 0.f; sb0[r] = 0.f; sb1[r] = 0.f; }
    float mref = 0.f;
    float* wsf = (float*)(lds + AT_WS + wid * 256);
    const bf16x8 ones = (bf16x8){0x3F80, 0x3F80, 0x3F80, 0x3F80, 0x3F80, 0x3F80, 0x3F80, 0x3F80};
    const bf16x8 qones = hi ? (bf16x8){0, 0, 0, 0, 0, 0, 0, 0} : (bf16x8){0x3F80, 0x3F80, 0x3F80, 0, 0, 0, 0, 0};
    const int krow = (DK == 64) ? (tid >> 3) : ((tid & 255) >> 2), kch = (DK == 64) ? (tid & 7) : (tid & 3);
    const int kswz = (DK == 64) ? ((krow >> 1) & 7) : ((krow >> 2) & 3);
    const bool kact = (DK == 64) || (tid < 256);
    const int vrow = tid >> 3, vch = tid & 7, vswz = (vrow & 2) << 1;
    const int koff = AT_K + krow * ROWB + ((kch ^ kswz) << 4), voff = AT_V + vrow * 128 + ((vch ^ vswz) << 4);
    const bf16_t* kptr = Kg + (long)(korg + 64 * kt_lo + krow) * krs + kch * 8; const bf16_t* vptr = Vg + (long)(korg + 64 * kt_lo + vrow) * vrs + vch * 8; const float* fptr = Fg + korg + 64 * kt_lo + (tid & 63);
    const int NT = kt_hi - kt_lo;
    u32x4 kreg0 = (u32x4){0u, 0u, 0u, 0u}, vreg0 = kreg0, kreg1 = kreg0, vreg1 = kreg0; float breg0 = 0.f, breg1 = 0.f;
#define AT_LOADK(S, i) do { if (kact) kreg##S = *(const u32x4*)(kptr + (long)(64 * (i)) * krs); if (MODE == 1 && tid < 64) breg##S = fref - fptr[64 * (i)]; } while (0)
#define AT_LOADV(S, i) do { vreg##S = *(const u32x4*)(vptr + (long)(64 * (i)) * vrs); } while (0)
#define AT_STOREK(S, buf) do { unsigned char* B_ = lds + (buf) * AT_BUF; if (kact) *(u32x4*)(B_ + koff) = kreg##S; \
        if (MODE == 1 && tid < 64) { const unsigned bh_ = f2bf(breg##S); const float r1_ = breg##S - __builtin_bit_cast(float, bh_ << 16); const unsigned bm_ = f2bf(r1_); \
            const float r2_ = r1_ - __builtin_bit_cast(float, bm_ << 16); const unsigned bl_ = f2bf(r2_); \
            *(u32x4*)(B_ + AT_BIAS + tid * 16) = (u32x4){bh_ | (bm_ << 16), bl_, 0u, 0u}; } } while (0)
#define AT_STOREV(S, buf) do { *(u32x4*)(lds + (buf) * AT_BUF + voff) = vreg##S; } while (0)
    const int kfs = (DK == 64) ? ((r32 >> 1) & 7) : ((r32 >> 2) & 3);
    const int q4 = (lane & 15) >> 2, p4 = lane & 3, dh = (lane >> 4) & 1;
    const int vs = (q4 & 2) >> 1;
    const int vbase = AT_V + (4 * hi + q4) * 128 + (p4 & 1) * 8;
    const int vc = 2 * dh + (p4 >> 1);
    const int vad0 = vbase + ((((0 ^ vs) << 2) | vc) << 4), vad1 = vbase + ((((1 ^ vs) << 2) | vc) << 4);
    const int kbase0 = 64 * kt_lo + korg;
#define AT_ACTIVE(i) ((MODE == 2) ? !((kbase0 + 64 * (i)) > qw + 31 || (kbase0 + 64 * (i)) + 63 < qw - 128) : !((kbase0 + 64 * (i)) > qw + 31))

    AT_LOADK(0, 0); AT_LOADV(0, 0); if (NT > 1) AT_LOADK(1, 1);
    AT_STOREK(0, 0); AT_STOREV(0, 0); if (NT > 1) AT_STOREK(1, 1);
    if (NT > 2) AT_LOADK(0, 2); if (NT > 3) AT_LOADK(1, 3); if (NT > 1) AT_LOADV(0, 1); if (NT > 2) AT_LOADV(1, 2);
    __syncthreads();
    if (AT_ACTIVE(0)) attn_qk<DK, MODE>(lds, qslot, r32, hi, kfs, qones, negm, sa0, sa1);
    __syncthreads();
#define AT_ITER(i, PAR, C0, C1, N0, N1) do { \
          \
        if ((i) + 2 < NT) AT_STOREK(PAR, PAR); \
        if ((i) + 1 < NT) AT_STOREV(PAR, 1 - (PAR)); \
        if ((i) + 4 < NT) AT_LOADK(PAR, (i) + 4); \
        if ((i) + 3 < NT) AT_LOADV(PAR, (i) + 3); \
        const bool an_ = ((i) + 1 < NT) && AT_ACTIVE((i) + 1); \
        if (an_) attn_qk<DK, MODE>(lds + (1 - (PAR)) * AT_BUF, qslot, r32, hi, kfs, qones, negm, N0, N1); \
        if (AT_ACTIVE(i)) attn_pv<MODE>(true, lds + (PAR) * AT_BUF, kbase0 + 64 * (i), qw, qi, r32, hi, vad0, vad1, ones, wsf, C0, C1, N0, N1, mref, negm, ol, oa, ob); \
        __syncthreads(); } while (0)
    for (int i = 0; i < NT; i += 2) {
        AT_ITER(i, 0, sa0, sa1, sb0, sb1);
        if (i + 1 >= NT) break;
        AT_ITER(i + 1, 1, sb0, sb1, sa0, sa1);
    }
#undef AT_ITER
#undef AT_LOADK
#undef AT_LOADV
#undef AT_STOREK
#undef AT_STOREV
#undef AT_ACTIVE
    mref_out = mref; ol_out = ol; o0 = oa; o1 = ob;
}


constexpr int ATB_WS = 6 * AT_BUF, ATB_Q = ATB_WS + 2048;
static_assert(ATB_Q + 32768 <= LDS_BYTES - 4096, "B-unit LDS map");
__device__ __forceinline__ void attn_core_band(unsigned char* lds, int tid_in, const bf16_t* Qg, const bf16_t* Kg, const bf16_t* Vg, long rs, int q0, int kt_lo, int korg,
                                               float& mref_out, f32x16& ol_out, f32x16& o0, f32x16& o1) {
    int tid = tid_in; asm volatile("" : "+v"(tid));
    const int lane = tid & 63, wid = __builtin_amdgcn_readfirstlane(tid >> 6), r32 = lane & 31, hi = lane >> 5;
    const int qw = q0 + 32 * wid, qi = qw + r32;
    unsigned char* qslot = lds + ATB_Q + wid * 4096 + lane * 16;
#pragma unroll
    for (int d0 = 0; d0 < 4; ++d0) *(bf16x8*)(qslot + d0 * 1024) = *(const bf16x8*)(Qg + (long)qi * rs + d0 * 16 + hi * 8);
    const int krow = tid >> 3, kch = tid & 7, kswz = (krow >> 1) & 7, vswz = (krow & 2) << 1;
    const int koff = AT_K + krow * 128 + ((kch ^ kswz) << 4), voff = AT_V + krow * 128 + ((kch ^ vswz) << 4);
    const int NT = 6 - kt_lo;
    const bf16_t* kptr = Kg + (long)(korg + 64 * kt_lo + krow) * rs + kch * 8; const bf16_t* vptr = Vg + (long)(korg + 64 * kt_lo + krow) * rs + kch * 8;
    u32x4 kr[6], vr[6];
#pragma unroll
    for (int i = 0; i < 6; ++i) if (i < NT) { kr[i] = *(const u32x4*)(kptr + (long)(64 * i) * rs); vr[i] = *(const u32x4*)(vptr + (long)(64 * i) * rs); }
#pragma unroll
    for (int i = 0; i < 6; ++i) if (i < NT) { *(u32x4*)(lds + i * AT_BUF + koff) = kr[i]; *(u32x4*)(lds + i * AT_BUF + voff) = vr[i]; }
    f32x16 oa, ob, ol, negm, s0, s1;
#pragma unroll
    for (int r = 0; r < 16; ++r) { oa[r] = 0.f; ob[r] = 0.f; ol[r] = 0.f; negm[r] = 0.f; s0[r] = 0.f; s1[r] = 0.f; }
    float mref = 0.f;
    float* wsf = (float*)(lds + ATB_WS + wid * 256);
    const bf16x8 ones = (bf16x8){0x3F80, 0x3F80, 0x3F80, 0x3F80, 0x3F80, 0x3F80, 0x3F80, 0x3F80};
    const bf16x8 qones = (bf16x8){0, 0, 0, 0, 0, 0, 0, 0};
    const int kfs = (r32 >> 1) & 7;
    const int q4 = (lane & 15) >> 2, p4 = lane & 3, dh = (lane >> 4) & 1, vs = (q4 & 2) >> 1;
    const int vbase = AT_V + (4 * hi + q4) * 128 + (p4 & 1) * 8, vc = 2 * dh + (p4 >> 1);
    const int vad0 = vbase + ((((0 ^ vs) << 2) | vc) << 4), vad1 = vbase + ((((1 ^ vs) << 2) | vc) << 4);
    const int kbase0 = 64 * kt_lo + korg;
    __syncthreads();
    for (int i = 0; i < NT; ++i) {
        const int key0 = kbase0 + 64 * i;
        if (!(key0 > qw + 31 || key0 + 63 < qw - 128)) {
            attn_qk<64, 2>(lds + i * AT_BUF, qslot, r32, hi, kfs, qones, negm, s0, s1);
            attn_pv<2>(false, lds + i * AT_BUF, key0, qw, qi, r32, hi, vad0, vad1, ones, wsf, s0, s1, s0, s1, mref, negm, ol, oa, ob);
        }
    }
    mref_out = mref; ol_out = ol; o0 = oa; o1 = ob;
}

__device__ __forceinline__ void row_bcast(float* wsf, float val, int r32, int hi, float (&out)[16]) {
    LDS_FENCE();
    if (hi == 0) wsf[r32] = val;
    LDS_FENCE();
#pragma unroll
    for (int g = 0; g < 4; ++g) { const f32x4 fv = *(const f32x4*)(wsf + 8 * g + 4 * hi);
#pragma unroll
        for (int i = 0; i < 4; ++i) out[4 * g + i] = fv[i]; }
    LDS_FENCE();
}

#ifndef PROBE_MASK
#define PROBE_MASK 0
#endif
#define TIC(id) unsigned long long t0_##id = 0; if ((PROBE_MASK >> (id)) & 1) t0_##id = __builtin_amdgcn_s_memrealtime()
#define TOC(id) if ((PROBE_MASK >> (id)) & 1) tacc += __builtin_amdgcn_s_memrealtime() - t0_##id
#define STG_BASE(stg) bf16_t* sp_; { int l_ = lane; asm volatile("" : "+v"(l_)); sp_ = (stg) + (l_ >> 5) * 256 + (l_ & 31); }
#define STG_PUT(r, a, b) do { const int o_ = (((r) & 3) + 8 * ((r) >> 2)) * 64; sp_[o_] = (bf16_t)f2bf(a); sp_[o_ + 32] = (bf16_t)f2bf(b); } while (0)
__device__ __forceinline__ void stage_flush(const bf16_t* stg, int lane_in, bf16_t* gbase, long grs) {
    int lane = lane_in; asm volatile("" : "+v"(lane));
    LDS_FENCE();
#pragma unroll
    for (int i = 0; i < 4; ++i) { const int row = i * 8 + (lane >> 3), ch = lane & 7; const u32x4 w = *(const u32x4*)(stg + row * 64 + ch * 8); *(u32x4*)(gbase + (long)row * grs + ch * 8) = w; }
    LDS_FENCE();
}

constexpr int N_AC = 32 * 80, N_BU = 3 * NB * 6 * 32, N_UNITS = N_AC + N_BU;

__device__ __forceinline__ void attn_phase(const Args& a, unsigned char* lds, int tid, int layer, unsigned long long& tacc) {
    unsigned char* ws = a.ws;
    const bf16_t* QKV = (const bf16_t*)(ws + WS_QKV);
    bf16_t* O = (bf16_t*)(ws + WS_O);
    bf16_t* OBP = (bf16_t*)(ws + WS_OBP);
    float* LSEB = (float*)(ws + WS_LSEB);
    const float* F2 = (const float*)(ws + WS_LOGF);
    const int lane = tid & 63, wid = __builtin_amdgcn_readfirstlane(tid >> 6), r32 = lane & 31, hi = lane >> 5;
    float* wsf = (float*)(lds + AT_WS + wid * 256);
    bf16_t* stg = (bf16_t*)(lds + AT_Q + wid * 4096);
    const float lam_init = 0.8f - 0.6f * __expf(-0.3f * (float)layer);
    float lam;
    { const float* lp = a.in[6] + (size_t)layer * 128; float s1 = 0.f, s2 = 0.f; if (lane < 32) { s1 = lp[lane] * lp[32 + lane]; s2 = lp[64 + lane] * lp[96 + lane]; }
      s1 = wave_sum(s1); s2 = wave_sum(s2); lam = expf(s1) - expf(s2) + lam_init; }
    const int G = gridDim.x, bx = blockIdx.x;
    const int vcu = (G % 8 == 0) ? (bx % 8) * (G / 8) + bx / 8 : bx;
    for (int it = vcu; it < 256 * 28; it += G) {
        const int s = it & 255, step = it >> 8, team = s >> 5, c = s & 31;
        int u;
        if (step < 6) { const int hd = team * 6 + step, qb = (step & 1) ? 31 - c : c; u = (31 - qb) * 80 + hd; }
        else if (step < 10) { const int st = step - 6, hd = team * 4 + st, qb = (st & 1) ? 31 - c : c; u = (31 - qb) * 80 + 48 + hd; }
        else { const int k = step - 10, hd = team * 6 + k / 3, p = k % 3; u = N_AC + ((p * 48 + hd) << 5) + c; }
        __syncthreads();
        float mref; f32x16 ol, o0, o1;
        if (u < N_AC) {
            const int qb = 31 - u / 80, j = u % 80, q0 = qb * 256;
            if (j < 48) {
#ifndef NO_VC
                TIC(13);
                const int b = j / 6, h = j % 6;
                const bf16_t* Qg = QKV + (size_t)(b * NSLOT + 30 + h) * T * 64; const bf16_t* Kg = QKV + (size_t)(b * NSLOT + 36 + h) * T * 64; const bf16_t* Vg = QKV + (size_t)(b * NSLOT + 42 + h) * T * 64;
                const float* Fg = F2 + (size_t)(b * 6 + h) * T;
                attn_core<64, 1>(lds, tid, Qg, 64, Kg, 64, Vg, 64, Fg, Fg[q0], q0, 0, 4 * qb + 4, 0, mref, ol, o0, o1);
                STG_BASE(stg);
#pragma unroll
                for (int r = 0; r < 16; ++r) { const float rl = __builtin_amdgcn_rcpf(ol[r]); STG_PUT(r, o0[r] * rl, o1[r] * rl); }
                stage_flush(stg, lane, O + (size_t)(b * T + q0 + 32 * wid) * DM + 640 + h * 64, DM);
                TOC(13);
#endif
            } else {
#ifndef NO_VA
                const int jj = j - 48, b = jj / 4, h = jj % 4;
                const bf16_t* Qg = QKV + (size_t)(b * NSLOT + h) * T * 64; const bf16_t* Kg = QKV + (size_t)(b * NSLOT + 4 + h) * T * 64; const bf16_t* Vg = QKV + (size_t)(b * NSLOT + 8 + h) * T * 64;
                attn_core<32, 0>(lds, tid, Qg, 32, Kg, 32, Vg, 64, nullptr, 0.f, q0, 0, 4 * qb + 4, 0, mref, ol, o0, o1);
                float* stash = (float*)(lds + AT_STASH + wid * 8192) + lane;
#pragma unroll
                for (int r = 0; r < 16; ++r) { const float rl = __builtin_amdgcn_rcpf(ol[r]); stash[r * 64] = o0[r] * rl; stash[(16 + r) * 64] = o1[r] * rl; }
                attn_core<32, 0>(lds, tid, Qg + (size_t)T * 32, 32, Kg + (size_t)T * 32, 32, Vg, 64, nullptr, 0.f, q0, 0, 4 * qb + 4, 0, mref, ol, o0, o1);
                const float* sg = a.in[7] + (size_t)layer * 64;
                const float g0 = sg[r32] * (1.0f - lam_init), g1 = sg[32 + r32] * (1.0f - lam_init);
                STG_BASE(stg);
#pragma unroll
                for (int r = 0; r < 16; ++r) {
                    const float rl = __builtin_amdgcn_rcpf(ol[r]);
                    const float a0 = stash[r * 64] - lam * (o0[r] * rl), a1 = stash[(16 + r) * 64] - lam * (o1[r] * rl);
                    float ss = a0 * a0 + a1 * a1;
                    ss += __shfl_xor(ss, 1); ss += __shfl_xor(ss, 2); ss += __shfl_xor(ss, 4); ss += __shfl_xor(ss, 8); ss += __shfl_xor(ss, 16);
                    const float rs = 1.0f / sqrtf(ss * (1.f / 64.f) + 1e-5f);
                    STG_PUT(r, a0 * rs * g0, a1 * rs * g1);
                }
                stage_flush(stg, lane, O + (size_t)(b * T + q0 + 32 * wid) * DM + h * 64, DM);
#endif
            }
        } else {
#ifndef NO_VB
            TIC(15);
            const int v = u - N_AC, k = v & 31, bhp = v >> 5, h = bhp % 6, b = (bhp / 6) % NB, p = bhp / (6 * NB);
            const int d = (p == 0) ? 1 : (p == 1) ? 4 : 16, bpc = 32 / d, cls = k / bpc, nb = k % bpc, q0 = nb * 256;
            const bf16_t* Qg = QKV + ((size_t)(b * NSLOT + 12 + h) * T + cls) * 64; const bf16_t* Kg = QKV + ((size_t)(b * NSLOT + 18 + h) * T + cls) * 64; const bf16_t* Vg = QKV + ((size_t)(b * NSLOT + 24 + h) * T + cls) * 64;
            const long rs_ = (long)d * 64;
            attn_core_band(lds, tid, Qg, Kg, Vg, rs_, q0, (nb == 0) ? 2 : 0, q0 - 128, mref, ol, o0, o1);
            float mr[16];
            row_bcast((float*)(lds + ATB_WS + wid * 256), mref, r32, hi, mr);
            const size_t pb = ((size_t)(p * NB + b) * 6 + h) * T;
            bf16_t* stgb = (bf16_t*)(lds + ATB_Q + wid * 4096);
            STG_BASE(stgb);
#pragma unroll
            for (int r = 0; r < 16; ++r) {
                const size_t tok = pb + cls + (size_t)d * (q0 + 32 * wid + crow(r, hi));
                const float rl = __builtin_amdgcn_rcpf(ol[r]);
                if (r32 == 0) LSEB[tok] = mr[r] + __log2f(ol[r]);
                STG_PUT(r, o0[r] * rl, o1[r] * rl);
            }
            stage_flush(stgb, lane, OBP + (pb + cls + (size_t)d * (q0 + 32 * wid)) * 64, rs_);
            TOC(15);
#endif
        }
    }
}

__device__ __forceinline__ void combine_phase(unsigned char* ws, int tid, int G) {
    const bf16_t* OBP = (const bf16_t*)(ws + WS_OBP); const float* LSEB = (const float*)(ws + WS_LSEB); bf16_t* O = (bf16_t*)(ws + WS_O);
    const size_t NI = (size_t)MROWS * 48, PS = (size_t)NB * 6 * T;
    for (size_t i = (size_t)blockIdx.x * 512 + tid; i < NI; i += (size_t)G * 512) {
        const int row = (int)(i / 48), rem = (int)(i % 48), h = rem >> 3, ch = rem & 7, b = row >> 13, t = row & (T - 1);
        const size_t e = ((size_t)b * 6 + h) * T + t;
        const float l0 = LSEB[e], l1 = LSEB[PS + e], l2 = LSEB[2 * PS + e];
        const float mx = fmaxf(l0, fmaxf(l1, l2));
        float w0 = __builtin_amdgcn_exp2f(l0 - mx), w1 = __builtin_amdgcn_exp2f(l1 - mx), w2 = __builtin_amdgcn_exp2f(l2 - mx);
        const float inv = 1.0f / (w0 + w1 + w2); w0 *= inv; w1 *= inv; w2 *= inv;
        const u32x4 a0 = *(const u32x4*)(OBP + e * 64 + ch * 8), a1 = *(const u32x4*)(OBP + (PS + e) * 64 + ch * 8), a2 = *(const u32x4*)(OBP + (2 * PS + e) * 64 + ch * 8);
        u32x4 o;
#pragma unroll
        for (int q = 0; q < 4; ++q) {
            const float x0 = w0 * bf2f((unsigned short)(a0[q] & 0xffffu)) + w1 * bf2f((unsigned short)(a1[q] & 0xffffu)) + w2 * bf2f((unsigned short)(a2[q] & 0xffffu));
            const float x1 = w0 * bf2f((unsigned short)(a0[q] >> 16)) + w1 * bf2f((unsigned short)(a1[q] >> 16)) + w2 * bf2f((unsigned short)(a2[q] >> 16));
            o[q] = pk2(x0, x1);
        }
        *(u32x4*)(O + (size_t)row * DM + 256 + h * 64 + ch * 8) = o;
    }
}
__device__ __forceinline__ void fix_phase(unsigned char* ws, const float* cw, const float* cb, int tid, int G) {
    const unsigned char* FIXP = (const unsigned char*)(ws + WS_FIX); const unsigned char* FIXT2 = FIXP + FIX_ELEMS * 4; bf16_t* ACT = (bf16_t*)(ws + WS_ACT);
    constexpr int F4 = DFF / 4; const int NI = 1024 * 2 * F4;
    for (int i = blockIdx.x * 512 + tid; i < NI; i += G * 512) {
        const int grp = i / (2 * F4), rem = i % (2 * F4), rr = rem / F4, f = (rem % F4) * 4;
        const int row = grp * 64 + rr, t = row & (T - 1);
#define FX_U2F(w, hi_) ((hi_) ? __builtin_bit_cast(float, (w) & 0xffff0000u) : __builtin_bit_cast(float, (w) << 16))
        const u32x4 own = *(const u32x4*)(FIXP + (((size_t)grp * 2 + rr) * DFF + f) * 4);
        const f32x4 uu = (f32x4){FX_U2F(own.x, 0), FX_U2F(own.x, 1), FX_U2F(own.y, 0), FX_U2F(own.y, 1)}, g0 = (f32x4){FX_U2F(own.z, 0), FX_U2F(own.z, 1), FX_U2F(own.w, 0), FX_U2F(own.w, 1)};
        f32x4 gm1 = (f32x4){0.f, 0.f, 0.f, 0.f}, gm2 = gm1;
        typedef unsigned u32x2t __attribute__((ext_vector_type(2)));
        const u32x2t t1 = (t >= 2 - rr && grp > 0) ? *(const u32x2t*)(FIXT2 + (((size_t)(grp - 1) * 2 + 1) * DFF + f) * 4) : (u32x2t){0u, 0u};
        const f32x4 tail1 = (f32x4){FX_U2F(t1.x, 0), FX_U2F(t1.x, 1), FX_U2F(t1.y, 0), FX_U2F(t1.y, 1)};
        if (rr == 0) {
            if (t >= 1) gm1 = tail1;
            if (t >= 2) { const u32x2t t0 = *(const u32x2t*)(FIXT2 + (((size_t)(grp - 1) * 2 + 0) * DFF + f) * 4); gm2 = (f32x4){FX_U2F(t0.x, 0), FX_U2F(t0.x, 1), FX_U2F(t0.y, 0), FX_U2F(t0.y, 1)}; }
        } else {
            const u32x4 p0 = *(const u32x4*)(FIXP + (((size_t)grp * 2 + 0) * DFF + f) * 4);
            gm1 = (f32x4){FX_U2F(p0.z, 0), FX_U2F(p0.z, 1), FX_U2F(p0.w, 0), FX_U2F(p0.w, 1)};
            if (t >= 2) gm2 = tail1;
        }
#undef FX_U2F
        const f32x4 w0 = *(const f32x4*)(cw + f), w1 = *(const f32x4*)(cw + DFF + f), w2 = *(const f32x4*)(cw + 2 * DFF + f), bb = *(const f32x4*)(cb + f);
        float av[4];
#pragma unroll
        for (int q = 0; q < 4; ++q) { const float y = bb[q] + w0[q] * gm2[q] + w1[q] * gm1[q] + w2[q] * g0[q]; av[q] = y * __builtin_amdgcn_rcpf(1.f + __expf(-y)) * uu[q]; }
        *(unsigned long long*)(ACT + (size_t)row * DFF + f) = (unsigned long long)pk2(av[0], av[1]) | ((unsigned long long)pk2(av[2], av[3]) << 32);
    }
}

#define XB_TMO      128
#define XB_XCNT(j)  (256  + 64 * (j))
#define XB_XSUB(j)  (1280 + 64 * (j))
#define XB_XGEN(j)  (2304 + 64 * (j))
#define XB_TOP      3328
#define XB_TOPGEN   3392
#define XCD_BAR_WORDS 3456
#define XB_SPIN_CAP (1u << 18)

__device__ __forceinline__ unsigned xb_ld(unsigned* p)              { return __hip_atomic_load(p, __ATOMIC_RELAXED, __HIP_MEMORY_SCOPE_AGENT); }
__device__ __forceinline__ unsigned xb_add(unsigned* p, unsigned v) { return __hip_atomic_fetch_add(p, v, __ATOMIC_RELAXED, __HIP_MEMORY_SCOPE_AGENT); }
__device__ __forceinline__ unsigned xb_xcc_id() { return (unsigned)__builtin_amdgcn_s_getreg((3 << 11) | 20) & 0xFu; }
#define XB_SPIN(cond, bar) do { unsigned _sp = 0; while (cond) { __builtin_amdgcn_s_sleep(1); \
    if ((++_sp & 255u) == 0u) { if (xb_ld(&(bar)[XB_TMO])) break; if (_sp > XB_SPIN_CAP) { atomicAdd(&(bar)[XB_TMO], 1u); break; } } } } while (0)

struct XcdBarrier {
    unsigned* bar; unsigned x;
    volatile LAS unsigned* st;
};

__device__ __forceinline__ XcdBarrier xcd_barrier_post(unsigned* bar, volatile LAS unsigned* st) {
    XcdBarrier b; b.bar = bar; b.x = xb_xcc_id(); b.st = st;
    if (threadIdx.x == 0) (void)xb_add(&bar[XB_XCNT(b.x)], 1u);
    return b;
}
__device__ __forceinline__ void xcd_barrier_complete(unsigned* bar, unsigned x, unsigned& nloc, unsigned& nx) {
    const unsigned G = gridDim.x * gridDim.y * gridDim.z;
    unsigned sum, cnt, mine, sp = 0u;
    for (;;) {
        sum = 0u; cnt = 0u; mine = 0u;
#pragma unroll
        for (unsigned j = 0; j < 16; ++j) { const unsigned c = xb_ld(&bar[XB_XCNT(j)]); sum += c; cnt += (c > 0u) ? 1u : 0u; mine = (j == x) ? c : mine; }
        if (sum == G) break;
        __builtin_amdgcn_s_sleep(1);
        if ((++sp & 255u) == 0u) { if (xb_ld(&bar[XB_TMO])) break; if (sp > XB_SPIN_CAP) { atomicAdd(&bar[XB_TMO], 1u); break; } }
    }
    nloc = mine > 0u ? mine : 1u; nx = cnt > 0u ? cnt : 1u;
}

__device__ __forceinline__ void xcd_barrier(const XcdBarrier& b) {
    asm volatile("s_waitcnt vmcnt(0)" ::: "memory");
    __syncthreads();
    if (threadIdx.x == 0) {
        unsigned* bar = b.bar;
        __builtin_amdgcn_s_waitcnt(0);
        unsigned nloc = b.st[0], nx = b.st[1];
        if (nloc == 0u) { xcd_barrier_complete(bar, b.x, nloc, nx); b.st[0] = nloc; b.st[1] = nx; }
        const unsigned old = xb_add(&bar[XB_XSUB(b.x)], 1u);
        const unsigned gen = old / nloc;
        if (old + 1u == (gen + 1u) * nloc) {
            __builtin_amdgcn_fence(__ATOMIC_RELEASE, "agent");
            asm volatile("s_waitcnt vmcnt(0)" ::: "memory");
            const unsigned og = xb_add(&bar[XB_TOP], 1u);
            const unsigned tg = og / nx;
            if (og + 1u == (tg + 1u) * nx) xb_add(&bar[XB_TOPGEN], 1u);
            else XB_SPIN(xb_ld(&bar[XB_TOPGEN]) == tg, bar);
            __builtin_amdgcn_fence(__ATOMIC_ACQUIRE, "agent");
            xb_add(&bar[XB_XGEN(b.x)], 1u);
            asm volatile("s_waitcnt vmcnt(0)" ::: "memory");
        } else {
            XB_SPIN(xb_ld(&bar[XB_XGEN(b.x)]) == gen, bar);
            __builtin_amdgcn_fence(__ATOMIC_ACQUIRE, "agent");
            asm volatile("s_waitcnt vmcnt(0)" ::: "memory");
        }
    }
    __syncthreads();
}

#define GSYNC() do { TIC(12); xcd_barrier(xbar); TOC(12); } while (0)
__global__ void __launch_bounds__(512, 2) fwd_mega(Args a) {
    extern __shared__ __attribute__((aligned(16))) unsigned char lds[];
    cg::grid_group grid = cg::this_grid();
    const int tid0 = threadIdx.x, G = gridDim.x;
#define LAUNDER_TID() int tid = tid0; asm volatile("" : "+v"(tid))
    unsigned char* ws = a.ws;
    PG8_LAS unsigned char* ldsl = (PG8_LAS unsigned char*)lds;
    bf16_t* H = (bf16_t*)(ws + WS_H);
    float* MOD = (float*)(ws + WS_MOD);
    unsigned* ctl = (unsigned*)(ws + WS_CTL);
    unsigned long long tacc = 0;
    if (tid0 < 64) ((volatile LAS unsigned*)(lds + LDS_BYTES - 4096))[tid0] = 0u;
    __syncthreads();
    XcdBarrier xbar = xcd_barrier_post(ctl + 4096, (volatile LAS unsigned*)(lds + LDS_BYTES - 4096) + 8);

#ifndef SK_PRO
    { TIC(1); LAUNDER_TID(); prologue(a, lds, tid, G); TOC(1); }
#endif
    grid.sync();
#pragma unroll 1
    for (int layer = 0; layer < DEPTH; ++layer) {
        const float* xin = (layer == 0) ? a.in[0] : nullptr;
        bf16_t* XB = (bf16_t*)(ws + WS_XB); bf16_t* XA = (bf16_t*)(ws + WS_XA);
        const float* modl = MOD + (size_t)layer * NB * NMOD;
        const bf16_t* WT = (const bf16_t*)(ws + WS_WT) + (size_t)layer * WL_ELEMS;
#ifndef SK_N1
        if (layer == 0) { LAUNDER_TID(); cvec_phase(ws, tid, G); }
        { TIC(2); LAUNDER_TID(); norm_phase<true>(xin, XB, XB, H, a.in[4] + (size_t)layer * DM, modl, 0, DM, (const float*)(ws + WS_WFZ) + (size_t)layer * 6 * DM, a.in[8] + (size_t)layer * 6, (float*)(ws + WS_LOGF), tid, G); TOC(2); }
#endif
        GSYNC();
#ifndef SK_SCAN
        { LAUNDER_TID(); scan_phase((float*)(ws + WS_LOGF), lds, tid, G); }
#endif
        __syncthreads();
#ifndef SK_GIN
        { TIC(3); pg8::Gemm g{H, WT + WL_IN, MROWS, NIN, DM}; pg8::StaticOrder S; S.init(MROWS, NIN, G, (int)blockIdx.x);
          pg8::EpiIn E{(bf16_t*)(ws + WS_QKV), (const float*)(ws + WS_ROPEA), (const float*)(ws + WS_ROPEB)};
          pg8::gemm_phase<pg8::EpiIn, pg8::StaticOrder, true, true>(ldsl, g, S, E); TOC(3); }
#endif
        GSYNC();
#ifndef SK_ATT
        { TIC(4); LAUNDER_TID(); attn_phase(a, lds, tid, layer, tacc); TOC(4); }
#endif
        GSYNC();
#ifndef SK_CMB
        { TIC(5); LAUNDER_TID(); combine_phase(ws, tid, G); TOC(5); }
#endif
        GSYNC();
#ifndef SK_GOUT
        { TIC(6); pg8::Gemm g{(const bf16_t*)(ws + WS_O), WT + WL_OUT, MROWS, DM, DM}; pg8::StaticOrder S; S.init(MROWS, DM, G, (int)blockIdx.x);
          pg8::EpiRes<true> E{XB, XB, modl + 2 * DM, XA, (unsigned long long*)(ws + WS_SSQ) + (size_t)layer * MROWS, a.in[10] + (size_t)layer * DM, modl + 4 * DM};
          pg8::gemm_phase<pg8::EpiRes<true>, pg8::StaticOrder, true, true>(ldsl, g, S, E); TOC(6); }
#endif
        GSYNC();
#ifndef SK_GUP
        { TIC(8); pg8::Gemm g{XA, WT + WL_UP, MROWS, NUP, DM}; pg8::StaticOrder S; S.init(MROWS, NUP, G, (int)blockIdx.x);
          float* FX = (float*)(ws + WS_FIX);
          pg8::EpiUp E{(bf16_t*)(ws + WS_ACT), (unsigned char*)FX, (unsigned char*)FX + FIX_ELEMS * 4, a.in[12] + (size_t)layer * 3 * DFF, a.in[13] + (size_t)layer * DFF,
                       (const unsigned long long*)(ws + WS_SSQ) + (size_t)layer * MROWS, (const float*)(ws + WS_CUP) + (size_t)layer * NB * NUP};
          pg8::gemm_phase<pg8::EpiUp, pg8::StaticOrder, true, true>(ldsl, g, S, E); TOC(8); }
#endif
        GSYNC();
#ifndef SK_FIX
        { TIC(9); LAUNDER_TID(); fix_phase(ws, a.in[12] + (size_t)layer * 3 * DFF, a.in[13] + (size_t)layer * DFF, tid, G); TOC(9); }
#endif
        GSYNC();
#ifndef SK_GDN
        { TIC(10); pg8::Gemm g{(const bf16_t*)(ws + WS_ACT), WT + WL_DN, MROWS, DM, DFF}; pg8::StaticOrder S; S.init(MROWS, DM, G, (int)blockIdx.x);
          pg8::EpiRes<false> E{XB, XB, modl + 5 * DM, nullptr, nullptr, nullptr, nullptr};
          pg8::gemm_phase<pg8::EpiRes<false>, pg8::StaticOrder, true, true>(ldsl, g, S, E); TOC(10); }
#endif
        GSYNC();
    }
    { TIC(11); LAUNDER_TID(); final_norm((const bf16_t*)(ws + WS_XB), a.out, a.in[15], tid, G); TOC(11); }
    if (PROBE_MASK != 0 && blockIdx.x == 0) { const unsigned long long ts = __builtin_amdgcn_s_memrealtime(); while (__builtin_amdgcn_s_memrealtime() - ts < tacc) __builtin_amdgcn_s_sleep(8); }
}

extern "C" void kernel_launch(void* const* d_in, const int* in_sizes, int n_in, void* d_out, int out_size, void* d_ws, size_t ws_size, hipStream_t stream) {
    static int grid = 0;
    if (grid == 0) {
        if (n_in != 16 || ws_size < WS_END) { fprintf(stderr, "kernel_launch: unexpected inputs (n_in %d, ws %zu)\n", n_in, ws_size); grid = -1; return; }
        int dev = 0, cus = 0, per_cu = 0;
        hipGetDevice(&dev);
        hipDeviceGetAttribute(&cus, hipDeviceAttributeMultiprocessorCount, dev);
        hipFuncSetAttribute((const void*)fwd_mega, hipFuncAttributeMaxDynamicSharedMemorySize, LDS_BYTES);
        hipOccupancyMaxActiveBlocksPerMultiprocessor(&per_cu, (const void*)fwd_mega, 512, LDS_BYTES);
        if (per_cu < 1) per_cu = 1;
        (void)hipGetLastError();
        grid = cus * per_cu;
    }
    if (grid < 0) return;
    hipMemsetAsync((char*)d_ws + WS_CTL, 0, CTL_BYTES, stream);
    hipMemsetAsync((char*)d_ws + WS_SSQ, 0, (size_t)DEPTH * MROWS * 8, stream);
    Args a{};
    for (int i = 0; i < 16; ++i) a.in[i] = (const float*)d_in[i];
    a.out = (float*)d_out; a.ws = (unsigned char*)d_ws;
    void* args[] = {&a};
    hipError_t e = hipLaunchCooperativeKernel((const void*)fwd_mega, dim3(grid), dim3(512), args, LDS_BYTES, stream);
    if (e != hipSuccess) fprintf(stderr, "cooperative launch failed: %s (grid %d)\n", hipGetErrorString(e), grid);
}
```
